# Optimizing an MI355X kernel written in HIP

```python
import jax, jax.numpy as jnp
from jax import lax
import numpy as np

D_MODEL = 1024
BATCH = 8
SEQ = 2048
DEPTH = 4
DEC_BATCH = 128
DEC_SEQ = 1
PAST_LEN = 16384
PAGE_SIZE = 128

D_LRU = D_MODEL // 2
LRU_HEADS = 8
LRU_HD = D_LRU // LRU_HEADS
LRU_C = 8.0
CONV_W = 4
RET_HEADS = 4
RET_DK = D_MODEL // 16
RET_DV = 2 * RET_DK
D_RET = RET_HEADS * RET_DV
ROPE_BASE = 10000.0
SSD_HD = 64
D_SSD = D_MODEL // 2
SSD_HEADS = D_SSD // SSD_HD
SSD_GROUPS = 2
SSD_DSTATE = 128
SSD_CONV_DIM = D_SSD + 2 * SSD_GROUPS * SSD_DSTATE
D_MIX = D_LRU + D_RET + D_SSD
IN_SIZES = (D_LRU, D_LRU, RET_HEADS * RET_DK, RET_HEADS * RET_DK, D_RET, D_RET, D_SSD, SSD_CONV_DIM, SSD_HEADS)
D_IN = 2 * D_LRU + 2 * RET_HEADS * RET_DK + 2 * D_RET + D_SSD + SSD_CONV_DIM + SSD_HEADS
CHUNK = 128
D_FF = 128 * ((8 * D_MODEL // 3 + 127) // 128)
FFN_CONV_W = 3
EPS = 1e-6

kernel_name = 'hybrid_lru_retention_ssd_convffn_step'


def _rmsnorm(x, g):
    xf = x.astype(jnp.float32)
    y = xf * lax.rsqrt(jnp.mean(xf * xf, axis=-1, keepdims=True) + EPS)
    return (y * g.astype(jnp.float32)).astype(x.dtype)


def _split_cols(t, sizes):
    out, start = [], 0
    for s in sizes:
        out.append(t[..., start:start + s])
        start += s
    return out


def _chunk_len(L):
    return CHUNK if L % CHUNK == 0 else L


def _causal_dwconv(x, prev, w, b):
    W = w.shape[0]
    L = x.shape[1]
    xp = jnp.concatenate([prev.astype(x.dtype), x], axis=1)
    y = b
    for k in range(W):
        y = y + w[k] * xp[:, k:k + L]
    return y, xp[:, L:]


def _lin_combine(c1, c2):
    a1, b1 = c1
    a2, b2 = c2
    return a1 * a2, a2 * b1 + b2


def _rg_lru(xc, h0, wr, br, wi, bi, lam):
    f32 = jnp.float32
    bsz, L, _ = xc.shape
    xf = xc.astype(f32)
    xh = xf.reshape(bsz, L, LRU_HEADS, LRU_HD)
    r = jax.nn.sigmoid(jnp.einsum('blhi,hij->blhj', xh, wr.astype(f32)).reshape(bsz, L, D_LRU) + br.astype(f32))
    ig = jax.nn.sigmoid(jnp.einsum('blhi,hij->blhj', xh, wi.astype(f32)).reshape(bsz, L, D_LRU) + bi.astype(f32))
    log_a = -LRU_C * r * jax.nn.softplus(-lam.astype(f32))
    a = jnp.exp(log_a)
    b = jnp.sqrt(-jnp.expm1(2.0 * log_a)) * (ig * xf)
    b = b.at[:, 0].add(a[:, 0] * h0.astype(f32))
    _, h = lax.associative_scan(_lin_combine, (a, b), axis=1)
    return h, h[:, -1]


def _rotary(x, pos):
    half = x.shape[-1] // 2
    freqs = ROPE_BASE ** (-jnp.arange(half, dtype=jnp.float32) / half)
    ang = pos.astype(jnp.float32)[:, None] * freqs[None, :]
    cos = jnp.cos(ang)[None, :, None, :]
    sin = jnp.sin(ang)[None, :, None, :]
    xf = x.astype(jnp.float32)
    x1, x2 = xf[..., :half], xf[..., half:]
    return jnp.concatenate([x1 * cos - x2 * sin, x1 * sin + x2 * cos], axis=-1)


def _retention(q, k, v, s0):
    f32 = jnp.float32
    bsz, L, H, _ = q.shape
    C = _chunk_len(L)
    nc = L // C
    log_g = jnp.log1p(-jnp.exp2(-5.0 - jnp.arange(H, dtype=f32)))
    idx = jnp.arange(C, dtype=f32)
    diff = idx[:, None] - idx[None, :]
    decay = jnp.exp(jnp.where(diff[None] >= 0, diff[None] * log_g[:, None, None], -jnp.inf))
    q_dec = jnp.exp((idx[None, :] + 1.0) * log_g[:, None])[..., None]
    k_dec = jnp.exp((C - 1.0 - idx[None, :]) * log_g[:, None])[..., None]
    c_dec = jnp.exp(C * log_g)[:, None, None]

    def to_chunks(t):
        t = t.astype(f32).reshape(bsz, nc, C, H, t.shape[-1])
        return jnp.moveaxis(t, 1, 0).transpose(0, 1, 3, 2, 4)

    def step(s, inp):
        qb, kb, vb = inp
        scores = jnp.einsum('bhik,bhjk->bhij', qb, kb) * decay
        o = jnp.einsum('bhij,bhjv->bhiv', scores, vb) + jnp.einsum('bhik,bhkv->bhiv', qb * q_dec, s)
        s = s * c_dec + jnp.einsum('bhjk,bhjv->bhkv', kb * k_dec, vb)
        return s, o

    s, o = lax.scan(step, s0.astype(f32), (to_chunks(q), to_chunks(k), to_chunks(v)))
    o = o.transpose(1, 0, 3, 2, 4).reshape(bsz, L, H, v.shape[-1])
    return o, s


def _ssd(x, dt, a, bm, cm, s0):
    f32 = jnp.float32
    bsz, L = x.shape[:2]
    C = _chunk_len(L)
    nc = L // C
    R = SSD_HEADS // SSD_GROUPS
    mv = lambda t: jnp.moveaxis(t, 1, 0)
    xf = mv(x.astype(f32).reshape(bsz, nc, C, SSD_GROUPS, R, SSD_HD))
    dtf = dt.astype(f32).reshape(bsz, nc, C, SSD_GROUPS, R)
    daf = mv(dtf * a.astype(f32).reshape(SSD_GROUPS, R))
    dtf = mv(dtf)
    bf = mv(bm.astype(f32).reshape(bsz, nc, C, SSD_GROUPS, SSD_DSTATE))
    cf = mv(cm.astype(f32).reshape(bsz, nc, C, SSD_GROUPS, SSD_DSTATE))
    causal = jnp.tril(jnp.ones((C, C), dtype=bool))[None, :, :, None, None]

    def step(s, inp):
        xb, dtb, dab, bb, cb = inp
        cum = jnp.cumsum(dab, axis=1)
        seg = cum[:, :, None] - cum[:, None, :]
        lmask = jnp.exp(jnp.where(causal, seg, -jnp.inf))
        cbw = jnp.einsum('bign,bjgn->bijg', cb, bb)
        wgt = cbw[..., None] * lmask * dtb[:, None]
        y = jnp.einsum('bijgr,bjgrp->bigrp', wgt, xb)
        y = y + jnp.einsum('bign,bgrpn->bigrp', cb, s) * jnp.exp(cum)[..., None]
        wlast = jnp.exp(cum[:, -1:] - cum) * dtb
        s = s * jnp.exp(cum[:, -1])[..., None, None] + jnp.einsum('bjgr,bjgrp,bjgn->bgrpn', wlast, xb, bb)
        return s, y

    s0f = s0.astype(f32).reshape(bsz, SSD_GROUPS, R, SSD_HD, SSD_DSTATE)
    s, y = lax.scan(step, s0f, (xf, dtf, daf, bf, cf))
    y = jnp.moveaxis(y, 0, 1).reshape(bsz, L, SSD_HEADS, SSD_HD)
    return y, s.reshape(bsz, SSD_HEADS, SSD_HD, SSD_DSTATE)


def _layer_stack(x, pos, st_lru_conv, st_lru_h, st_ret, st_ssd_conv, st_ssd, st_ffn_conv, w):
    f32 = jnp.float32
    bsz, L, _ = x.shape
    refs = (st_lru_conv, st_lru_h, st_ret, st_ssd_conv, st_ssd, st_ffn_conv)
    new = [[] for _ in refs]
    for l in range(DEPTH):
        h = _rmsnorm(x, w['norm_mix_g'][l])
        proj = jnp.einsum('bld,de->ble', h, w['w_in'][l])
        lru_x, lru_gate, r_q, r_k, r_v, r_g, s_z, s_xbc, s_dt = _split_cols(proj, IN_SIZES)
        xc, lru_buf = _causal_dwconv(lru_x, st_lru_conv[l], w['lru_conv_w'][l], w['lru_conv_b'][l])
        h_lru, lru_last = _rg_lru(xc, st_lru_h[l], w['lru_wr'][l], w['lru_br'][l], w['lru_wi'][l], w['lru_bi'][l], w['lru_lambda'][l])
        y_a = h_lru.astype(x.dtype) * jax.nn.gelu(lru_gate)
        q = _rotary(r_q.reshape(bsz, L, RET_HEADS, RET_DK), pos)
        k = _rotary(r_k.reshape(bsz, L, RET_HEADS, RET_DK), pos) * (RET_DK ** -0.5)
        v = r_v.reshape(bsz, L, RET_HEADS, RET_DV)
        o, ret_last = _retention(q, k, v, st_ret[l])
        o = _rmsnorm(o, w['ret_norm_g'][l]).astype(x.dtype).reshape(bsz, L, D_RET)
        y_b = jax.nn.silu(r_g) * o
        xbc, ssd_buf = _causal_dwconv(s_xbc, st_ssd_conv[l], w['ssd_conv_w'][l], w['ssd_conv_b'][l])
        xbc = jax.nn.silu(xbc)
        xs, bm, cm = _split_cols(xbc, (D_SSD, SSD_GROUPS * SSD_DSTATE, SSD_GROUPS * SSD_DSTATE))
        dt = jax.nn.softplus(s_dt.astype(f32) + w['ssd_dt_bias'][l].astype(f32))
        a = -jnp.exp(w['ssd_a_log'][l].astype(f32))
        ys, ssd_last = _ssd(xs, dt, a, bm.reshape(bsz, L, SSD_GROUPS, SSD_DSTATE), cm.reshape(bsz, L, SSD_GROUPS, SSD_DSTATE), st_ssd[l])
        ys = ys + w['ssd_d'][l].astype(f32)[:, None] * xs.astype(f32).reshape(bsz, L, SSD_HEADS, SSD_HD)
        gated = ys * jax.nn.silu(s_z.astype(f32)).reshape(bsz, L, SSD_HEADS, SSD_HD)
        gated = gated.reshape(bsz, L, SSD_GROUPS, D_SSD // SSD_GROUPS)
        y_c = _rmsnorm(gated, w['ssd_norm_g'][l].reshape(SSD_GROUPS, D_SSD // SSD_GROUPS)).astype(x.dtype).reshape(bsz, L, D_SSD)
        mix = jnp.concatenate([y_a, y_b, y_c], axis=-1)
        x = x + jnp.einsum('blm,md->bld', mix, w['w_out'][l])
        h = _rmsnorm(x, w['norm_ffn_g'][l])
        gu = jnp.einsum('bld,df->blf', h, w['ffn_w_up'][l])
        gate, up = gu[..., :D_FF], gu[..., D_FF:]
        gate, ffn_buf = _causal_dwconv(gate, st_ffn_conv[l], w['ffn_conv_w'][l], w['ffn_conv_b'][l])
        x = x + jnp.einsum('blf,fd->bld', jax.nn.gelu(gate) * up, w['ffn_w_down'][l])
        for lst, val, ref in zip(new, (lru_buf, lru_last, ret_last, ssd_buf, ssd_last, ffn_buf), refs):
            lst.append(val.astype(ref.dtype))
    y = _rmsnorm(x, w['norm_final_g'])
    return y, [jnp.stack(s, axis=0) for s in new]


def setup_inputs(seed: int = 0) -> dict:
    key = jax.random.key(seed)
    ks = iter(jax.random.split(key, 48))
    f32 = jnp.float32

    def nrm(shape, scale):
        return jax.random.normal(next(ks), shape, f32) * scale

    x_prompt = nrm((BATCH, SEQ, D_MODEL), 1.0)
    x_sample = nrm((DEC_BATCH, DEC_SEQ, D_MODEL), 1.0)
    state_lru_conv = nrm((DEPTH, DEC_BATCH, CONV_W - 1, D_LRU), 1.0)
    state_lru_h = nrm((DEPTH, DEC_BATCH, D_LRU), 0.5)
    state_ret = nrm((DEPTH, DEC_BATCH, RET_HEADS, RET_DK, RET_DV), 0.5)
    state_ssd_conv = nrm((DEPTH, DEC_BATCH, CONV_W - 1, SSD_CONV_DIM), 1.0)
    state_ssd = nrm((DEPTH, DEC_BATCH, SSD_HEADS, SSD_HD, SSD_DSTATE), 0.1)
    state_ffn_conv = nrm((DEPTH, DEC_BATCH, FFN_CONV_W - 1, D_FF), 1.0)
    norm_mix_g = 1.0 + nrm((DEPTH, D_MODEL), 0.02)
    w_in = nrm((DEPTH, D_MODEL, D_IN), D_MODEL ** -0.5)
    lru_conv_w = nrm((DEPTH, CONV_W, D_LRU), CONV_W ** -0.5)
    lru_conv_b = nrm((DEPTH, D_LRU), 0.02)
    lru_wr = nrm((DEPTH, LRU_HEADS, LRU_HD, LRU_HD), LRU_HD ** -0.5)
    lru_br = nrm((DEPTH, D_LRU), 0.02)
    lru_wi = nrm((DEPTH, LRU_HEADS, LRU_HD, LRU_HD), LRU_HD ** -0.5)
    lru_bi = nrm((DEPTH, D_LRU), 0.02)
    a_lru = jax.random.uniform(next(ks), (DEPTH, D_LRU), f32, 0.9, 0.999)
    a_root = a_lru ** (1.0 / LRU_C)
    lru_lambda = jnp.log(a_root) - jnp.log1p(-a_root)
    ret_norm_g = 1.0 + nrm((DEPTH, RET_HEADS, RET_DV), 0.02)
    ssd_conv_w = nrm((DEPTH, CONV_W, SSD_CONV_DIM), CONV_W ** -0.5)
    ssd_conv_b = nrm((DEPTH, SSD_CONV_DIM), 0.02)
    dt0 = jnp.exp(jax.random.uniform(next(ks), (DEPTH, SSD_HEADS), f32, float(np.log(1e-3)), float(np.log(1e-1))))
    ssd_dt_bias = dt0 + jnp.log(-jnp.expm1(-dt0))
    ssd_a_log = jnp.log(jax.random.uniform(next(ks), (DEPTH, SSD_HEADS), f32, 1.0, 16.0))
    ssd_d = 1.0 + nrm((DEPTH, SSD_HEADS), 0.02)
    ssd_norm_g = 1.0 + nrm((DEPTH, D_SSD), 0.02)
    w_out = nrm((DEPTH, D_MIX, D_MODEL), D_MIX ** -0.5)
    norm_ffn_g = 1.0 + nrm((DEPTH, D_MODEL), 0.02)
    ffn_w_up = nrm((DEPTH, D_MODEL, 2 * D_FF), D_MODEL ** -0.5)
    ffn_conv_w = nrm((DEPTH, FFN_CONV_W, D_FF), FFN_CONV_W ** -0.5)
    ffn_conv_b = nrm((DEPTH, D_FF), 0.02)
    ffn_w_down = nrm((DEPTH, D_FF, D_MODEL), D_FF ** -0.5)
    norm_final_g = 1.0 + nrm((D_MODEL,), 0.02)
    return {'x_prompt': x_prompt, 'x_sample': x_sample,
            'state_lru_conv': state_lru_conv, 'state_lru_h': state_lru_h, 'state_ret': state_ret,
            'state_ssd_conv': state_ssd_conv, 'state_ssd': state_ssd, 'state_ffn_conv': state_ffn_conv,
            'norm_mix_g': norm_mix_g, 'w_in': w_in,
            'lru_conv_w': lru_conv_w, 'lru_conv_b': lru_conv_b, 'lru_wr': lru_wr, 'lru_br': lru_br,
            'lru_wi': lru_wi, 'lru_bi': lru_bi, 'lru_lambda': lru_lambda,
            'ret_norm_g': ret_norm_g,
            'ssd_conv_w': ssd_conv_w, 'ssd_conv_b': ssd_conv_b, 'ssd_dt_bias': ssd_dt_bias,
            'ssd_a_log': ssd_a_log, 'ssd_d': ssd_d, 'ssd_norm_g': ssd_norm_g,
            'w_out': w_out, 'norm_ffn_g': norm_ffn_g, 'ffn_w_up': ffn_w_up,
            'ffn_conv_w': ffn_conv_w, 'ffn_conv_b': ffn_conv_b, 'ffn_w_down': ffn_w_down,
            'norm_final_g': norm_final_g}


def reference(x_prompt, x_sample, state_lru_conv, state_lru_h, state_ret, state_ssd_conv, state_ssd, state_ffn_conv,
              norm_mix_g, w_in, lru_conv_w, lru_conv_b, lru_wr, lru_br, lru_wi, lru_bi, lru_lambda,
              ret_norm_g, ssd_conv_w, ssd_conv_b, ssd_dt_bias, ssd_a_log, ssd_d, ssd_norm_g,
              w_out, norm_ffn_g, ffn_w_up, ffn_conv_w, ffn_conv_b, ffn_w_down, norm_final_g):
    w = {'norm_mix_g': norm_mix_g, 'w_in': w_in, 'lru_conv_w': lru_conv_w, 'lru_conv_b': lru_conv_b,
         'lru_wr': lru_wr, 'lru_br': lru_br, 'lru_wi': lru_wi, 'lru_bi': lru_bi, 'lru_lambda': lru_lambda,
         'ret_norm_g': ret_norm_g, 'ssd_conv_w': ssd_conv_w, 'ssd_conv_b': ssd_conv_b,
         'ssd_dt_bias': ssd_dt_bias, 'ssd_a_log': ssd_a_log, 'ssd_d': ssd_d, 'ssd_norm_g': ssd_norm_g,
         'w_out': w_out, 'norm_ffn_g': norm_ffn_g, 'ffn_w_up': ffn_w_up, 'ffn_conv_w': ffn_conv_w,
         'ffn_conv_b': ffn_conv_b, 'ffn_w_down': ffn_w_down, 'norm_final_g': norm_final_g}
    bp = x_prompt.shape[0]
    p_lru_conv0 = jnp.zeros((DEPTH, bp) + state_lru_conv.shape[2:], state_lru_conv.dtype)
    p_lru_h0 = jnp.zeros((DEPTH, bp) + state_lru_h.shape[2:], state_lru_h.dtype)
    p_ret0 = jnp.zeros((DEPTH, bp) + state_ret.shape[2:], state_ret.dtype)
    p_ssd_conv0 = jnp.zeros((DEPTH, bp) + state_ssd_conv.shape[2:], state_ssd_conv.dtype)
    p_ssd0 = jnp.zeros((DEPTH, bp) + state_ssd.shape[2:], state_ssd.dtype)
    p_ffn_conv0 = jnp.zeros((DEPTH, bp) + state_ffn_conv.shape[2:], state_ffn_conv.dtype)
    pos_p = jnp.arange(x_prompt.shape[1], dtype=jnp.int32)
    pos_s = PAST_LEN + jnp.arange(x_sample.shape[1], dtype=jnp.int32)
    y_prompt, ns_p = _layer_stack(x_prompt, pos_p, p_lru_conv0, p_lru_h0, p_ret0, p_ssd_conv0, p_ssd0, p_ffn_conv0, w)
    y_sample, ns_s = _layer_stack(x_sample, pos_s, state_lru_conv, state_lru_h, state_ret, state_ssd_conv, state_ssd, state_ffn_conv, w)
    lru_conv_p, lru_h_p, ret_p, ssd_conv_p, ssd_p, ffn_conv_p = ns_p
    lru_conv_s, lru_h_s, ret_s, ssd_conv_s, ssd_s, ffn_conv_s = ns_s
    return (y_prompt, y_sample, lru_conv_p, lru_conv_s, lru_h_p, lru_h_s, ret_p, ret_s,
            ssd_conv_p, ssd_conv_s, ssd_p, ssd_s, ffn_conv_p, ffn_conv_s)
```

```cpp
#include <hip/hip_runtime.h>
#include <hip/hip_cooperative_groups.h>
#include <cstdio>
namespace cg = cooperative_groups;

#define LAS __attribute__((address_space(3)))
typedef unsigned short bf16_t;
typedef short bf16x8 __attribute__((ext_vector_type(8)));
typedef short s16x4 __attribute__((ext_vector_type(4)));
typedef float f32x4 __attribute__((ext_vector_type(4)));
typedef float f32x2 __attribute__((ext_vector_type(2)));
typedef unsigned u32x4 __attribute__((ext_vector_type(4)));
typedef unsigned u32x2 __attribute__((ext_vector_type(2)));

constexpr int DM = 1024, NB = 8, SEQ = 2048, DEPTH = 4, NS = 128;
constexpr int TP = NB * SEQ;
constexpr int TT = TP + NS;
constexpr int DLRU = 512, DIN = 4104, NPROJ = 4096, DMIX = 1536, DFF = 2816, DGU = 5632;
constexpr int NCH = 32;
constexpr float EPS = 1e-6f;
constexpr int PC_LX = 0, PC_LG = 512, PC_Q = 1024, PC_K = 1280, PC_V = 1536, PC_RG = 2048, PC_Z = 2560, PC_XBC = 3072;

constexpr size_t O_Y = 0;
constexpr size_t O_LCP = (size_t)TT * DM;
constexpr size_t O_LCS = O_LCP + (size_t)DEPTH * NB * 3 * 512;
constexpr size_t O_LHP = O_LCS + (size_t)DEPTH * NS * 3 * 512;
constexpr size_t O_LHS = O_LHP + (size_t)DEPTH * NB * 512;
constexpr size_t O_RP = O_LHS + (size_t)DEPTH * NS * 512;
constexpr size_t O_RS = O_RP + (size_t)DEPTH * NB * 4 * 64 * 128;
constexpr size_t O_SCP = O_RS + (size_t)DEPTH * NS * 4 * 64 * 128;
constexpr size_t O_SCS = O_SCP + (size_t)DEPTH * NB * 3 * 1024;
constexpr size_t O_SP = O_SCS + (size_t)DEPTH * NS * 3 * 1024;
constexpr size_t O_SS = O_SP + (size_t)DEPTH * NB * 8 * 64 * 128;
constexpr size_t O_FCP = O_SS + (size_t)DEPTH * NS * 8 * 64 * 128;
constexpr size_t O_FCS = O_FCP + (size_t)DEPTH * NB * 2 * DFF;

constexpr size_t W_WIN = 0;
constexpr size_t W_WOUT = W_WIN + (size_t)DEPTH * NPROJ * DM * 2;
constexpr size_t W_WUP = W_WOUT + (size_t)DEPTH * DM * DMIX * 2;
constexpr size_t W_WDOWN = W_WUP + (size_t)DEPTH * DGU * DM * 2;
constexpr size_t W_LRUW = W_WDOWN + (size_t)DEPTH * DM * DFF * 2;
constexpr size_t W_ROPE = W_LRUW + (size_t)2 * DEPTH * 8 * 64 * 64 * 2;
constexpr size_t W_DT = W_ROPE + 524800;
constexpr size_t W_LRUAB = W_DT + (size_t)TT * 8 * 4;
constexpr size_t W_LRUHIN = W_LRUAB + (size_t)NB * NCH * 512 * 2 * 4;
constexpr size_t W_DEC = W_LRUHIN + (size_t)NB * NCH * 512 * 4;
constexpr size_t W_RSS = W_DEC + 8192;
constexpr size_t W_WDT = W_RSS + (size_t)9 * TT * 8;
constexpr size_t W_HB = W_WDT + (size_t)DEPTH * 16 * DM * 2;
constexpr size_t W_XB = W_HB + (size_t)TT * DMIX * 2;
constexpr size_t W_PROJ = W_XB + (size_t)TT * DM * 2;
constexpr size_t W_SPR = W_PROJ + (size_t)TT * NPROJ * 2;
constexpr size_t W_SPS = W_SPR + (size_t)NB * 4 * NCH * 8192 * 2;
static_assert(W_SPS + (size_t)NB * 8 * NCH * 8192 * 2 <= W_PROJ + (size_t)TT * DGU * 2, "Sp does not fit behind proj");
constexpr size_t W_DS = W_PROJ + (size_t)TT * DGU * 2;
constexpr size_t W_DSSSD = W_DS + (size_t)NB * 4 * NCH * 8192 * 4;
constexpr size_t W_BAR = W_DSSSD + (size_t)NB * 8 * NCH * 8192 * 4;
constexpr size_t W_GS01 = W_BAR + 16384;
constexpr size_t W_US01 = W_GS01 + (size_t)256 * 2 * DFF * 2;
constexpr size_t W_GS23 = W_US01 + (size_t)256 * 2 * DFF * 2;
constexpr size_t W_END = W_GS23 + (size_t)256 * 2 * DFF * 2;
static_assert(W_END <= (size_t)512 * 1024 * 1024, "workspace budget");
constexpr int LDS_BYTES = 131072;

struct Params { const float* in[31]; float* out; unsigned char* ws; };

typedef unsigned long long u64;
__device__ __forceinline__ u64 ss_fix(float ss) { return (u64)(ss * 1048576.f + 0.5f); }
__device__ __forceinline__ float rstd_fix(u64 v) { return rsqrtf((float)v * (1.f / (1048576.f * 1024.f)) + 1e-6f); }
__device__ __forceinline__ int opaque_tid() { int t = threadIdx.x; asm volatile("" : "+v"(t)); return t; }
#define TIDX opaque_tid()
__device__ __forceinline__ float bf2f(bf16_t v) { return __uint_as_float(((unsigned)v) << 16); }
__device__ __forceinline__ unsigned pk2(float lo, float hi) { unsigned r; asm volatile("v_cvt_pk_bf16_f32 %0, %1, %2" : "=v"(r) : "v"(lo), "v"(hi)); return r; }
__device__ __forceinline__ bf16_t f2bf(float f) { return (bf16_t)(pk2(f, 0.f) & 0xffffu); }
__device__ __forceinline__ void unpack8(u32x4 w, float* f) {
    f[0] = __uint_as_float(w.x << 16); f[1] = __uint_as_float(w.x & 0xffff0000u);
    f[2] = __uint_as_float(w.y << 16); f[3] = __uint_as_float(w.y & 0xffff0000u);
    f[4] = __uint_as_float(w.z << 16); f[5] = __uint_as_float(w.z & 0xffff0000u);
    f[6] = __uint_as_float(w.w << 16); f[7] = __uint_as_float(w.w & 0xffff0000u);
}
__device__ __forceinline__ void unpack4(u32x2 w, float* f) {
    f[0] = __uint_as_float(w.x << 16); f[1] = __uint_as_float(w.x & 0xffff0000u);
    f[2] = __uint_as_float(w.y << 16); f[3] = __uint_as_float(w.y & 0xffff0000u);
}
__device__ __forceinline__ u32x4 pack8(const float* f) { u32x4 w; w.x = pk2(f[0], f[1]); w.y = pk2(f[2], f[3]); w.z = pk2(f[4], f[5]); w.w = pk2(f[6], f[7]); return w; }
__device__ __forceinline__ float fexp_(float x) { return __builtin_amdgcn_exp2f(x * 1.44269504089f); }
__device__ __forceinline__ float sigmoidf_(float x) { return __builtin_amdgcn_rcpf(1.f + fexp_(-x)); }
__device__ __forceinline__ float siluf_(float x) { return x * __builtin_amdgcn_rcpf(1.f + fexp_(-x)); }
__device__ __forceinline__ float geluf_(float x) { const float u = 0.7978845608028654f * (x + 0.044715f * x * x * x); return x * (1.f - __builtin_amdgcn_rcpf(1.f + fexp_(2.f * u))); }
__device__ __forceinline__ float softplusf_(float x) { return x > 20.f ? x : log1pf(fexp_(x)); }
__device__ __forceinline__ float shfl_idx(float v, int src) { return __int_as_float(__builtin_amdgcn_ds_bpermute(src << 2, __float_as_int(v))); }
__device__ __forceinline__ float shfl_xor_(float v, int o, int lane) { return shfl_idx(v, lane ^ o); }
__device__ __forceinline__ float shfl_up_(float v, int o, int lane) { return shfl_idx(v, (lane - o) & 63); }
__device__ __forceinline__ float wave_sum(float v, int lane) {
#pragma unroll
    for (int o = 32; o >= 1; o >>= 1) v += shfl_xor_(v, o, lane);
    return v;
}
template <int N> __device__ __forceinline__ float dpp_shr(float old, float src) { return __int_as_float(__builtin_amdgcn_update_dpp(__float_as_int(old), __float_as_int(src), 0x110 + N, 0xf, 0xf, false)); }
template <int N> __device__ __forceinline__ float dpp_ror(float src) { return __int_as_float(__builtin_amdgcn_update_dpp(0, __float_as_int(src), 0x120 + N, 0xf, 0xf, false)); }
__device__ __forceinline__ bf16x8 frag_row(const LAS bf16_t* t, int ld, int r0, int k0, int fr, int fq) {
    return *(const LAS bf16x8*)(t + (r0 + fr) * ld + k0 + 8 * fq);
}
__device__ __forceinline__ bf16x8 frag_tr(const LAS bf16_t* t, int ld, int k0, int c0, int fr, int fq) {
    const LAS bf16_t* p = t + (k0 + 8 * fq + (fr >> 2)) * ld + c0 + 4 * (fr & 3);
    s16x4 lo = __builtin_bit_cast(s16x4, __builtin_amdgcn_ds_read_tr16_b64_v4i16((LAS s16x4*)p));
    s16x4 hi = __builtin_bit_cast(s16x4, __builtin_amdgcn_ds_read_tr16_b64_v4i16((LAS s16x4*)(p + 4 * ld)));
    bf16x8 r; r[0] = lo[0]; r[1] = lo[1]; r[2] = lo[2]; r[3] = lo[3]; r[4] = hi[0]; r[5] = hi[1]; r[6] = hi[2]; r[7] = hi[3]; return r;
}
#define MFMA(X, Y, C) __builtin_amdgcn_mfma_f32_16x16x32_bf16((X), (Y), (C), 0, 0, 0)

namespace pg8 {
constexpr int BM = 256, BK = 64, HALF = 128, HTB = HALF * BK * 2, NXCD = 8, WGM = 8;
__device__ __forceinline__ int lds_byte(int r, int c) { const int st = (r >> 4) * 2 + (c >> 5), rr = r & 15, cc = c & 31, ob = rr * 64 + cc * 2; return st * 1024 + (ob ^ (((ob >> 9) & 1) << 5)); }
__device__ __forceinline__ void stage_rc(int b, int& R, int& C) { const int st = b / 1024, sb = b % 1024, swz = sb ^ (((sb >> 9) & 1) << 5); R = (st >> 1) * 16 + swz / 64; C = (st & 1) * 32 + (swz % 64) / 2; }
__device__ __forceinline__ int perm32(int rho) { const int n = rho >> 4, i = rho & 15; return 8 * (i >> 2) + 4 * n + (i & 3); }
struct Unit { int pm, pn; };
struct Gemm { const bf16_t* A; const bf16_t* Bt; int M, N, K; };
struct StaticOrder {
    int nM, nN, nwg, G, c;
    __device__ void init(int M, int N, int G_, int c_) { nM = M / BM; nN = N / BM; nwg = nM * nN; G = G_; c = c_; }
    __device__ bool next(int i, Unit& u) const {
        const long L = (long)i * G + c; if (L >= nwg) return false;
        int wgid = (int)L; { const int q = nwg / NXCD, r = nwg % NXCD, xcd = wgid % NXCD, off = wgid / NXCD; wgid = (xcd < r ? xcd * (q + 1) : r * (q + 1) + (xcd - r) * q) + off; }
        const int nig = WGM * nN, gid = wgid / nig, fm = gid * WGM, gsz = (nM - fm) < WGM ? (nM - fm) : WGM;
        u.pm = fm + ((wgid % nig) % gsz); u.pn = (wgid % nig) / gsz; return true;
    }
};
template <class Epi>
__device__ __forceinline__ void gemm_phase(LAS unsigned char* lds, const Gemm g, const StaticOrder& S, const Epi& E) {
    const int tid = TIDX, wid = __builtin_amdgcn_readfirstlane(tid >> 6), lane = tid & 63, wr = wid >> 2, wc = wid & 3, fr = lane & 15, fq = lane >> 4;
    const int K = g.K, nt = K / BK;
    unsigned voffA[2], voffB[2];
#pragma unroll
    for (int i = 0; i < 2; ++i) { int R, C; stage_rc(tid * 16 + i * 8192, R, C); const int Rb = Epi::PERM ? ((R & ~31) + perm32(R & 31)) : R;
        voffA[i] = (unsigned)(R * K + C) * 2u; voffB[i] = (unsigned)(Rb * K + C) * 2u; }
    const size_t kstep = (size_t)(BK * 2);
    const size_t hstep = (size_t)HALF * K * 2;
    const size_t tstep = 2 * hstep;
    const unsigned ldsw = (unsigned)wid * 1024u;
    const int aoff = lds_byte(wr * 64 + fr, fq * 8), boff = lds_byte(wc * 32 + fr, fq * 8);
#define PG8_SA(b, h) (((b) * 2 + (h)) * HTB)
#define PG8_SB(b, h) ((4 + (b) * 2 + (h)) * HTB)
#define PG8_STAGE(bufoff, gbase, voff) do { _Pragma("unroll") for (int _i = 0; _i < 2; ++_i) \
        __builtin_amdgcn_global_load_lds((const unsigned*)((const char*)(gbase) + (voff)[_i]), (LAS unsigned*)(lds + (bufoff) + ldsw + _i * 8192), 16, 0, 0); } while (0)
#define PG8_LDA(dst, b, h) do { _Pragma("unroll") for (int m = 0; m < 4; ++m) _Pragma("unroll") for (int k = 0; k < 2; ++k) dst[m][k] = *(const LAS bf16x8*)(lds + PG8_SA(b, h) + aoff + m * 2048 + k * 1024); } while (0)
#define PG8_LDB(dst, b, h) do { _Pragma("unroll") for (int n = 0; n < 2; ++n) _Pragma("unroll") for (int k = 0; k < 2; ++k) dst[n][k] = *(const LAS bf16x8*)(lds + PG8_SB(b, h) + boff + n * 2048 + k * 1024); } while (0)
#define PG8_MMA(ai, bj, At, Bt) do { __builtin_amdgcn_s_setprio(1); _Pragma("unroll") for (int m = 0; m < 4; ++m) _Pragma("unroll") for (int n = 0; n < 2; ++n) _Pragma("unroll") for (int k = 0; k < 2; ++k) \
        acc[ai][bj][m][n] = __builtin_amdgcn_mfma_f32_16x16x32_bf16(Bt[n][k], At[m][k], acc[ai][bj][m][n], 0, 0, 0); __builtin_amdgcn_s_setprio(0); } while (0)
#define PG8_WAIT_V(n) asm volatile("s_waitcnt vmcnt(" #n ")" ::: "memory")
#define PG8_WAIT_L(n) asm volatile("s_waitcnt lgkmcnt(" #n ")" ::: "memory")
#define PG8_BAR __builtin_amdgcn_s_barrier()
#define PG8_SCHED __builtin_amdgcn_sched_barrier(0)
    Unit cur, nxt; int ui = 0;
    if (!S.next(0, cur)) return;
    f32x4 acc[2][2][4][2];
#pragma unroll
    for (int a = 0; a < 2; ++a)
#pragma unroll
        for (int b = 0; b < 2; ++b)
#pragma unroll
            for (int m = 0; m < 4; ++m)
#pragma unroll
                for (int n = 0; n < 2; ++n) acc[a][b][m][n] = (f32x4){0.f, 0.f, 0.f, 0.f};
    bf16x8 At[4][2], B0[2][2], B1[2][2];
    const char* cA = (const char*)g.A + (size_t)cur.pm * tstep; const char* cB = (const char*)g.Bt + (size_t)cur.pn * tstep;
    PG8_STAGE(PG8_SB(0, 0), cB, voffB); PG8_STAGE(PG8_SA(0, 0), cA, voffA); PG8_STAGE(PG8_SB(0, 1), cB + hstep, voffB); PG8_STAGE(PG8_SA(0, 1), cA + hstep, voffA);
    if (wr == 1) PG8_BAR;
    PG8_WAIT_V(4); PG8_BAR;
    PG8_STAGE(PG8_SB(1, 0), cB + kstep, voffB); PG8_STAGE(PG8_SA(1, 0), cA + kstep, voffA); PG8_STAGE(PG8_SB(1, 1), cB + hstep + kstep, voffB);
    PG8_WAIT_V(6); PG8_BAR;
    for (;;) {
        const bool has_next = S.next(ui + 1, nxt);
        const char* nA = has_next ? (const char*)g.A + (size_t)nxt.pm * tstep : cA; const char* nB = has_next ? (const char*)g.Bt + (size_t)nxt.pn * tstep : cB;
        for (int t = 0; t < nt; t += 2) {
            const bool last = (t == nt - 2);
            const char* a1 = cA + (size_t)(t + 1) * kstep;
            const char* a2 = last ? nA : cA + (size_t)(t + 2) * kstep; const char* b2 = last ? nB : cB + (size_t)(t + 2) * kstep;
            const char* a3 = a2 + kstep; const char* b3 = b2 + kstep;
            PG8_LDB(B0, 0, 0); PG8_SCHED; PG8_LDA(At, 0, 0); PG8_STAGE(PG8_SA(1, 1), a1 + hstep, voffA);
            PG8_WAIT_L(8); PG8_BAR; PG8_WAIT_L(0); PG8_MMA(0, 0, At, B0); PG8_BAR; PG8_SCHED;
            PG8_LDB(B1, 0, 1); PG8_STAGE(PG8_SB(0, 0), b2, voffB);
            PG8_BAR; PG8_WAIT_L(0); PG8_MMA(0, 1, At, B1); PG8_BAR;
            PG8_LDA(At, 0, 1); PG8_STAGE(PG8_SA(0, 0), a2, voffA);
            PG8_BAR; PG8_WAIT_L(0); PG8_MMA(1, 0, At, B0); PG8_BAR; PG8_SCHED;
            PG8_STAGE(PG8_SB(0, 1), b2 + hstep, voffB);
            PG8_WAIT_V(6); PG8_BAR; PG8_MMA(1, 1, At, B1); PG8_BAR;
            PG8_LDB(B0, 1, 0); PG8_SCHED; PG8_LDA(At, 1, 0); PG8_STAGE(PG8_SA(0, 1), a2 + hstep, voffA);
            PG8_WAIT_L(8); PG8_BAR; PG8_WAIT_L(0); PG8_MMA(0, 0, At, B0); PG8_BAR; PG8_SCHED;
            PG8_LDB(B1, 1, 1); PG8_STAGE(PG8_SB(1, 0), b3, voffB);
            PG8_BAR; PG8_WAIT_L(0); PG8_MMA(0, 1, At, B1); PG8_BAR;
            PG8_LDA(At, 1, 1); PG8_STAGE(PG8_SA(1, 0), a3, voffA);
            PG8_BAR; PG8_WAIT_L(0); PG8_MMA(1, 0, At, B0); PG8_BAR; PG8_SCHED;
            PG8_STAGE(PG8_SB(1, 1), b3 + hstep, voffB);
            PG8_WAIT_V(6); PG8_BAR; PG8_MMA(1, 1, At, B1); PG8_BAR;
        }
        if constexpr (Epi::AFTER_DRAIN) { if (has_next) E(acc, cur, wr, wc, fr, fq); } else E(acc, cur, wr, wc, fr, fq);
        if (!has_next) break;
#pragma unroll
        for (int a = 0; a < 2; ++a)
#pragma unroll
            for (int b = 0; b < 2; ++b)
#pragma unroll
                for (int m = 0; m < 4; ++m)
#pragma unroll
                    for (int n = 0; n < 2; ++n) acc[a][b][m][n] = (f32x4){0.f, 0.f, 0.f, 0.f};
        cur = nxt; cA = nA; cB = nB; ++ui;
    }
    PG8_WAIT_V(0);
    if (wr == 0) PG8_BAR;
    PG8_BAR;
    if constexpr (Epi::AFTER_DRAIN) E.fused(acc, cur, wr, wc, fr, fq, lds, wid, lane);
#undef PG8_SA
#undef PG8_SB
#undef PG8_STAGE
#undef PG8_LDA
#undef PG8_LDB
#undef PG8_MMA
#undef PG8_WAIT_V
#undef PG8_WAIT_L
#undef PG8_BAR
#undef PG8_SCHED
}
struct EpiBf16 {
    static constexpr bool PERM = true, AFTER_DRAIN = false;
    bf16_t* O; int ldc; const u64* rss;
    __device__ __forceinline__ void operator()(const f32x4 (&acc)[2][2][4][2], const Unit& u, int wr, int wc, int fr, int fq) const {
        const int row0 = u.pm * BM + wr * 64 + fr, col0 = u.pn * BM + wc * 32 + 8 * fq;
        u64 rv[2][4];
#pragma unroll
        for (int ai = 0; ai < 2; ++ai)
#pragma unroll
            for (int m = 0; m < 4; ++m) rv[ai][m] = rss[row0 + ai * HALF + m * 16];
#pragma unroll
        for (int ai = 0; ai < 2; ++ai)
#pragma unroll
            for (int m = 0; m < 4; ++m) { const int row = row0 + ai * HALF + m * 16; bf16_t* rowp = O + (size_t)row * ldc + col0;
                const float rs = rstd_fix(rv[ai][m]);
#pragma unroll
                for (int bj = 0; bj < 2; ++bj) { const f32x4 v0 = acc[ai][bj][m][0] * rs, v1 = acc[ai][bj][m][1] * rs;
                    u32x4 w; w.x = pk2(v0[0], v0[1]); w.y = pk2(v0[2], v0[3]); w.z = pk2(v1[0], v1[1]); w.w = pk2(v1[2], v1[3]);
                    *(u32x4*)(rowp + bj * HALF) = w; } }
    }
};
struct EpiResid {
    static constexpr bool PERM = false, AFTER_DRAIN = true;
    int ldc; bf16_t* xb; u64* rss;
    __device__ __forceinline__ void operator()(const f32x4 (&acc)[2][2][4][2], const Unit& u, int wr, int wc, int fr, int fq) const {
        const int row0 = u.pm * BM + wr * 64 + fr, col0 = u.pn * BM + wc * 32 + 4 * fq, lane = fr | (fq << 4);
#pragma unroll
        for (int ai = 0; ai < 2; ++ai)
#pragma unroll
            for (int m = 0; m < 4; ++m) { const int row = row0 + ai * HALF + m * 16; bf16_t* xbp = xb + (size_t)row * ldc + col0;
                float ss = 0.f;
#pragma unroll
                for (int bj = 0; bj < 2; ++bj)
#pragma unroll
                    for (int n = 0; n < 2; ++n) { u32x2* pp = (u32x2*)(xbp + bj * HALF + n * 16); float o[4]; unpack4(*pp, o);
                        u32x2 w; w.x = pk2(o[0] + acc[ai][bj][m][n][0], o[1] + acc[ai][bj][m][n][1]); w.y = pk2(o[2] + acc[ai][bj][m][n][2], o[3] + acc[ai][bj][m][n][3]); *pp = w;
                        unpack4(w, o); ss += o[0] * o[0] + o[1] * o[1] + o[2] * o[2] + o[3] * o[3]; }
                ss += shfl_xor_(ss, 16, lane); ss += shfl_xor_(ss, 32, lane);
                if (fq == 0) atomicAdd(rss + row, ss_fix(ss)); }
    }
    __device__ __forceinline__ void fused(const f32x4 (&acc)[2][2][4][2], const Unit& u, int wr, int wc, int fr, int fq, LAS unsigned char* lds, int wid, int lane) const {
        LAS f32x4* t = (LAS f32x4*)lds;
#pragma unroll
        for (int ai = 0; ai < 2; ++ai) {
            const int rbase = u.pm * BM + ai * HALF + wid * 16, col = u.pn * BM + lane * 4;
            u32x2 xv[16];
#pragma unroll
            for (int i = 0; i < 16; ++i) xv[i] = *(const u32x2*)(xb + (size_t)(rbase + i) * ldc + col);
#pragma unroll
            for (int m = 0; m < 4; ++m)
#pragma unroll
                for (int bj = 0; bj < 2; ++bj)
#pragma unroll
                    for (int n = 0; n < 2; ++n) { const int r = 64 * wr + 16 * m + fr, chunk = 32 * bj + 8 * wc + 4 * n + fq; t[r * 64 + (chunk ^ (r & 15))] = acc[ai][bj][m][n]; }
            __syncthreads();
            float myss = 0.f;
#pragma unroll
            for (int i = 0; i < 16; ++i) { const int r = wid * 16 + i;
                const f32x4 a = t[r * 64 + (lane ^ (r & 15))]; float o[4]; unpack4(xv[i], o);
                u32x2 w; w.x = pk2(o[0] + a[0], o[1] + a[1]); w.y = pk2(o[2] + a[2], o[3] + a[3]); *(u32x2*)(xb + (size_t)(rbase + i) * ldc + col) = w;
                unpack4(w, o);
                const float ss = wave_sum(o[0] * o[0] + o[1] * o[1] + o[2] * o[2] + o[3] * o[3], lane);
                if (lane == i) myss = ss; }
            if (lane < 16) atomicAdd(rss + rbase + lane, ss_fix(myss));
            __syncthreads();
        }
    }
};
struct EpiAct {
    static constexpr bool PERM = true, AFTER_DRAIN = false;
    bf16_t* act; const u64* rss; const float* cw; const float* cb; bf16_t* gs01; bf16_t* us01; bf16_t* gs23; float* fcp;
    __device__ __forceinline__ void operator()(const f32x4 (&acc)[2][2][4][2], const Unit& u, int wr, int wc, int fr, int fq) const {
        const int row0 = u.pm * BM + wr * 64 + fr, f0 = u.pn * HALF + wc * 32 + 8 * fq;
        float w0[8], w1[8], w2[8], bb[8];
        *(f32x4*)w0 = *(const f32x4*)(cw + f0); *(f32x4*)(w0 + 4) = *(const f32x4*)(cw + f0 + 4);
        *(f32x4*)w1 = *(const f32x4*)(cw + DFF + f0); *(f32x4*)(w1 + 4) = *(const f32x4*)(cw + DFF + f0 + 4);
        *(f32x4*)w2 = *(const f32x4*)(cw + 2 * DFF + f0); *(f32x4*)(w2 + 4) = *(const f32x4*)(cw + 2 * DFF + f0 + 4);
        *(f32x4*)bb = *(const f32x4*)(cb + f0); *(f32x4*)(bb + 4) = *(const f32x4*)(cb + f0 + 4);
        u64 rv[2][4];
#pragma unroll
        for (int ai = 0; ai < 2; ++ai)
#pragma unroll
            for (int m = 0; m < 4; ++m) rv[ai][m] = rss[row0 + ai * HALF + m * 16];
#pragma unroll
        for (int ai = 0; ai < 2; ++ai) {
            float gp[8];
#pragma unroll
            for (int e = 0; e < 8; ++e) gp[e] = 0.f;
#pragma unroll
            for (int m = 0; m < 4; ++m) {
                const int row = row0 + ai * HALF + m * 16;
                const float rs = rstd_fix(rv[ai][m]);
                float g[8], up[8], o[8];
#pragma unroll
                for (int e = 0; e < 8; ++e) { g[e] = acc[ai][0][m][e >> 2][e & 3] * rs; up[e] = acc[ai][1][m][e >> 2][e & 3] * rs; }
#pragma unroll
                for (int e = 0; e < 8; ++e) {
                    const float g1 = dpp_shr<1>(dpp_ror<1>(gp[e]), g[e]);
                    const float g2 = dpp_shr<2>(dpp_ror<2>(gp[e]), g[e]);
                    const float y = bb[e] + w0[e] * g2 + w1[e] * g1 + w2[e] * g[e];
                    o[e] = geluf_(y) * up[e];
                }
                if (m == 0 && fr < 2) {
                    const size_t so = ((size_t)(row >> 6) * 2 + fr) * DFF + f0;
                    *(u32x4*)(gs01 + so) = pack8(g); *(u32x4*)(us01 + so) = pack8(up);
                } else *(u32x4*)(act + (size_t)row * DFF + f0) = pack8(o);
                if (m == 3 && fr >= 14) *(u32x4*)(gs23 + ((size_t)(row >> 6) * 2 + (fr - 14)) * DFF + f0) = pack8(g);
                const int ts = row & (SEQ - 1);
                if (ts >= SEQ - 2) { float* fo = fcp + ((size_t)(row >> 11) * 2 + (ts - (SEQ - 2))) * DFF + f0;
                    *(f32x4*)fo = (f32x4){g[0], g[1], g[2], g[3]}; *(f32x4*)(fo + 4) = (f32x4){g[4], g[5], g[6], g[7]}; }
#pragma unroll
                for (int e = 0; e < 8; ++e) gp[e] = g[e];
            }
        }
    }
};
struct EpiDry {
    static constexpr bool PERM = false, AFTER_DRAIN = false;
    float* C;
    __device__ __forceinline__ void operator()(const f32x4 (&acc)[2][2][4][2], const Unit& u, int wr, int wc, int fr, int fq) const {
        float s = 0.f;
#pragma unroll
        for (int ai = 0; ai < 2; ++ai)
#pragma unroll
            for (int bj = 0; bj < 2; ++bj)
#pragma unroll
                for (int m = 0; m < 4; ++m)
#pragma unroll
                    for (int n = 0; n < 2; ++n) s += acc[ai][bj][m][n][0] + acc[ai][bj][m][n][1] + acc[ai][bj][m][n][2] + acc[ai][bj][m][n][3];
        if (s != s) C[0] = s;
    }
};
}

template <int K, int MODE  >
__device__ __forceinline__ void thin_gemm(LAS unsigned char* lds, const bf16_t* A, const bf16_t* Bt, int N, void* out, int ldc, bf16_t* xb, u64* rss) {
    const int tid = TIDX, wid = tid >> 6, lane = tid & 63, fr = lane & 15, fq = lane >> 4;
    constexpr int KW = K / 8, STEPS = KW / 32;
    const int ntask = (N / 16) * 8;
    LAS f32x4* red = (LAS f32x4*)lds;
    const int per = (ntask + (int)gridDim.x - 1) / (int)gridDim.x, t0 = blockIdx.x * per, t1 = min(ntask, t0 + per);
    for (int base = t0; base < t1; base += 8) {
        const int nr = min(8, t1 - base);
#pragma unroll (STEPS <= 4 ? 4 : 2)
        for (int i = 0; i < nr; ++i) {
            const int t = base + i, ct = t >> 3, rt = t & 7;
            const bf16_t* ap = A + (size_t)(rt * 16 + fr) * K + wid * KW + 8 * fq;
            const bf16_t* bp = Bt + (size_t)(ct * 16 + fr) * K + wid * KW + 8 * fq;
            bf16x8 a[STEPS], b[STEPS];
#pragma unroll
            for (int s = 0; s < STEPS; ++s) { a[s] = *(const bf16x8*)(ap + 32 * s); b[s] = *(const bf16x8*)(bp + 32 * s); }
            f32x4 acc = {0.f, 0.f, 0.f, 0.f};
#pragma unroll
            for (int s = 0; s < STEPS; ++s) acc = MFMA(b[s], a[s], acc);
            red[(i * 8 + wid) * 64 + lane] = acc;
        }
        __syncthreads();
        if (wid < nr) {
            const int t = base + wid, ct = t >> 3, rt = t & 7;
            f32x4 s = red[(wid * 8) * 64 + lane];
#pragma unroll
            for (int w = 1; w < 8; ++w) s = s + red[(wid * 8 + w) * 64 + lane];
            const int row = rt * 16 + fr, col = ct * 16 + 4 * fq;
            if (MODE == 0) { const float rs = rstd_fix(rss[row]);
                u32x2 w2; w2.x = pk2(s[0] * rs, s[1] * rs); w2.y = pk2(s[2] * rs, s[3] * rs); *(u32x2*)((bf16_t*)out + (size_t)row * ldc + col) = w2; }
            else { u32x2* pp = (u32x2*)(xb + (size_t)row * ldc + col); float o[4]; unpack4(*pp, o);
                u32x2 w2; w2.x = pk2(o[0] + s[0], o[1] + s[1]); w2.y = pk2(o[2] + s[2], o[3] + s[3]); *pp = w2;
                unpack4(w2, o);
                float ss = o[0] * o[0] + o[1] * o[1] + o[2] * o[2] + o[3] * o[3];
                ss += shfl_xor_(ss, 16, lane); ss += shfl_xor_(ss, 32, lane);
                if (fq == 0) atomicAdd(rss + row, ss_fix(ss)); }
        }
        __syncthreads();
    }
}

__device__ __forceinline__ void thin_gemm_act(LAS unsigned char* lds, const bf16_t* A, const bf16_t* Bt, const u64* rss, const float* cw, const float* cb, const float* st, float* fo, bf16_t* act, int c0, int cnt) {
    const int tid = TIDX, wid = tid >> 6, lane = tid & 63, fr = lane & 15, fq = lane >> 4;
    constexpr int K = DM, KW = K / 8, STEPS = KW / 32;
    const int ntask = (DFF / 16) * 8;
    LAS f32x4* red = (LAS f32x4*)lds;
    if ((int)blockIdx.x < c0) return;
    const int per = (ntask + cnt - 1) / cnt, t0 = ((int)blockIdx.x - c0) * per, t1 = min(ntask, t0 + per);
    for (int base = t0; base < t1; base += 8) {
        const int nr = min(8, t1 - base);
#pragma unroll 2
        for (int i = 0; i < nr; ++i) {
            const int t = base + i, ft = t >> 3, rt = t & 7;
            const int f = ft * 16 + fr, wrow = 256 * (f >> 7) + (f & 127);
            const bf16_t* ap = A + (size_t)(rt * 16 + fr) * K + wid * KW + 8 * fq;
            const bf16_t* bg = Bt + (size_t)wrow * K + wid * KW + 8 * fq;
            const bf16_t* bu = bg + (size_t)128 * K;
            bf16x8 a[STEPS], b1[STEPS], b2[STEPS];
#pragma unroll
            for (int s = 0; s < STEPS; ++s) { a[s] = *(const bf16x8*)(ap + 32 * s); b1[s] = *(const bf16x8*)(bg + 32 * s); b2[s] = *(const bf16x8*)(bu + 32 * s); }
            f32x4 ag = {0.f, 0.f, 0.f, 0.f}, au = {0.f, 0.f, 0.f, 0.f};
#pragma unroll
            for (int s = 0; s < STEPS; ++s) { ag = MFMA(b1[s], a[s], ag); au = MFMA(b2[s], a[s], au); }
            red[(i * 8 + wid) * 64 + lane] = ag; red[4096 + (i * 8 + wid) * 64 + lane] = au;
        }
        __syncthreads();
        if (wid < nr) {
            const int t = base + wid, ft = t >> 3, rt = t & 7;
            f32x4 g = red[(wid * 8) * 64 + lane], up = red[4096 + (wid * 8) * 64 + lane];
#pragma unroll
            for (int w = 1; w < 8; ++w) { g = g + red[(wid * 8 + w) * 64 + lane]; up = up + red[4096 + (wid * 8 + w) * 64 + lane]; }
            const int s = rt * 16 + fr, f = ft * 16 + 4 * fq;
            const float rs = rstd_fix(rss[s]);
            g = g * rs; up = up * rs;
            const f32x4 p0 = *(const f32x4*)(st + ((size_t)s * 2 + 0) * DFF + f), p1 = *(const f32x4*)(st + ((size_t)s * 2 + 1) * DFF + f);
            const f32x4 c0 = *(const f32x4*)(cw + f), c1 = *(const f32x4*)(cw + DFF + f), c2 = *(const f32x4*)(cw + 2 * DFF + f), cbv = *(const f32x4*)(cb + f);
            float o[4];
#pragma unroll
            for (int e = 0; e < 4; ++e) o[e] = geluf_(cbv[e] + c0[e] * p0[e] + c1[e] * p1[e] + c2[e] * g[e]) * up[e];
            u32x2 w2; w2.x = pk2(o[0], o[1]); w2.y = pk2(o[2], o[3]); *(u32x2*)(act + (size_t)s * DFF + f) = w2;
            *(f32x4*)(fo + ((size_t)s * 2 + 0) * DFF + f) = p1; *(f32x4*)(fo + ((size_t)s * 2 + 1) * DFF + f) = g;
        }
        __syncthreads();
    }
}
__device__ __forceinline__ void act_fixup(const Params& p, int l, int pm) {
    const bf16_t* gs01 = (const bf16_t*)(p.ws + W_GS01); const bf16_t* us01 = (const bf16_t*)(p.ws + W_US01); const bf16_t* gs23 = (const bf16_t*)(p.ws + W_GS23);
    bf16_t* act = (bf16_t*)(p.ws + W_DS);
    const float* cw = p.in[27] + (size_t)l * 3 * DFF; const float* cb = p.in[28] + (size_t)l * DFF;
    const int tid = TIDX;
    constexpr int NU = 8 * (DFF / 8), NK = (NU + 511) / 512;
    u32x4 rg[NK], ru[NK], r1[NK], r2[NK];
#pragma unroll
    for (int k = 0; k < NK; ++k) {
        const int idx = tid + 512 * k;
        rg[k] = ru[k] = r1[k] = r2[k] = (u32x4){0u, 0u, 0u, 0u};
        if (idx < NU) {
            const int rsel = idx / (DFF / 8), c0 = (idx % (DFF / 8)) * 8, blk = pm * 4 + (rsel >> 1), rr = rsel & 1;
            const bool seq0 = (blk & 31) == 0;
            rg[k] = *(const u32x4*)(gs01 + ((size_t)blk * 2 + rr) * DFF + c0);
            ru[k] = *(const u32x4*)(us01 + ((size_t)blk * 2 + rr) * DFF + c0);
            if (rr == 0) { if (!seq0) { r1[k] = *(const u32x4*)(gs23 + ((size_t)(blk - 1) * 2 + 1) * DFF + c0); r2[k] = *(const u32x4*)(gs23 + ((size_t)(blk - 1) * 2 + 0) * DFF + c0); } }
            else { r1[k] = *(const u32x4*)(gs01 + ((size_t)blk * 2 + 0) * DFF + c0); if (!seq0) r2[k] = *(const u32x4*)(gs23 + ((size_t)(blk - 1) * 2 + 1) * DFF + c0); }
        }
    }
#pragma unroll
    for (int k = 0; k < NK; ++k) {
        const int idx = tid + 512 * k;
        if (idx < NU) {
            const int rsel = idx / (DFF / 8), c0 = (idx % (DFF / 8)) * 8, blk = pm * 4 + (rsel >> 1), rr = rsel & 1;
            float g[8], up[8], g1[8], g2[8], o[8];
            unpack8(rg[k], g); unpack8(ru[k], up); unpack8(r1[k], g1); unpack8(r2[k], g2);
#pragma unroll
            for (int e = 0; e < 8; ++e) o[e] = geluf_(cb[c0 + e] + cw[c0 + e] * g2[e] + cw[DFF + c0 + e] * g1[e] + cw[2 * DFF + c0 + e] * g[e]) * up[e];
            *(u32x4*)(act + ((size_t)blk * 64 + rr) * DFF + c0) = pack8(o);
        }
    }
}

constexpr int TILES_L = 3520;
constexpr int SLACK_TILES = 12;
template <class MAP>
__device__ __forceinline__ void convert_tiles(const Params& p, LAS unsigned char* lds, int first_grp, int ngrp, int stride, MAP&& map) {
    const int tid = TIDX;
    LAS float* tl = (LAS float*)lds;
    for (int grp = first_grp; grp < ngrp; grp += stride) {
        const float* src[4]; bf16_t* dst[4]; int Ks[4], ldns[4]; const float* gs[4];
        f32x4 v[4][2];
#pragma unroll
        for (int q = 0; q < 4; ++q) {
            const int idx = map(grp * 4 + q);
            const int l = idx / TILES_L; int r = idx % TILES_L;
            int kt, nt;
            if (r < 1024) { gs[q] = p.in[8] + l * DM; src[q] = p.in[9] + (size_t)l * DM * DIN; ldns[q] = DIN; Ks[q] = DM; dst[q] = (bf16_t*)(p.ws + W_WIN) + (size_t)l * NPROJ * DM; nt = r % 64; kt = r / 64; }
            else if (r < 1408) { r -= 1024; gs[q] = nullptr; src[q] = p.in[24] + (size_t)l * DMIX * DM; ldns[q] = DM; Ks[q] = DMIX; dst[q] = (bf16_t*)(p.ws + W_WOUT) + (size_t)l * DM * DMIX; nt = r % 16; kt = r / 16; }
            else if (r < 2816) { r -= 1408; gs[q] = p.in[25] + l * DM; src[q] = p.in[26] + (size_t)l * DM * DGU; ldns[q] = DGU; Ks[q] = DM; dst[q] = (bf16_t*)(p.ws + W_WUP) + (size_t)l * DGU * DM; nt = r % 88; kt = r / 88; }
            else { r -= 2816; gs[q] = nullptr; src[q] = p.in[29] + (size_t)l * DFF * DM; ldns[q] = DM; Ks[q] = DFF; dst[q] = (bf16_t*)(p.ws + W_WDOWN) + (size_t)l * DM * DFF; nt = r % 16; kt = r / 16; }
            int drow = nt * 64;
            if (ldns[q] == DGU) { const int f = drow < DFF ? drow : drow - DFF; drow = 256 * (f >> 7) + (f & 127) + (drow < DFF ? 0 : 128); }
            src[q] += (size_t)(kt * 64) * ldns[q] + nt * 64; dst[q] += (size_t)drow * Ks[q] + kt * 64;
#pragma unroll
            for (int ps = 0; ps < 2; ++ps) { v[q][ps] = *(const f32x4*)(src[q] + (size_t)((tid >> 4) + ps * 32) * ldns[q] + (tid & 15) * 4); if (gs[q]) v[q][ps] = v[q][ps] * gs[q][kt * 64 + (tid >> 4) + ps * 32]; }
        }
#pragma unroll
        for (int q = 0; q < 4; ++q)
#pragma unroll
            for (int ps = 0; ps < 2; ++ps) { LAS float* t = tl + q * 4160 + ((tid >> 4) + ps * 32) * 65 + (tid & 15) * 4; t[0] = v[q][ps][0]; t[1] = v[q][ps][1]; t[2] = v[q][ps][2]; t[3] = v[q][ps][3]; }
        __syncthreads();
#pragma unroll
        for (int q = 0; q < 4; ++q) {
            const int n = tid >> 3, kq = tid & 7;
            float f[8];
#pragma unroll
            for (int e = 0; e < 8; ++e) f[e] = tl[q * 4160 + (8 * kq + e) * 65 + n];
            *(u32x4*)(dst[q] + (size_t)n * Ks[q] + 8 * kq) = pack8(f);
        }
        __syncthreads();
    }
}
__device__ __forceinline__ int slack_r0() { return gridDim.x == 256 ? 128 * SLACK_TILES : 0; }

__device__ void phase_prep(const Params& p, LAS unsigned char* lds) {
    const int tid = TIDX;
    {
        const int r0 = slack_r0(), span = TILES_L - r0, n = TILES_L + (DEPTH - 1) * span;
        convert_tiles(p, lds, blockIdx.x, n / 4, gridDim.x, [=](int j) { if (j < TILES_L) return j; const int jj = j - TILES_L; return (1 + jj / span) * TILES_L + r0 + jj % span; });
    }
    const int gt = blockIdx.x * 512 + tid, gn = gridDim.x * 512;
    {
        bf16_t* wrT = (bf16_t*)(p.ws + W_LRUW); bf16_t* wiT = wrT + DEPTH * 8 * 64 * 64;
        for (int i = gt; i < DEPTH * 8 * 64 * 64; i += gn) {
            const int lh = i >> 12, j = (i >> 6) & 63, ii = i & 63;
            wrT[i] = f2bf(p.in[12][(size_t)lh * 4096 + ii * 64 + j]);
            wiT[i] = f2bf(p.in[14][(size_t)lh * 4096 + ii * 64 + j]);
        }
    }
    {
        float* rc = (float*)(p.ws + W_ROPE); float* rs = rc + 2049 * 32;
        for (int i = gt; i < 2049 * 32; i += gn) {
            const int pos = (i >> 5) < 2048 ? (i >> 5) : 16384; const int d = i & 31;
            const float freq = powf(10000.f, -(float)d / 32.f);
            const float ang = (float)pos * freq;
            rc[i] = cosf(ang); rs[i] = sinf(ang);
        }
    }
    {
        bf16_t* wdt = (bf16_t*)(p.ws + W_WDT);
        for (int i = gt; i < DEPTH * 16 * DM; i += gn) {
            const int l = i >> 14, j = (i >> 10) & 15, k = i & 1023;
            wdt[i] = j < 8 ? f2bf(p.in[8][l * DM + k] * p.in[9][((size_t)l * DM + k) * DIN + NPROJ + j]) : (bf16_t)0;
        }
    }
    {
        u64* rss = (u64*)(p.ws + W_RSS);
        for (int i = gt; i < 8 * TT; i += gn) rss[TT + i] = 0ull;
    }
    {
        const int wid = tid >> 6, lane = tid & 63;
        bf16_t* xb = (bf16_t*)(p.ws + W_XB); u64* rss = (u64*)(p.ws + W_RSS);
        const int nw = gridDim.x * 8;
        for (int row0 = blockIdx.x * 8 + wid; row0 < TT; row0 += 4 * nw) {
            f32x4 v[4][4];
#pragma unroll
            for (int r = 0; r < 4; ++r) { const int row = row0 + r * nw; const float* src = row < TP ? p.in[0] + (size_t)row * DM : p.in[1] + (size_t)(row - TP) * DM;
#pragma unroll
                for (int i = 0; i < 4; ++i) v[r][i] = row < TT ? *(const f32x4*)(src + i * 256 + lane * 4) : (f32x4){0.f, 0.f, 0.f, 0.f}; }
#pragma unroll
            for (int r = 0; r < 4; ++r) { const int row = row0 + r * nw; float ss = 0.f;
                if (row < TT) {
#pragma unroll
                    for (int i = 0; i < 4; ++i) { u32x2 w; w.x = pk2(v[r][i][0], v[r][i][1]); w.y = pk2(v[r][i][2], v[r][i][3]); *(u32x2*)(xb + (size_t)row * DM + i * 256 + lane * 4) = w;
                        float o[4]; unpack4(w, o); ss += o[0] * o[0] + o[1] * o[1] + o[2] * o[2] + o[3] * o[3]; }
                }
                ss = wave_sum(ss, lane);
                if (lane == 0 && row < TT) rss[row] = ss_fix(ss);
            }
        }
    }
}

__device__ void phase_dt(const Params& p, int l) {
    const int tid = TIDX, wid = tid >> 6, lane = tid & 63, fr = lane & 15, fq = lane >> 4;
    const bf16_t* xb = (const bf16_t*)(p.ws + W_XB); const bf16_t* wdt = (const bf16_t*)(p.ws + W_WDT) + (size_t)l * 16 * DM;
    const u64* rss = (const u64*)(p.ws + W_RSS) + (size_t)(2 * l) * TT; float* dtraw = (float*)(p.ws + W_DT);
    for (int tile = blockIdx.x * 8 + wid; tile < TT / 16; tile += gridDim.x * 8) {
        const bf16_t* ap = xb + (size_t)(tile * 16 + fr) * DM + 8 * fq; const bf16_t* bp = wdt + (size_t)fr * DM + 8 * fq;
        f32x4 acc = {0.f, 0.f, 0.f, 0.f};
#pragma unroll 16
        for (int s = 0; s < 32; ++s) acc = MFMA(*(const bf16x8*)(bp + 32 * s), *(const bf16x8*)(ap + 32 * s), acc);
        const int row = tile * 16 + fr;
        if (fq < 2) { const float rs = rstd_fix(rss[row]); *(f32x4*)(dtraw + (size_t)row * 8 + 4 * fq) = acc * rs; }
    }
}

__device__ void phase_final(const Params& p) {
    const int tid = TIDX, wid = tid >> 6, lane = tid & 63;
    const bf16_t* xb = (const bf16_t*)(p.ws + W_XB);
    const float* g = p.in[30];
    f32x4 g4[4];
#pragma unroll
    for (int i = 0; i < 4; ++i) g4[i] = *(const f32x4*)(g + i * 256 + lane * 4);
    const int nw = gridDim.x * 8;
    for (int row0 = blockIdx.x * 8 + wid; row0 < TT; row0 += 4 * nw) {
        u32x2 raw[4][4];
#pragma unroll
        for (int r = 0; r < 4; ++r) { const int row = row0 + r * nw;
#pragma unroll
            for (int i = 0; i < 4; ++i) raw[r][i] = row < TT ? *(const u32x2*)(xb + (size_t)row * DM + i * 256 + lane * 4) : (u32x2){0u, 0u}; }
#pragma unroll
        for (int r = 0; r < 4; ++r) { const int row = row0 + r * nw;
            f32x4 v[4]; float ss = 0.f;
#pragma unroll
            for (int i = 0; i < 4; ++i) { float o[4]; unpack4(raw[r][i], o); v[i] = (f32x4){o[0], o[1], o[2], o[3]}; ss += o[0] * o[0] + o[1] * o[1] + o[2] * o[2] + o[3] * o[3]; }
            ss = wave_sum(ss, lane);
            const float rstd = rsqrtf(ss * (1.f / DM) + EPS);
            if (row < TT) {
#pragma unroll
                for (int i = 0; i < 4; ++i) *(f32x4*)(p.out + (size_t)row * DM + i * 256 + lane * 4) = v[i] * rstd * g4[i];
            }
        }
    }
}


__device__ __forceinline__ float ret_logg(int h) { return log1pf(-exp2f(-5.f - (float)h)); }

template <class CM, class F>
__device__ __forceinline__ void conv64(const bf16_t* proj, int row0, int tseq0, int pc0, const float* cw, const float* cb, int C, int nchunks, CM&& chmap, F&& emit) {
    for (int u = TIDX; u < nchunks * 8; u += 512) {
        const int q = u % nchunks, seg = u / nchunks, c = chmap(q), j0 = seg * 8;
        const bf16_t* src = proj + (size_t)(row0 + j0) * NPROJ + pc0 + c;
        u32x4 raw[11];
        if (tseq0 + j0 == 0) { raw[0] = (u32x4){0u, 0u, 0u, 0u}; raw[1] = raw[0]; raw[2] = raw[0]; }
        else { raw[0] = *(const u32x4*)(src - 3 * NPROJ); raw[1] = *(const u32x4*)(src - 2 * NPROJ); raw[2] = *(const u32x4*)(src - NPROJ); }
#pragma unroll
        for (int j = 0; j < 8; ++j) raw[3 + j] = *(const u32x4*)(src + (size_t)j * NPROJ);
        float w0[8], w1[8], w2[8], w3[8], bb[8];
#pragma unroll
        for (int e = 0; e < 8; ++e) { w0[e] = cw[c + e]; w1[e] = cw[C + c + e]; w2[e] = cw[2 * C + c + e]; w3[e] = cw[3 * C + c + e]; bb[e] = cb[c + e]; }
        float h3[8], h2[8], h1[8];
        unpack8(raw[0], h3); unpack8(raw[1], h2); unpack8(raw[2], h1);
#pragma unroll
        for (int j = 0; j < 8; ++j) {
            float cur[8], y[8];
            unpack8(raw[3 + j], cur);
#pragma unroll
            for (int e = 0; e < 8; ++e) y[e] = bb[e] + w0[e] * h3[e] + w1[e] * h2[e] + w2[e] * h1[e] + w3[e] * cur[e];
            emit(j0 + j, q, c, y);
#pragma unroll
            for (int e = 0; e < 8; ++e) { h3[e] = h2[e]; h2[e] = h1[e]; h1[e] = cur[e]; }
        }
    }
}

__device__ __forceinline__ void rot16(const bf16_t* src, const float* rc, const float* rs, float scale, LAS bf16_t* dst) {
    float x1[16], x2[16], o1[16], o2[16];
    unpack8(*(const u32x4*)src, x1); unpack8(*(const u32x4*)(src + 8), x1 + 8);
    unpack8(*(const u32x4*)(src + 32), x2); unpack8(*(const u32x4*)(src + 40), x2 + 8);
#pragma unroll
    for (int e = 0; e < 16; ++e) { const float c = rc[e], s = rs[e]; o1[e] = (x1[e] * c - x2[e] * s) * scale; o2[e] = (x1[e] * s + x2[e] * c) * scale; }
    *(LAS u32x4*)dst = pack8(o1); *(LAS u32x4*)(dst + 8) = pack8(o1 + 8);
    *(LAS u32x4*)(dst + 32) = pack8(o2); *(LAS u32x4*)(dst + 40) = pack8(o2 + 8);
}

__device__ void ret_m1(const Params& p, LAS unsigned char* lds, int b, int c) {
    const int tid = TIDX, wid = tid >> 6, lane = tid & 63, fr = lane & 15, fq = lane >> 4;
    const bf16_t* proj = (const bf16_t*)(p.ws + W_PROJ);
    const float* rc = (const float*)(p.ws + W_ROPE); const float* rs = rc + 2049 * 32;
    float* dS = (float*)(p.ws + W_DS);
    LAS bf16_t* Kt = (LAS bf16_t*)lds;
    LAS bf16_t* Vt = (LAS bf16_t*)(lds + 33792);
    const int row0 = b * SEQ + c * 64, pos0 = c * 64;
    {
        const int j = tid >> 3, sub = tid & 7, h = sub >> 1, d0 = (sub & 1) * 16;
        const float scale = 0.125f * fexp_((float)(63 - j) * ret_logg(h));
        rot16(proj + (size_t)(row0 + j) * NPROJ + PC_K + h * 64 + d0, rc + (pos0 + j) * 32 + d0, rs + (pos0 + j) * 32 + d0, scale, Kt + j * 264 + h * 64 + d0);
#pragma unroll
        for (int i = 0; i < 8; ++i) { const int id = tid + 512 * i, jj = id >> 6, cc = id & 63;
            *(LAS u32x4*)(Vt + jj * 520 + cc * 8) = *(const u32x4*)(proj + (size_t)(row0 + jj) * NPROJ + PC_V + cc * 8); }
    }
    __syncthreads();
    {
        const int h = wid >> 1, vh = wid & 1;
        bf16x8 X[4][2];
#pragma unroll
        for (int kt = 0; kt < 4; ++kt)
#pragma unroll
            for (int kk = 0; kk < 2; ++kk) X[kt][kk] = frag_tr(Kt, 264, kk * 32, h * 64 + kt * 16, fr, fq);
        float* out = dS + ((size_t)((b * 4 + h) * NCH + c)) * 8192;
#pragma unroll
        for (int vt = 0; vt < 4; ++vt) {
            bf16x8 Y[2];
#pragma unroll
            for (int kk = 0; kk < 2; ++kk) Y[kk] = frag_tr(Vt, 520, kk * 32, h * 128 + vh * 64 + vt * 16, fr, fq);
#pragma unroll
            for (int kt = 0; kt < 4; ++kt) {
                f32x4 a = {0.f, 0.f, 0.f, 0.f};
                a = MFMA(X[kt][0], Y[0], a); a = MFMA(X[kt][1], Y[1], a);
                *(f32x4*)(out + (vh * 64 + vt * 16 + fr) * 64 + kt * 16 + 4 * fq) = a;
            }
        }
    }
    __syncthreads();
}

template <int NH>
__device__ __forceinline__ void ssd_dt_cum(const Params& p, int l, int row0, int h0, LAS float* dtv, LAS float* cum) {
    const int tid = TIDX, hl = tid >> 6, j = tid & 63;
    const float* dtraw = (const float*)(p.ws + W_DT);
    if (hl < NH) {
        const int h = h0 + hl;
        const float dt = softplusf_(dtraw[(size_t)(row0 + j) * 8 + h] + p.in[20][l * 8 + h]);
        float v = -dt * fexp_(p.in[21][l * 8 + h]);
#pragma unroll
        for (int o = 1; o < 64; o <<= 1) { const float t = shfl_up_(v, o, j); if (j >= o) v += t; }
        dtv[hl * 64 + j] = dt; cum[hl * 64 + j] = v;
    }
    __syncthreads();
}

__device__ void ssd_m1(const Params& p, LAS unsigned char* lds, int l, int b, int c) {
    const int tid = TIDX, wid = tid >> 6, lane = tid & 63, fr = lane & 15, fq = lane >> 4;
    const bf16_t* proj = (const bf16_t*)(p.ws + W_PROJ);
    float* dS = (float*)(p.ws + W_DSSSD); float* dec = (float*)(p.ws + W_DEC);
    LAS bf16_t* Xs = (LAS bf16_t*)lds;
    LAS bf16_t* Bm = (LAS bf16_t*)(lds + 66560);
    LAS float* dtv = (LAS float*)(lds + 100352);
    LAS float* cum = dtv + 512;
    LAS float* wl = cum + 512;
    const int row0 = b * SEQ + c * 64;
    ssd_dt_cum<8>(p, l, row0, 0, dtv, cum);
    { const int h = tid >> 6, j = tid & 63; wl[tid] = fexp_(cum[h * 64 + 63] - cum[tid]) * dtv[tid]; if (j == 63) dec[(b * 8 + h) * NCH + c] = fexp_(cum[h * 64 + 63]); }
    __syncthreads();
    conv64(proj, row0, c * 64, PC_XBC, p.in[18] + (size_t)l * 4 * 1024, p.in[19] + l * 1024, 1024, 96, [](int q) { return q * 8; },
           [&](int j, int q, int ch, float* y) {
               float s[8];
               if (ch < 512) { const float w = wl[(ch >> 6) * 64 + j];
#pragma unroll
                   for (int e = 0; e < 8; ++e) s[e] = siluf_(y[e]) * w;
                   *(LAS u32x4*)(Xs + j * 520 + ch) = pack8(s);
               } else {
#pragma unroll
                   for (int e = 0; e < 8; ++e) s[e] = siluf_(y[e]);
                   *(LAS u32x4*)(Bm + j * 264 + ch - 512) = pack8(s);
               }
           });
    __syncthreads();
    {
        const int h = wid, g = h >> 2;
        bf16x8 Y[4][2];
#pragma unroll
        for (int pt = 0; pt < 4; ++pt)
#pragma unroll
            for (int kk = 0; kk < 2; ++kk) Y[pt][kk] = frag_tr(Xs, 520, kk * 32, h * 64 + pt * 16, fr, fq);
        float* out = dS + ((size_t)((b * 8 + h) * NCH + c)) * 8192;
#pragma unroll
        for (int nt = 0; nt < 8; ++nt) {
            bf16x8 X[2];
#pragma unroll
            for (int kk = 0; kk < 2; ++kk) X[kk] = frag_tr(Bm, 264, kk * 32, g * 128 + nt * 16, fr, fq);
#pragma unroll
            for (int pt = 0; pt < 4; ++pt) {
                f32x4 a = {0.f, 0.f, 0.f, 0.f};
                a = MFMA(X[0], Y[pt][0], a); a = MFMA(X[1], Y[pt][1], a);
                *(f32x4*)(out + (pt * 16 + fr) * 128 + nt * 16 + 4 * fq) = a;
            }
        }
    }
    __syncthreads();
}

template <int PASS>
__device__ void lru_item(const Params& p, LAS unsigned char* lds, int l, int b, int c) {
    const int tid = TIDX, wid = tid >> 6, lane = tid & 63, fr = lane & 15, fq = lane >> 4;
    const bf16_t* proj = (const bf16_t*)(p.ws + W_PROJ);
    LAS bf16_t* xc = (LAS bf16_t*)lds;
    const int row0 = b * SEQ + c * 64;
    const int h = wid;
    const bf16_t* wrT = (const bf16_t*)(p.ws + W_LRUW) + (size_t)(l * 8 + h) * 4096;
    const bf16_t* wiT = wrT + DEPTH * 8 * 4096;
    bf16x8 BrA[4][2], BiA[4][2]; float brA[4], biA[4], lamA[4], hinA[4];
#pragma unroll
    for (int n = 0; n < 4; ++n) {
#pragma unroll
        for (int kk = 0; kk < 2; ++kk) { BrA[n][kk] = *(const bf16x8*)(wrT + (n * 16 + fr) * 64 + kk * 32 + 8 * fq); BiA[n][kk] = *(const bf16x8*)(wiT + (n * 16 + fr) * 64 + kk * 32 + 8 * fq); }
        const int ch = h * 64 + n * 16 + fr;
        brA[n] = p.in[13][l * 512 + ch]; biA[n] = p.in[15][l * 512 + ch]; lamA[n] = p.in[16][l * 512 + ch];
        hinA[n] = PASS == 2 ? ((const float*)(p.ws + W_LRUHIN))[(size_t)(b * NCH + c) * 512 + ch] : 0.f;
    }
    conv64(proj, row0, c * 64, PC_LX, p.in[10] + (size_t)l * 4 * 512, p.in[11] + l * 512, 512, 64, [](int q) { return q * 8; },
           [&](int j, int q, int ch, float* y) { *(LAS u32x4*)(xc + j * 520 + ch) = pack8(y); });
    __syncthreads();
    bf16x8 Af[4][2];
#pragma unroll
    for (int m = 0; m < 4; ++m)
#pragma unroll
        for (int kk = 0; kk < 2; ++kk) Af[m][kk] = frag_row(xc, 520, m * 16, h * 64 + kk * 32, fr, fq);
    float* lruAB = (float*)(p.ws + W_LRUAB); const float* hin = (const float*)(p.ws + W_LRUHIN);
    bf16_t* mix = (bf16_t*)(p.ws + W_HB);
#pragma unroll
    for (int n = 0; n < 4; ++n) {
        f32x4 ar[4], ai[4];
        {
            bf16x8 Br[2], Bi[2];
#pragma unroll
            for (int kk = 0; kk < 2; ++kk) { Br[kk] = BrA[n][kk]; Bi[kk] = BiA[n][kk]; }
#pragma unroll
            for (int m = 0; m < 4; ++m) {
                f32x4 a = {0.f, 0.f, 0.f, 0.f}, bq = {0.f, 0.f, 0.f, 0.f};
                a = MFMA(Af[m][0], Br[0], a); a = MFMA(Af[m][1], Br[1], a);
                bq = MFMA(Af[m][0], Bi[0], bq); bq = MFMA(Af[m][1], Bi[1], bq);
                ar[m] = a; ai[m] = bq;
            }
        }
        const int ch = h * 64 + n * 16 + fr;
        const float br = brA[n], bi = biA[n];
        const float sp = log1pf(fexp_(-lamA[n]));
#pragma unroll
        for (int m = 0; m < 4; ++m)
#pragma unroll
            for (int i = 0; i < 4; ++i) {
                const int t = m * 16 + 4 * fq + i;
                const float xv = bf2f(xc[t * 520 + ch]);
                const float r = sigmoidf_(ar[m][i] + br), ig = sigmoidf_(ai[m][i] + bi);
                const float la = -8.f * r * sp;
                const float av = fexp_(la);
                ar[m][i] = av;
                ai[m][i] = __builtin_amdgcn_sqrtf(fmaxf(1.f - av * av, 0.f)) * ig * xv;
            }
        float carry = 0.f, Atot = 1.f;
        if (PASS == 2) carry = hinA[n];
#pragma unroll
        for (int m = 0; m < 4; ++m) {
            const float a0 = ar[m][0], a1 = ar[m][1], a2 = ar[m][2], a3 = ar[m][3];
            const float b0 = ai[m][0], b1 = ai[m][1], b2 = ai[m][2], b3 = ai[m][3];
            float Al = a0 * a1 * a2 * a3, Bl = ((b0 * a1 + b1) * a2 + b2) * a3 + b3;
            float Ap = shfl_up_(Al, 16, lane), Bp = shfl_up_(Bl, 16, lane);
            if (fq >= 1) { Bl = Bp * Al + Bl; Al = Ap * Al; }
            Ap = shfl_up_(Al, 32, lane); Bp = shfl_up_(Bl, 32, lane);
            if (fq >= 2) { Bl = Bp * Al + Bl; Al = Ap * Al; }
            float Aex = shfl_up_(Al, 16, lane), Bex = shfl_up_(Bl, 16, lane);
            if (fq == 0) { Aex = 1.f; Bex = 0.f; }
            const float At = shfl_idx(Al, fr + 48), Bt = shfl_idx(Bl, fr + 48);
            if (PASS == 2) {
                float hh = Aex * carry + Bex;
                hh = a0 * hh + b0; ai[m][0] = hh;
                hh = a1 * hh + b1; ai[m][1] = hh;
                hh = a2 * hh + b2; ai[m][2] = hh;
                hh = a3 * hh + b3; ai[m][3] = hh;
            }
            carry = At * carry + Bt; Atot *= At;
        }
        if (PASS == 1) {
            if (fq == 0) { f32x2 v = {Atot, carry}; *(f32x2*)(lruAB + ((size_t)(b * NCH + c) * 512 + ch) * 2) = v; }
        } else {
            bf16_t gv[4][4];
#pragma unroll
            for (int m = 0; m < 4; ++m)
#pragma unroll
                for (int i = 0; i < 4; ++i) gv[m][i] = proj[(size_t)(row0 + m * 16 + 4 * fq + i) * NPROJ + PC_LG + ch];
#pragma unroll
            for (int m = 0; m < 4; ++m)
#pragma unroll
                for (int i = 0; i < 4; ++i) {
                    const size_t t = row0 + m * 16 + 4 * fq + i;
                    mix[t * DMIX + ch] = f2bf(ai[m][i] * geluf_(bf2f(gv[m][i])));
                }
        }
    }
    __syncthreads();
}

__device__ void phase_m15(const Params& p, int l) {
    const int gt = blockIdx.x * 512 + TIDX, gn = gridDim.x * 512;
    const float* dSr = (const float*)(p.ws + W_DS); const float* dSs = (const float*)(p.ws + W_DSSSD); const float* dec = (const float*)(p.ws + W_DEC);
    bf16_t* spr = (bf16_t*)(p.ws + W_SPR); bf16_t* sps = (bf16_t*)(p.ws + W_SPS);
    for (int u = gt; u < (32 + 64) * 4096; u += gn) {
        float zz = 0.f; asm volatile("" : "+v"(zz));
        f32x2 S = {zz, zz};
        f32x2 tv[NCH];
        if (u < 32 * 4096) {
            const int bh = u >> 12, e2 = u & 4095, h = bh & 3;
            const float* ptr = dSr + (size_t)bh * NCH * 8192 + e2 * 2; bf16_t* sp = spr + (size_t)bh * NCH * 8192 + e2 * 2;
            const float d = fexp_(64.f * ret_logg(h));
#pragma unroll
            for (int c = 0; c < NCH; ++c) tv[c] = *(const f32x2*)(ptr + (size_t)c * 8192);
#pragma unroll
            for (int c = 0; c < NCH; ++c) { *(unsigned*)(sp + (size_t)c * 8192) = pk2(S[0], S[1]); S = S * d + tv[c]; }
            float* o = p.out + O_RP + ((size_t)(l * NB * 4 + bh)) * 8192;
#pragma unroll
            for (int i = 0; i < 2; ++i) { const int e = e2 * 2 + i, v = e >> 6, k = e & 63; o[k * 128 + v] = S[i]; }
        } else {
            const int uu = u - 32 * 4096, bh = uu >> 12, e2 = uu & 4095;
            const float* ptr = dSs + (size_t)bh * NCH * 8192 + e2 * 2; bf16_t* sp = sps + (size_t)bh * NCH * 8192 + e2 * 2;
            float dc[NCH];
#pragma unroll
            for (int c = 0; c < NCH; ++c) { tv[c] = *(const f32x2*)(ptr + (size_t)c * 8192); dc[c] = dec[bh * NCH + c]; }
#pragma unroll
            for (int c = 0; c < NCH; ++c) { *(unsigned*)(sp + (size_t)c * 8192) = pk2(S[0], S[1]); S = S * dc[c] + tv[c]; }
            *(f32x2*)(p.out + O_SP + ((size_t)(l * NB * 8 + bh)) * 8192 + e2 * 2) = S;
        }
    }
    const float* lruAB = (const float*)(p.ws + W_LRUAB); float* hin = (float*)(p.ws + W_LRUHIN);
    for (int u = gt; u < NB * 512; u += gn) {
        const int b = u >> 9, ch = u & 511; float h = 0.f;
        f32x2 ab[NCH];
#pragma unroll
        for (int c = 0; c < NCH; ++c) ab[c] = *(const f32x2*)(lruAB + ((size_t)(b * NCH + c) * 512 + ch) * 2);
#pragma unroll
        for (int c = 0; c < NCH; ++c) { hin[(size_t)(b * NCH + c) * 512 + ch] = h; h = ab[c][0] * h + ab[c][1]; }
        p.out[O_LHP + (size_t)(l * NB + b) * 512 + ch] = h;
    }
}

__device__ void ret_m2(const Params& p, LAS unsigned char* lds, int l, int b, int c, int hp) {
    const int tid = TIDX, wid = tid >> 6, lane = tid & 63, fr = lane & 15, fq = lane >> 4;
    const bf16_t* proj = (const bf16_t*)(p.ws + W_PROJ);
    const float* rc = (const float*)(p.ws + W_ROPE); const float* rs = rc + 2049 * 32;
    const bf16_t* sp = (const bf16_t*)(p.ws + W_SPR);
    bf16_t* mix = (bf16_t*)(p.ws + W_HB);
    const int row0 = b * SEQ + c * 64, pos0 = c * 64;
    constexpr int HB = 63488;
    {
        const int j = tid >> 3, sub = tid & 7, hh = sub >> 2, which = (sub >> 1) & 1, d0 = (sub & 1) * 16, h = 2 * hp + hh;
        LAS bf16_t* dst = (LAS bf16_t*)(lds + hh * HB + which * 9216) + j * 72 + d0;
        rot16(proj + (size_t)(row0 + j) * NPROJ + (which ? PC_K : PC_Q) + h * 64 + d0, rc + (pos0 + j) * 32 + d0, rs + (pos0 + j) * 32 + d0, which ? 0.125f : 1.f, dst);
#pragma unroll
        for (int i = 0; i < 4; ++i) { const int id = tid + 512 * i, h2 = id >> 10, jj = (id >> 4) & 63, cc = id & 15;
            *(LAS u32x4*)((LAS bf16_t*)(lds + h2 * HB + 18432) + jj * 136 + cc * 8) = *(const u32x4*)(proj + (size_t)(row0 + jj) * NPROJ + PC_V + (2 * hp + h2) * 128 + cc * 8); }
#pragma unroll
        for (int i = 0; i < 4; ++i) { const int id = tid + 512 * i, h2 = id >> 10, v = (id >> 3) & 127, kc = id & 7;
            *(LAS u32x4*)((LAS bf16_t*)(lds + h2 * HB + 35840) + v * 72 + kc * 8) = *(const u32x4*)(sp + ((size_t)((b * 4 + 2 * hp + h2) * NCH + c)) * 8192 + v * 64 + kc * 8); }
    }
    __syncthreads();
    const int hh = wid >> 2, it = wid & 3, i0 = it * 16, h = 2 * hp + hh;
    const float lg = ret_logg(h);
    LAS bf16_t* Q = (LAS bf16_t*)(lds + hh * HB); LAS bf16_t* Kk = Q + 64 * 72; LAS bf16_t* V = (LAS bf16_t*)(lds + hh * HB + 18432);
    LAS bf16_t* S = (LAS bf16_t*)(lds + hh * HB + 35840); LAS bf16_t* P = (LAS bf16_t*)(lds + hh * HB + 54272);
    bf16x8 Yq[2];
#pragma unroll
    for (int kk = 0; kk < 2; ++kk) Yq[kk] = frag_row(Q, 72, i0, kk * 32, fr, fq);
    const int irow = i0 + fr;
#pragma unroll
    for (int jt = 0; jt < 4; ++jt) {
        f32x4 sc = {0.f, 0.f, 0.f, 0.f};
#pragma unroll
        for (int kk = 0; kk < 2; ++kk) sc = MFMA(frag_row(Kk, 72, jt * 16, kk * 32, fr, fq), Yq[kk], sc);
        float v[4];
#pragma unroll
        for (int i = 0; i < 4; ++i) { const int j = jt * 16 + 4 * fq + i; v[i] = j <= irow ? sc[i] * fexp_((float)(irow - j) * lg) : 0.f; }
        u32x2 w; w.x = pk2(v[0], v[1]); w.y = pk2(v[2], v[3]);
        *(LAS u32x2*)(P + irow * 72 + jt * 16 + 4 * fq) = w;
    }
    __syncthreads();
    const size_t t = row0 + irow;
    u32x2 rgv[8]; f32x4 ngv[8];
#pragma unroll
    for (int vt = 0; vt < 8; ++vt) { rgv[vt] = *(const u32x2*)(proj + t * NPROJ + PC_RG + h * 128 + vt * 16 + 4 * fq); ngv[vt] = *(const f32x4*)(p.in[17] + l * 512 + h * 128 + vt * 16 + 4 * fq); }
    bf16x8 Yp[2];
#pragma unroll
    for (int kk = 0; kk < 2; ++kk) Yp[kk] = frag_row(P, 72, i0, kk * 32, fr, fq);
    const float qdec = fexp_((float)(irow + 1) * lg);
    f32x4 o[8]; float ssq = 0.f;
#pragma unroll
    for (int vt = 0; vt < 8; ++vt) {
        f32x4 a1 = {0.f, 0.f, 0.f, 0.f}, a2 = {0.f, 0.f, 0.f, 0.f};
#pragma unroll
        for (int kk = 0; kk < 2; ++kk) { a1 = MFMA(frag_tr(V, 136, kk * 32, vt * 16, fr, fq), Yp[kk], a1); a2 = MFMA(frag_row(S, 72, vt * 16, kk * 32, fr, fq), Yq[kk], a2); }
        o[vt] = a1 + a2 * qdec;
        ssq += o[vt][0] * o[vt][0] + o[vt][1] * o[vt][1] + o[vt][2] * o[vt][2] + o[vt][3] * o[vt][3];
    }
    ssq += shfl_xor_(ssq, 16, lane); ssq += shfl_xor_(ssq, 32, lane);
    const float rstd = rsqrtf(ssq * (1.f / 128.f) + EPS);
#pragma unroll
    for (int vt = 0; vt < 8; ++vt) {
        const int v = vt * 16 + 4 * fq;
        float gt[4]; unpack4(rgv[vt], gt);
        const f32x4 ng = ngv[vt];
        float y[4];
#pragma unroll
        for (int i = 0; i < 4; ++i) y[i] = siluf_(gt[i]) * (o[vt][i] * rstd * ng[i]);
        u32x2 w; w.x = pk2(y[0], y[1]); w.y = pk2(y[2], y[3]);
        *(u32x2*)(mix + t * DMIX + 512 + h * 128 + v) = w;
    }
    __syncthreads();
}

__device__ void ssd_m2(const Params& p, LAS unsigned char* lds, int l, int b, int c, int g) {
    const int tid = TIDX, wid = tid >> 6, lane = tid & 63, fr = lane & 15, fq = lane >> 4;
    const bf16_t* proj = (const bf16_t*)(p.ws + W_PROJ);
    const bf16_t* sp = (const bf16_t*)(p.ws + W_SPS);
    bf16_t* mix = (bf16_t*)(p.ws + W_HB);
    const int row0 = b * SEQ + c * 64;
    LAS bf16_t* Cm = (LAS bf16_t*)lds;
    LAS bf16_t* Bm = (LAS bf16_t*)(lds + 17408);
    constexpr int PB = 34816, HB = 35840;
    LAS float* dtv = (LAS float*)(lds + 106496);
    LAS float* cum = dtv + 256;
    LAS float* ssqb = cum + 256;
    ssd_dt_cum<4>(p, l, row0, 4 * g, dtv, cum);
    const float* cw = p.in[18] + (size_t)l * 4 * 1024; const float* cb = p.in[19] + l * 1024;
    conv64(proj, row0, c * 64, PC_XBC, cw, cb, 1024, 32, [g](int q) { return (q < 16 ? 512 : 768 - 128) + g * 128 + q * 8; },
           [&](int j, int q, int ch, float* y) {
               float s[8];
#pragma unroll
               for (int e = 0; e < 8; ++e) s[e] = siluf_(y[e]);
               if (q < 16) *(LAS u32x4*)(Bm + j * 136 + q * 8) = pack8(s); else *(LAS u32x4*)(Cm + j * 136 + (q - 16) * 8) = pack8(s);
           });
    const int hh = wid >> 2, it = wid & 3, i0 = it * 16, irow = i0 + fr;
    const size_t t = row0 + irow;
    f32x4 gy[2][4]; float ssq = 0.f;
#pragma unroll
    for (int pr = 0; pr < 2; ++pr) {
        const int hbase = 4 * g + 2 * pr;
        conv64(proj, row0, c * 64, PC_XBC, cw, cb, 1024, 16, [hbase](int q) { return hbase * 64 + q * 8; },
               [&](int j, int q, int ch, float* y) {
                   float s[8];
#pragma unroll
                   for (int e = 0; e < 8; ++e) s[e] = siluf_(y[e]);
                   *(LAS u32x4*)((LAS bf16_t*)(lds + PB + (q >> 3) * HB + 9216) + j * 72 + (q & 7) * 8) = pack8(s);
               });
#pragma unroll
        for (int i = 0; i < 4; ++i) { const int id = tid + 512 * i, h2 = id >> 10, pp = (id >> 4) & 63, nc = id & 15;
            *(LAS u32x4*)((LAS bf16_t*)(lds + PB + h2 * HB + 18432) + pp * 136 + nc * 8) = *(const u32x4*)(sp + ((size_t)((b * 8 + hbase + h2) * NCH + c)) * 8192 + pp * 128 + nc * 8); }
        __syncthreads();
        const int h = hbase + hh, hl = 2 * pr + hh;
        LAS bf16_t* P = (LAS bf16_t*)(lds + PB + hh * HB); LAS bf16_t* X = P + 64 * 72; LAS bf16_t* S = (LAS bf16_t*)(lds + PB + hh * HB + 18432);
        bf16x8 Yc[4];
#pragma unroll
        for (int kk = 0; kk < 4; ++kk) Yc[kk] = frag_row(Cm, 136, i0, kk * 32, fr, fq);
        const float cumi = cum[hl * 64 + irow];
#pragma unroll
        for (int jh = 0; jh < 2; ++jh) {
            bf16x8 Xb[2][4]; f32x4 cj[2], dj[2];
#pragma unroll
            for (int q = 0; q < 2; ++q) {
#pragma unroll
                for (int kk = 0; kk < 4; ++kk) Xb[q][kk] = frag_row(Bm, 136, (2 * jh + q) * 16, kk * 32, fr, fq);
                cj[q] = *(const LAS f32x4*)(cum + hl * 64 + (2 * jh + q) * 16 + 4 * fq); dj[q] = *(const LAS f32x4*)(dtv + hl * 64 + (2 * jh + q) * 16 + 4 * fq);
            }
#pragma unroll
            for (int q = 0; q < 2; ++q) {
                const int jt = 2 * jh + q;
                f32x4 sc = {0.f, 0.f, 0.f, 0.f};
#pragma unroll
                for (int kk = 0; kk < 4; ++kk) sc = MFMA(Xb[q][kk], Yc[kk], sc);
                float v[4];
#pragma unroll
                for (int i = 0; i < 4; ++i) { const int j = jt * 16 + 4 * fq + i; v[i] = j <= irow ? sc[i] * fexp_(cumi - cj[q][i]) * dj[q][i] : 0.f; }
                u32x2 w; w.x = pk2(v[0], v[1]); w.y = pk2(v[2], v[3]);
                *(LAS u32x2*)(P + irow * 72 + jt * 16 + 4 * fq) = w;
            }
        }
        __syncthreads();
        u32x2 zraw[4];
#pragma unroll
        for (int pt = 0; pt < 4; ++pt) zraw[pt] = *(const u32x2*)(proj + t * NPROJ + PC_Z + h * 64 + pt * 16 + 4 * fq);
        bf16x8 Yp[2];
#pragma unroll
        for (int kk = 0; kk < 2; ++kk) Yp[kk] = frag_row(P, 72, i0, kk * 32, fr, fq);
        const float ecum = fexp_(cumi), Dh = p.in[22][l * 8 + h];
#pragma unroll
        for (int pt = 0; pt < 4; ++pt) {
            f32x4 a1 = {0.f, 0.f, 0.f, 0.f}, a2 = {0.f, 0.f, 0.f, 0.f};
#pragma unroll
            for (int kk = 0; kk < 2; ++kk) a1 = MFMA(frag_tr(X, 72, kk * 32, pt * 16, fr, fq), Yp[kk], a1);
#pragma unroll
            for (int kk = 0; kk < 4; ++kk) a2 = MFMA(frag_row(S, 136, pt * 16, kk * 32, fr, fq), Yc[kk], a2);
            const int pp = pt * 16 + 4 * fq;
            float xv[4], zv[4]; unpack4(*(const LAS u32x2*)(X + irow * 72 + pp), xv);
            unpack4(zraw[pt], zv);
            f32x4 r;
#pragma unroll
            for (int i = 0; i < 4; ++i) { const float y = a1[i] + ecum * a2[i] + Dh * xv[i]; r[i] = y * siluf_(zv[i]); ssq += r[i] * r[i]; }
            gy[pr][pt] = r;
        }
        __syncthreads();
    }
    f32x4 ngv[2][4];
#pragma unroll
    for (int pr = 0; pr < 2; ++pr)
#pragma unroll
        for (int pt = 0; pt < 4; ++pt) ngv[pr][pt] = *(const f32x4*)(p.in[23] + l * 512 + g * 256 + (2 * pr + hh) * 64 + pt * 16 + 4 * fq);
    ssq += shfl_xor_(ssq, 16, lane); ssq += shfl_xor_(ssq, 32, lane);
    if (fq == 0) ssqb[irow * 2 + hh] = ssq;
    __syncthreads();
    const float rstd = rsqrtf((ssqb[irow * 2] + ssqb[irow * 2 + 1]) * (1.f / 256.f) + EPS);
#pragma unroll
    for (int pr = 0; pr < 2; ++pr)
#pragma unroll
        for (int pt = 0; pt < 4; ++pt) {
            const int chn = g * 256 + (2 * pr + hh) * 64 + pt * 16 + 4 * fq;
            const f32x4 ng = ngv[pr][pt];
            u32x2 w; w.x = pk2(gy[pr][pt][0] * rstd * ng[0], gy[pr][pt][1] * rstd * ng[1]); w.y = pk2(gy[pr][pt][2] * rstd * ng[2], gy[pr][pt][3] * rstd * ng[3]);
            *(u32x2*)(mix + t * DMIX + 1024 + chn) = w;
        }
    __syncthreads();
}

__device__ void sample_item(const Params& p, LAS unsigned char* lds, int l, int s, int g) {
    const int tid = TIDX, wid = tid >> 6, lane = tid & 63;
    const bf16_t* proj = (const bf16_t*)(p.ws + W_PROJ);
    bf16_t* mix = (bf16_t*)(p.ws + W_HB);
    const size_t t = TP + s;
    const bf16_t* prow = proj + t * NPROJ;
    LAS float* sv = (LAS float*)lds;
    LAS float* sdt = sv + 512;
    LAS float* gy = sv + 520;
    LAS float* sq = sv + 776;
    LAS float* ro = sv + 1032;
    LAS float* sxc = sv + 2304;
    f32x4 ssd0[4][4], ret0[2][4];
    {
        const int n4 = (tid & 31) * 4, pr = tid >> 5;
#pragma unroll
        for (int hl = 0; hl < 4; ++hl)
#pragma unroll
            for (int ps = 0; ps < 4; ++ps) ssd0[hl][ps] = *(const f32x4*)(p.in[6] + ((size_t)(l * NS + s) * 8 + 4 * g + hl) * 8192 + (ps * 16 + pr) * 128 + n4);
#pragma unroll
        for (int hh = 0; hh < 2; ++hh)
#pragma unroll
            for (int ps = 0; ps < 4; ++ps) ret0[hh][ps] = *(const f32x4*)(p.in[4] + ((size_t)(l * NS + s) * 4 + 2 * g + hh) * 8192 + (ps * 16 + pr) * 128 + n4);
    }
    {
        const int ch = tid < 256 ? g * 256 + tid : (tid < 384 ? 512 + g * 128 + (tid - 256) : 768 + g * 128 + (tid - 384));
        const float* cw = p.in[18] + (size_t)l * 4 * 1024; const float* st = p.in[5] + (size_t)(l * NS + s) * 3 * 1024;
        const float cur = bf2f(prow[PC_XBC + ch]);
        const float s0 = st[ch], s1 = st[1024 + ch], s2 = st[2048 + ch];
        const float y = p.in[19][l * 1024 + ch] + cw[ch] * s0 + cw[1024 + ch] * s1 + cw[2048 + ch] * s2 + cw[3072 + ch] * cur;
        sv[tid] = siluf_(y);
        float* so = p.out + O_SCS + (size_t)(l * NS + s) * 3 * 1024;
        so[ch] = s1; so[1024 + ch] = s2; so[2048 + ch] = cur;
        if (tid < 4) {
            const int h = 4 * g + tid;
            const float dt = softplusf_(((const float*)(p.ws + W_DT))[t * 8 + h] + p.in[20][l * 8 + h]);
            sdt[tid] = dt; sdt[4 + tid] = fexp_(-dt * fexp_(p.in[21][l * 8 + h]));
        }
    }
    __syncthreads();
    {
        const int n4 = (tid & 31) * 4, pr = tid >> 5;
        const f32x4 bv = *(const LAS f32x4*)(sv + 256 + n4), cv = *(const LAS f32x4*)(sv + 384 + n4);
        float part[4][4]; bf16_t zr[4][4];
#pragma unroll
        for (int hl = 0; hl < 4; ++hl)
#pragma unroll
            for (int ps = 0; ps < 4; ++ps) zr[hl][ps] = prow[PC_Z + (4 * g + hl) * 64 + ps * 16 + pr];
#pragma unroll
        for (int hl = 0; hl < 4; ++hl) {
            const int h = 4 * g + hl;
            const float dt = sdt[hl], eda = sdt[4 + hl];
            float* S1 = p.out + O_SS + ((size_t)(l * NS + s) * 8 + h) * 8192;
#pragma unroll
            for (int ps = 0; ps < 4; ++ps) {
                const int pp = ps * 16 + pr;
                const float xp = sv[hl * 64 + pp];
                const f32x4 sn = ssd0[hl][ps] * eda + bv * (dt * xp);
                *(f32x4*)(S1 + pp * 128 + n4) = sn;
                part[hl][ps] = cv[0] * sn[0] + cv[1] * sn[1] + cv[2] * sn[2] + cv[3] * sn[3];
            }
        }
#pragma unroll
        for (int o = 16; o >= 1; o >>= 1)
#pragma unroll
            for (int hl = 0; hl < 4; ++hl)
#pragma unroll
                for (int ps = 0; ps < 4; ++ps) part[hl][ps] += shfl_xor_(part[hl][ps], o, lane);
        if ((tid & 31) == 0) {
#pragma unroll
            for (int hl = 0; hl < 4; ++hl)
#pragma unroll
                for (int ps = 0; ps < 4; ++ps) { const int pp = ps * 16 + pr; const float y = part[hl][ps] + p.in[22][l * 8 + 4 * g + hl] * sv[hl * 64 + pp]; gy[hl * 64 + pp] = y * siluf_(bf2f(zr[hl][ps])); }
        }
    }
    __syncthreads();
    {
        const f32x4 v = *(const LAS f32x4*)(gy + lane * 4);
        const float ssq = wave_sum(v[0] * v[0] + v[1] * v[1] + v[2] * v[2] + v[3] * v[3], lane);
        const float rstd = rsqrtf(ssq * (1.f / 256.f) + EPS);
        if (tid < 256) mix[t * DMIX + 1024 + g * 256 + tid] = f2bf(gy[tid] * rstd * p.in[23][l * 512 + g * 256 + tid]);
    }
    if (tid < 128) {
        const int hh = tid >> 6, w = (tid >> 5) & 1, d = tid & 31, h = 2 * g + hh;
        const int col = (w ? PC_K : PC_Q) + h * 64;
        const float x1 = bf2f(prow[col + d]), x2 = bf2f(prow[col + 32 + d]);
        const float* rc = (const float*)(p.ws + W_ROPE); const float* rs = rc + 2049 * 32;
        const float cs = rc[2048 * 32 + d], sn = rs[2048 * 32 + d], sc = w ? 0.125f : 1.f;
        sq[w * 128 + hh * 64 + d] = (x1 * cs - x2 * sn) * sc; sq[w * 128 + hh * 64 + 32 + d] = (x1 * sn + x2 * cs) * sc;
    }
    __syncthreads();
#pragma unroll
    for (int hh = 0; hh < 2; ++hh) {
        const int h = 2 * g + hh;
        const float gh = 1.f - exp2f(-5.f - (float)h);
        const int v4 = (tid & 31) * 4, kr = tid >> 5;
        float vv[4]; unpack4(*(const u32x2*)(prow + PC_V + h * 128 + v4), vv);
        const float* S0 = p.in[4] + ((size_t)(l * NS + s) * 4 + h) * 8192; float* S1 = p.out + O_RS + ((size_t)(l * NS + s) * 4 + h) * 8192;
        f32x4 part = {0.f, 0.f, 0.f, 0.f};
#pragma unroll
        for (int ps = 0; ps < 4; ++ps) {
            const int k = ps * 16 + kr;
            const float kk = sq[128 + hh * 64 + k], qq = sq[hh * 64 + k];
            const f32x4 s0 = ret0[hh][ps];
            f32x4 sn; sn[0] = gh * s0[0] + kk * vv[0]; sn[1] = gh * s0[1] + kk * vv[1]; sn[2] = gh * s0[2] + kk * vv[2]; sn[3] = gh * s0[3] + kk * vv[3];
            *(f32x4*)(S1 + k * 128 + v4) = sn;
            part = part + sn * qq;
        }
#pragma unroll
        for (int i = 0; i < 4; ++i) part[i] += shfl_xor_(part[i], 32, lane);
        if (lane < 32) *(LAS f32x4*)(ro + wid * 128 + v4) = part;
        __syncthreads();
        if (tid < 128) {
            float o = 0.f;
#pragma unroll
            for (int w = 0; w < 8; ++w) o += ro[w * 128 + tid];
            float ssq = wave_sum(o * o, lane);
            ro[1024 + tid] = o; if (lane == 0) ro[1152 + wid] = ssq;
        }
        __syncthreads();
        if (tid < 128) {
            const float rstd = rsqrtf((ro[1152] + ro[1153]) * (1.f / 128.f) + EPS);
            const float o = ro[1024 + tid];
            mix[t * DMIX + 512 + h * 128 + tid] = f2bf(siluf_(bf2f(prow[PC_RG + h * 128 + tid])) * (o * rstd * p.in[17][l * 512 + h * 128 + tid]));
        }
        __syncthreads();
    }
    if (tid < 256) {
        const int ch = 256 * g + tid;
        const float* cw = p.in[10] + (size_t)l * 4 * 512; const float* st = p.in[2] + (size_t)(l * NS + s) * 3 * 512;
        const float cur = bf2f(prow[PC_LX + ch]);
        const float s0 = st[ch], s1 = st[512 + ch], s2 = st[1024 + ch];
        sxc[tid] = p.in[11][l * 512 + ch] + cw[ch] * s0 + cw[512 + ch] * s1 + cw[1024 + ch] * s2 + cw[1536 + ch] * cur;
        float* so = p.out + O_LCS + (size_t)(l * NS + s) * 3 * 512;
        so[ch] = s1; so[512 + ch] = s2; so[1024 + ch] = cur;
    }
    __syncthreads();
    if (tid < 256) {
        const int j = tid & 63, hl = tid >> 6, h = 4 * g + hl, ch = h * 64 + j;
        const float* wr = p.in[12] + (size_t)(l * 8 + h) * 4096; const float* wi = p.in[14] + (size_t)(l * 8 + h) * 4096;
        float r = 0.f, ig = 0.f;
        for (int i = 0; i < 64; ++i) { const float xv = sxc[hl * 64 + i]; r += xv * wr[i * 64 + j]; ig += xv * wi[i * 64 + j]; }
        r = sigmoidf_(r + p.in[13][l * 512 + ch]); ig = sigmoidf_(ig + p.in[15][l * 512 + ch]);
        const float sp = log1pf(fexp_(-p.in[16][l * 512 + ch]));
        const float la = -8.f * r * sp, a = fexp_(la);
        const float hn = a * p.in[3][(size_t)(l * NS + s) * 512 + ch] + __builtin_amdgcn_sqrtf(fmaxf(-expm1f(2.f * la), 0.f)) * ig * sxc[tid];
        p.out[O_LHS + (size_t)(l * NS + s) * 512 + ch] = hn;
        mix[t * DMIX + ch] = f2bf(hn * geluf_(bf2f(prow[PC_LG + ch])));
    }
    __syncthreads();
}

#ifndef ITMASK
#define ITMASK 0xFF
#endif
#define IT_EN(x) (((ITMASK) >> (x)) & 1)
#ifndef REP_ITEM
#define REP_ITEM 0
#endif
__device__ void phase_m1(const Params& p, LAS unsigned char* lds, int l) {
    for (int rr = 0; rr < 1 + ((REP_ITEM >> 0) & 1); ++rr) { if (IT_EN(0)) for (int it = blockIdx.x; it < 256; it += gridDim.x) ret_m1(p, lds, it >> 5, it & 31); }
    for (int rr = 0; rr < 1 + ((REP_ITEM >> 1) & 1); ++rr) { if (IT_EN(1)) for (int it = blockIdx.x; it < 256; it += gridDim.x) ssd_m1(p, lds, l, it >> 5, it & 31); }
    for (int rr = 0; rr < 1 + ((REP_ITEM >> 2) & 1); ++rr) { if (IT_EN(2)) for (int it = blockIdx.x; it < 256; it += gridDim.x) lru_item<1>(p, lds, l, it >> 5, it & 31); }
    for (int rr = 0; rr < 1 + ((REP_ITEM >> 3) & 1); ++rr) { if (IT_EN(3)) for (int it = blockIdx.x; it < 256; it += gridDim.x) sample_item(p, lds, l, it >> 1, it & 1); }
    const bf16_t* proj = (const bf16_t*)(p.ws + W_PROJ);
    const int gt = blockIdx.x * 512 + TIDX, gn = gridDim.x * 512;
    for (int u = gt; u < NB * 3 * 1536; u += gn) {
        const int b = u / (3 * 1536), r = u % (3 * 1536), k = r / 1536, cc = r % 1536;
        const size_t row = (size_t)b * SEQ + SEQ - 3 + k;
        if (cc < 512) p.out[O_LCP + ((size_t)(l * NB + b) * 3 + k) * 512 + cc] = bf2f(proj[row * NPROJ + PC_LX + cc]);
        else p.out[O_SCP + ((size_t)(l * NB + b) * 3 + k) * 1024 + cc - 512] = bf2f(proj[row * NPROJ + PC_XBC + cc - 512]);
    }
}
__device__ void phase_m2(const Params& p, LAS unsigned char* lds, int l) {
    for (int rr = 0; rr < 1 + ((REP_ITEM >> 4) & 1); ++rr) { if (IT_EN(4)) for (int it = blockIdx.x; it < 512; it += gridDim.x) ret_m2(p, lds, l, it >> 6, (it >> 1) & 31, it & 1); }
    for (int rr = 0; rr < 1 + ((REP_ITEM >> 5) & 1); ++rr) { if (IT_EN(5)) for (int it = blockIdx.x; it < 512; it += gridDim.x) ssd_m2(p, lds, l, it >> 6, (it >> 1) & 31, it & 1); }
    for (int rr = 0; rr < 1 + ((REP_ITEM >> 6) & 1); ++rr) { if (IT_EN(6)) for (int it = blockIdx.x; it < 256; it += gridDim.x) lru_item<2>(p, lds, l, it >> 5, it & 31); }
}


#define XB_TMO      128
#define XB_XCNT(j)  (256  + 64 * (j))
#define XB_XSUB(j)  (1280 + 64 * (j))
#define XB_XGEN(j)  (2304 + 64 * (j))
#define XB_TOP      3328
#define XB_TOPGEN   3392
#define XCD_BAR_WORDS 3456
#define XB_SPIN_CAP (1u << 22)
__device__ __forceinline__ unsigned xb_ld(unsigned* p)              { return __hip_atomic_load(p, __ATOMIC_RELAXED, __HIP_MEMORY_SCOPE_AGENT); }
__device__ __forceinline__ unsigned xb_add(unsigned* p, unsigned v) { return __hip_atomic_fetch_add(p, v, __ATOMIC_RELAXED, __HIP_MEMORY_SCOPE_AGENT); }
__device__ __forceinline__ unsigned xb_xcc_id() { return (unsigned)__builtin_amdgcn_s_getreg((3 << 11) | 20) & 0xFu; }
#define XB_SPIN(cond, bar) do { unsigned _sp = 0; while (cond) { __builtin_amdgcn_s_sleep(1); \
    if ((++_sp & 255u) == 0u) { if (xb_ld(&(bar)[XB_TMO])) break; if (_sp > XB_SPIN_CAP) { atomicAdd(&(bar)[XB_TMO], 1u); break; } } } } while (0)
struct XcdBarrier { unsigned* bar; unsigned x; volatile LAS unsigned* st; };
__device__ __forceinline__ XcdBarrier xcd_barrier_post(unsigned* bar, volatile LAS unsigned* st) {
    XcdBarrier b; b.bar = bar; b.x = xb_xcc_id(); b.st = st;
    if (threadIdx.x == 0) (void)xb_add(&bar[XB_XCNT(b.x)], 1u);
    return b;
}
__device__ __forceinline__ void xcd_barrier_complete(unsigned* bar, unsigned x, unsigned& nloc, unsigned& nx) {
    const unsigned G = gridDim.x * gridDim.y * gridDim.z;
    unsigned sum, cnt, mine, sp = 0u;
    for (;;) {
        sum = 0u; cnt = 0u; mine = 0u;
#pragma unroll
        for (unsigned j = 0; j < 16; ++j) { const unsigned c = xb_ld(&bar[XB_XCNT(j)]); sum += c; cnt += (c > 0u) ? 1u : 0u; mine = (j == x) ? c : mine; }
        if (sum == G) break;
        __builtin_amdgcn_s_sleep(1);
        if ((++sp & 255u) == 0u) { if (xb_ld(&bar[XB_TMO])) break; if (sp > XB_SPIN_CAP) { atomicAdd(&bar[XB_TMO], 1u); break; } }
    }
    nloc = mine > 0u ? mine : 1u; nx = cnt > 0u ? cnt : 1u;
}
__device__ __forceinline__ void xcd_barrier(const XcdBarrier& b) {
    asm volatile("s_waitcnt vmcnt(0)" ::: "memory");
    __syncthreads();
    if (threadIdx.x == 0) {
        unsigned* bar = b.bar;
        __builtin_amdgcn_s_waitcnt(0);
        unsigned nloc = b.st[0], nx = b.st[1];
        if (nloc == 0u) { xcd_barrier_complete(bar, b.x, nloc, nx); b.st[0] = nloc; b.st[1] = nx; }
        const unsigned old = xb_add(&bar[XB_XSUB(b.x)], 1u);
        const unsigned gen = old / nloc;
        if (old + 1u == (gen + 1u) * nloc) {
            __builtin_amdgcn_fence(__ATOMIC_RELEASE, "agent");
            asm volatile("s_waitcnt vmcnt(0)" ::: "memory");
            const unsigned og = xb_add(&bar[XB_TOP], 1u);
            const unsigned tg = og / nx;
            if (og + 1u == (tg + 1u) * nx) xb_add(&bar[XB_TOPGEN], 1u);
            else XB_SPIN(xb_ld(&bar[XB_TOPGEN]) == tg, bar);
            __builtin_amdgcn_fence(__ATOMIC_ACQUIRE, "agent");
            xb_add(&bar[XB_XGEN(b.x)], 1u);
            asm volatile("s_waitcnt vmcnt(0)" ::: "memory");
        } else {
            XB_SPIN(xb_ld(&bar[XB_XGEN(b.x)]) == gen, bar);
            __builtin_amdgcn_fence(__ATOMIC_ACQUIRE, "agent");
            asm volatile("s_waitcnt vmcnt(0)" ::: "memory");
        }
    }
    __syncthreads();
}

constexpr int NPHASE = 2 + 7 * DEPTH;
#ifndef PHMASK
#define PHMASK 0xFFF
#endif
#define PH_EN(x) (((PHMASK) >> (x)) & 1)
__device__ __forceinline__ void run_phase(const Params& p, LAS unsigned char* lds, int ph) {
    if (ph == 0) { if (PH_EN(10)) phase_prep(p, lds); return; }
    if (ph == NPHASE - 1) { if (PH_EN(11)) phase_final(p); return; }
    const int l = (ph - 1) / 7, s = (ph - 1) % 7;
    bf16_t* mix = (bf16_t*)(p.ws + W_HB); bf16_t* xb = (bf16_t*)(p.ws + W_XB); bf16_t* big = (bf16_t*)(p.ws + W_PROJ); bf16_t* act = (bf16_t*)(p.ws + W_DS);
    u64* rss = (u64*)(p.ws + W_RSS);
    pg8::StaticOrder S;
    switch (s) {
    case 0: if (PH_EN(1)) {
        const bf16_t* W = (const bf16_t*)(p.ws + W_WIN) + (size_t)l * NPROJ * DM;
        const u64* r = rss + (size_t)(2 * l) * TT;
        S.init(TP, NPROJ, gridDim.x, blockIdx.x);
        pg8::gemm_phase(lds, pg8::Gemm{xb, W, TP, NPROJ, DM}, S, pg8::EpiBf16{big, NPROJ, r});
        phase_dt(p, l);
        thin_gemm<DM, 0>(lds, xb + (size_t)TP * DM, W, NPROJ, big + (size_t)TP * NPROJ, NPROJ, nullptr, (u64*)r + TP);
    } break;
    case 1: if (PH_EN(2)) phase_m1(p, lds, l); break;
    case 2: if (PH_EN(3)) phase_m15(p, l); break;
    case 3: if (PH_EN(4)) phase_m2(p, lds, l); break;
    case 4: if (PH_EN(5)) {
        const bf16_t* W = (const bf16_t*)(p.ws + W_WOUT) + (size_t)l * DM * DMIX;
        u64* r = rss + (size_t)(2 * l + 1) * TT;
        S.init(TP, DM, gridDim.x, blockIdx.x);
        pg8::gemm_phase(lds, pg8::Gemm{mix, W, TP, DM, DMIX}, S, pg8::EpiResid{DM, xb, r});
        thin_gemm<DMIX, 1>(lds, mix + (size_t)TP * DMIX, W, DM, nullptr, DM, xb + (size_t)TP * DM, r + TP);
    } break;
    case 5: if (PH_EN(7)) {
        const bf16_t* W = (const bf16_t*)(p.ws + W_WUP) + (size_t)l * DGU * DM;
        const u64* r = rss + (size_t)(2 * l + 1) * TT;
        const float* cw = p.in[27] + (size_t)l * 3 * DFF; const float* cb = p.in[28] + (size_t)l * DFF;
        S.init(TP, DGU, gridDim.x, blockIdx.x);
        pg8::gemm_phase(lds, pg8::Gemm{xb, W, TP, DGU, DM}, S, pg8::EpiAct{act, r, cw, cb, (bf16_t*)(p.ws + W_GS01), (bf16_t*)(p.ws + W_US01), (bf16_t*)(p.ws + W_GS23), p.out + O_FCP + (size_t)l * NB * 2 * DFF});
        const bool split = gridDim.x == 256;
        if (split && l + 1 < DEPTH && blockIdx.x >= 128) {
            const int base = (l + 1) * TILES_L + ((int)blockIdx.x - 128) * SLACK_TILES;
            convert_tiles(p, lds, 0, SLACK_TILES / 4, 1, [=](int j) { return base + j; });
        }
        thin_gemm_act(lds, xb + (size_t)TP * DM, W, r + TP, cw, cb, p.in[7] + (size_t)l * NS * 2 * DFF, p.out + O_FCS + (size_t)l * NS * 2 * DFF, act + (size_t)TP * DFF, split ? 128 : 0, split ? 128 : (int)gridDim.x);
    } break;
    case 6: if (PH_EN(9)) {
        const bf16_t* W = (const bf16_t*)(p.ws + W_WDOWN) + (size_t)l * DM * DFF;
        u64* r = rss + (size_t)(2 * l + 2) * TT;
        S.init(TP, DM, gridDim.x, blockIdx.x);
        { pg8::Unit uu; for (int i = 0; S.next(i, uu); ++i) act_fixup(p, l, uu.pm); __threadfence(); __syncthreads(); }
        pg8::gemm_phase(lds, pg8::Gemm{act, W, TP, DM, DFF}, S, pg8::EpiResid{DM, xb, r});
        thin_gemm<DFF, 1>(lds, act + (size_t)TP * DFF, W, DM, nullptr, DM, xb + (size_t)TP * DM, r + TP);
    } break;
    }
}

__global__ void __launch_bounds__(512, 2) mega(Params p, int ph0, int ph1, int coop) {
    extern __shared__ __attribute__((aligned(16))) unsigned char shm[];
    LAS unsigned char* lds = (LAS unsigned char*)shm;
    cg::grid_group grid = cg::this_grid();
    volatile LAS unsigned* st = (volatile LAS unsigned*)(lds + LDS_BYTES);
    if (threadIdx.x < 4) st[threadIdx.x] = 0u;
    __syncthreads();
    XcdBarrier xb = xcd_barrier_post((unsigned*)(p.ws + W_BAR), st);
    for (int ph = ph0; ph < ph1; ++ph) {
        int reps = 1;
#ifdef REP_MASK
        { const int s = (ph == 0) ? 10 : (ph == NPHASE - 1 ? 11 : (ph - 1) % 7); if ((REP_MASK >> s) & 1) reps = 2; }
#endif
        for (int r = 0; r < reps; ++r) { run_phase(p, lds, ph); if (reps > 1) __syncthreads(); }
        if (coop && ph + 1 < ph1) {
            if (coop == 2) grid.sync();
            xcd_barrier(xb);
#ifdef REP_SYNC
            xcd_barrier(xb);
#endif
        }
    }
}

extern "C" void kernel_launch(void* const* d_in, const int* in_sizes, int n_in, void* d_out, int out_size, void* d_ws, size_t ws_size, hipStream_t stream) {
    static int grid_blocks = 0;
    if (!grid_blocks) {
        int dev = 0, cus = 0, per_cu = 0;
        hipGetDevice(&dev);
        hipDeviceGetAttribute(&cus, hipDeviceAttributeMultiprocessorCount, dev);
        hipFuncSetAttribute((const void*)mega, hipFuncAttributeMaxDynamicSharedMemorySize, LDS_BYTES + 16);
        hipOccupancyMaxActiveBlocksPerMultiprocessor(&per_cu, (const void*)mega, 512, LDS_BYTES + 16);
        if (per_cu < 1) per_cu = 1;
        grid_blocks = cus * per_cu;
        if (grid_blocks > 256) grid_blocks = 256;
        if (ws_size < W_END) fprintf(stderr, "kernel_launch: workspace too small: %zu < %zu\n", ws_size, (size_t)W_END);
    }
    Params p{};
    for (int i = 0; i < 31; ++i) p.in[i] = (const float*)d_in[i];
    p.out = (float*)d_out; p.ws = (unsigned char*)d_ws;
    hipMemsetAsync((unsigned char*)d_ws + W_BAR, 0, XCD_BAR_WORDS * 4, stream);
    int ph0 = 0, ph1 = NPHASE, coop = 1;
    void* args[] = {&p, &ph0, &ph1, &coop};
    hipError_t e = hipLaunchCooperativeKernel((const void*)mega, dim3(grid_blocks), dim3(512), args, LDS_BYTES + 16, stream);
    if (e != hipSuccess) fprintf(stderr, "cooperative launch failed: %s (grid %d)\n", hipGetErrorString(e), grid_blocks);
}
```

```cpp
#include <hip/hip_runtime.h>
#include <hip/hip_cooperative_groups.h>
#include <cstdio>
namespace cg = cooperative_groups;

#define LAS __attribute__((address_space(3)))
typedef unsigned short bf16_t;
typedef short bf16x8 __attribute__((ext_vector_type(8)));
typedef short s16x4 __attribute__((ext_vector_type(4)));
typedef float f32x4 __attribute__((ext_vector_type(4)));
typedef float f32x2 __attribute__((ext_vector_type(2)));
typedef unsigned u32x4 __attribute__((ext_vector_type(4)));
typedef unsigned u32x2 __attribute__((ext_vector_type(2)));

constexpr int DM = 1024, NB = 8, SEQ = 2048, DEPTH = 4, NS = 128;
constexpr int TP = NB * SEQ;
constexpr int TT = TP + NS;
constexpr int DLRU = 512, DIN = 4104, NPROJ = 4096, DMIX = 1536, DFF = 2816, DGU = 5632;
constexpr int NCH = 32;
constexpr float EPS = 1e-6f;
constexpr int PC_LX = 0, PC_LG = 512, PC_Q = 1024, PC_K = 1280, PC_V = 1536, PC_RG = 2048, PC_Z = 2560, PC_XBC = 3072;

constexpr size_t O_Y = 0;
constexpr size_t O_LCP = (size_t)TT * DM;
constexpr size_t O_LCS = O_LCP + (size_t)DEPTH * NB * 3 * 512;
constexpr size_t O_LHP = O_LCS + (size_t)DEPTH * NS * 3 * 512;
constexpr size_t O_LHS = O_LHP + (size_t)DEPTH * NB * 512;
constexpr size_t O_RP = O_LHS + (size_t)DEPTH * NS * 512;
constexpr size_t O_RS = O_RP + (size_t)DEPTH * NB * 4 * 64 * 128;
constexpr size_t O_SCP = O_RS + (size_t)DEPTH * NS * 4 * 64 * 128;
constexpr size_t O_SCS = O_SCP + (size_t)DEPTH * NB * 3 * 1024;
constexpr size_t O_SP = O_SCS + (size_t)DEPTH * NS * 3 * 1024;
constexpr size_t O_SS = O_SP + (size_t)DEPTH * NB * 8 * 64 * 128;
constexpr size_t O_FCP = O_SS + (size_t)DEPTH * NS * 8 * 64 * 128;
constexpr size_t O_FCS = O_FCP + (size_t)DEPTH * NB * 2 * DFF;

constexpr size_t W_WIN = 0;
constexpr size_t W_WOUT = W_WIN + (size_t)DEPTH * NPROJ * DM * 2;
constexpr size_t W_WUP = W_WOUT + (size_t)DEPTH * DM * DMIX * 2;
constexpr size_t W_WDOWN = W_WUP + (size_t)DEPTH * DGU * DM * 2;
constexpr size_t W_LRUW = W_WDOWN + (size_t)DEPTH * DM * DFF * 2;
constexpr size_t W_ROPE = W_LRUW + (size_t)2 * DEPTH * 8 * 64 * 64 * 2;
constexpr size_t W_DT = W_ROPE + 524800;
constexpr size_t W_LRUAB = W_DT + (size_t)TT * 8 * 4;
constexpr size_t W_LRUHIN = W_LRUAB + (size_t)NB * NCH * 512 * 2 * 4;
constexpr size_t W_DEC = W_LRUHIN + (size_t)NB * NCH * 512 * 4;
constexpr size_t W_RSS = W_DEC + 8192;
constexpr size_t W_WDT = W_RSS + (size_t)9 * TT * 8;
constexpr size_t W_HB = W_WDT + (size_t)DEPTH * 16 * DM * 2;
constexpr size_t W_XB = W_HB + (size_t)TT * DMIX * 2;
constexpr size_t W_PROJ = W_XB + (size_t)TT * DM * 2;
constexpr size_t W_SPR = W_PROJ + (size_t)TT * NPROJ * 2;
constexpr size_t W_SPS = W_SPR + (size_t)NB * 4 * NCH * 8192 * 2;
static_assert(W_SPS + (size_t)NB * 8 * NCH * 8192 * 2 <= W_PROJ + (size_t)TT * DGU * 2, "Sp does not fit behind proj");
constexpr size_t W_DS = W_PROJ + (size_t)TT * DGU * 2;
constexpr size_t W_DSSSD = W_DS + (size_t)NB * 4 * NCH * 8192 * 4;
constexpr size_t W_BAR = W_DSSSD + (size_t)NB * 8 * NCH * 8192 * 4;
constexpr size_t W_GS01 = W_BAR + 16384;
constexpr size_t W_US01 = W_GS01 + (size_t)256 * 2 * DFF * 2;
constexpr size_t W_GS23 = W_US01 + (size_t)256 * 2 * DFF * 2;
constexpr size_t W_END = W_GS23 + (size_t)256 * 2 * DFF * 2;
static_assert(W_END <= (size_t)512 * 1024 * 1024, "workspace budget");
constexpr int LDS_BYTES = 131072;

struct Params { const float* in[31]; float* out; unsigned char* ws; };

typedef unsigned long long u64;
__device__ __forceinline__ u64 ss_fix(float ss) { return (u64)(ss * 1048576.f + 0.5f); }
__device__ __forceinline__ float rstd_fix(u64 v) { return rsqrtf((float)v * (1.f / (1048576.f * 1024.f)) + 1e-6f); }
__device__ __forceinline__ int opaque_tid() { int t = threadIdx.x; asm volatile("" : "+v"(t)); return t; }
#define TIDX opaque_tid()
__device__ __forceinline__ float bf2f(bf16_t v) { return __uint_as_float(((unsigned)v) << 16); }
__device__ __forceinline__ unsigned pk2(float lo, float hi) { unsigned r; asm volatile("v_cvt_pk_bf16_f32 %0, %1, %2" : "=v"(r) : "v"(lo), "v"(hi)); return r; }
__device__ __forceinline__ bf16_t f2bf(float f) { return (bf16_t)(pk2(f, 0.f) & 0xffffu); }
__device__ __forceinline__ void unpack8(u32x4 w, float* f) {
    f[0] = __uint_as_float(w.x << 16); f[1] = __uint_as_float(w.x & 0xffff0000u);
    f[2] = __uint_as_float(w.y << 16); f[3] = __uint_as_float(w.y & 0xffff0000u);
    f[4] = __uint_as_float(w.z << 16); f[5] = __uint_as_float(w.z & 0xffff0000u);
    f[6] = __uint_as_float(w.w << 16); f[7] = __uint_as_float(w.w & 0xffff0000u);
}
__device__ __forceinline__ void unpack4(u32x2 w, float* f) {
    f[0] = __uint_as_float(w.x << 16); f[1] = __uint_as_float(w.x & 0xffff0000u);
    f[2] = __uint_as_float(w.y << 16); f[3] = __uint_as_float(w.y & 0xffff0000u);
}
__device__ __forceinline__ u32x4 pack8(const float* f) { u32x4 w; w.x = pk2(f[0], f[1]); w.y = pk2(f[2], f[3]); w.z = pk2(f[4], f[5]); w.w = pk2(f[6], f[7]); return w; }
__device__ __forceinline__ float fexp_(float x) { return __builtin_amdgcn_exp2f(x * 1.44269504089f); }
__device__ __forceinline__ float sigmoidf_(float x) { return __builtin_amdgcn_rcpf(1.f + fexp_(-x)); }
__device__ __forceinline__ float siluf_(float x) { return x * __builtin_amdgcn_rcpf(1.f + fexp_(-x)); }
__device__ __forceinline__ float geluf_(float x) { const float u = 0.7978845608028654f * (x + 0.044715f * x * x * x); return x * (1.f - __builtin_amdgcn_rcpf(1.f + fexp_(2.f * u))); }
__device__ __forceinline__ float softplusf_(float x) { return x > 20.f ? x : log1pf(fexp_(x)); }
__device__ __forceinline__ float shfl_idx(float v, int src) { return __int_as_float(__builtin_amdgcn_ds_bpermute(src << 2, __float_as_int(v))); }
__device__ __forceinline__ float shfl_xor_(float v, int o, int lane) { return shfl_idx(v, lane ^ o); }
__device__ __forceinline__ float shfl_up_(float v, int o, int lane) { return shfl_idx(v, (lane - o) & 63); }
__device__ __forceinline__ float wave_sum(float v, int lane) {
#pragma unroll
    for (int o = 32; o >= 1; o >>= 1) v += shfl_xor_(v, o, lane);
    return v;
}
template <int N> __device__ __forceinline__ float dpp_shr(float old, float src) { return __int_as_float(__builtin_amdgcn_update_dpp(__float_as_int(old), __float_as_int(src), 0x110 + N, 0xf, 0xf, false)); }
template <int N> __device__ __forceinline__ float dpp_ror(float src) { return __int_as_float(__builtin_amdgcn_update_dpp(0, __float_as_int(src), 0x120 + N, 0xf, 0xf, false)); }
__device__ __forceinline__ bf16x8 frag_row(const LAS bf16_t* t, int ld, int r0, int k0, int fr, int fq) {
    return *(const LAS bf16x8*)(t + (r0 + fr) * ld + k0 + 8 * fq);
}
__device__ __forceinline__ bf16x8 frag_tr(const LAS bf16_t* t, int ld, int k0, int c0, int fr, int fq) {
    const LAS bf16_t* p = t + (k0 + 8 * fq + (fr >> 2)) * ld + c0 + 4 * (fr & 3);
    s16x4 lo = __builtin_bit_cast(s16x4, __builtin_amdgcn_ds_read_tr16_b64_v4i16((LAS s16x4*)p));
    s16x4 hi = __builtin_bit_cast(s16x4, __builtin_amdgcn_ds_read_tr16_b64_v4i16((LAS s16x4*)(p + 4 * ld)));
    bf16x8 r; r[0] = lo[0]; r[1] = lo[1]; r[2] = lo[2]; r[3] = lo[3]; r[4] = hi[0]; r[5] = hi[1]; r[6] = hi[2]; r[7] = hi[3]; return r;
}
#define MFMA(X, Y, C) __builtin_amdgcn_mfma_f32_16x16x32_bf16((X), (Y), (C), 0, 0, 0)

namespace pg8 {
constexpr int BM = 256, BK = 64, HALF = 128, HTB = HALF * BK * 2, NXCD = 8, WGM = 8;
__device__ __forceinline__ int lds_byte(int r, int c) { const int st = (r >> 4) * 2 + (c >> 5), rr = r & 15, cc = c & 31, ob = rr * 64 + cc * 2; return st * 1024 + (ob ^ (((ob >> 9) & 1) << 5)); }
__device__ __forceinline__ void stage_rc(int b, int& R, int& C) { const int st = b / 1024, sb = b % 1024, swz = sb ^ (((sb >> 9) & 1) << 5); R = (st >> 1) * 16 + swz / 64; C = (st & 1) * 32 + (swz % 64) / 2; }
__device__ __forceinline__ int perm32(int rho) { const int n = rho >> 4, i = rho & 15; return 8 * (i >> 2) + 4 * n + (i & 3); }
struct Unit { int pm, pn; };
struct Gemm { const bf16_t* A; const bf16_t* Bt; int M, N, K; };
struct StaticOrder {
    int nM, nN, nwg, G, c;
    __device__ void init(int M, int N, int G_, int c_) { nM = M / BM; nN = N / BM; nwg = nM * nN; G = G_; c = c_; }
    __device__ bool next(int i, Unit& u) const {
        const long L = (long)i * G + c; if (L >= nwg) return false;
        int wgid = (int)L; { const int q = nwg / NXCD, r = nwg % NXCD, xcd = wgid % NXCD, off = wgid / NXCD; wgid = (xcd < r ? xcd * (q + 1) : r * (q + 1) + (xcd - r) * q) + off; }
        const int nig = WGM * nN, gid = wgid / nig, fm = gid * WGM, gsz = (nM - fm) < WGM ? (nM - fm) : WGM;
        u.pm = fm + ((wgid % nig) % gsz); u.pn = (wgid % nig) / gsz; return true;
    }
};
template <class Epi>
__device__ __forceinline__ void gemm_phase(LAS unsigned char* lds, const Gemm g, const StaticOrder& S, const Epi& E) {
    const int tid = TIDX, wid = __builtin_amdgcn_readfirstlane(tid >> 6), lane = tid & 63, wr = wid >> 2, wc = wid & 3, fr = lane & 15, fq = lane >> 4;
    const int K = g.K, nt = K / BK;
    unsigned voffA[2], voffB[2];
#pragma unroll
    for (int i = 0; i < 2; ++i) { int R, C; stage_rc(tid * 16 + i * 8192, R, C); const int Rb = Epi::PERM ? ((R & ~31) + perm32(R & 31)) : R;
        voffA[i] = (unsigned)(R * K + C) * 2u; voffB[i] = (unsigned)(Rb * K + C) * 2u; }
    const size_t kstep = (size_t)(BK * 2);
    const size_t hstep = (size_t)HALF * K * 2;
    const size_t tstep = 2 * hstep;
    const unsigned ldsw = (unsigned)wid * 1024u;
    const int aoff = lds_byte(wr * 64 + fr, fq * 8), boff = lds_byte(wc * 32 + fr, fq * 8);
#define PG8_SA(b, h) (((b) * 2 + (h)) * HTB)
#define PG8_SB(b, h) ((4 + (b) * 2 + (h)) * HTB)
#define PG8_STAGE(bufoff, gbase, voff) do { _Pragma("unroll") for (int _i = 0; _i < 2; ++_i) \
        __builtin_amdgcn_global_load_lds((const unsigned*)((const char*)(gbase) + (voff)[_i]), (LAS unsigned*)(lds + (bufoff) + ldsw + _i * 8192), 16, 0, 0); } while (0)
#define PG8_LDA(dst, b, h) do { _Pragma("unroll") for (int m = 0; m < 4; ++m) _Pragma("unroll") for (int k = 0; k < 2; ++k) dst[m][k] = *(const LAS bf16x8*)(lds + PG8_SA(b, h) + aoff + m * 2048 + k * 1024); } while (0)
#define PG8_LDB(dst, b, h) do { _Pragma("unroll") for (int n = 0; n < 2; ++n) _Pragma("unroll") for (int k = 0; k < 2; ++k) dst[n][k] = *(const LAS bf16x8*)(lds + PG8_SB(b, h) + boff + n * 2048 + k * 1024); } while (0)
#define PG8_MMA(ai, bj, At, Bt) do { __builtin_amdgcn_s_setprio(1); _Pragma("unroll") for (int m = 0; m < 4; ++m) _Pragma("unroll") for (int n = 0; n < 2; ++n) _Pragma("unroll") for (int k = 0; k < 2; ++k) \
        acc[ai][bj][m][n] = __builtin_amdgcn_mfma_f32_16x16x32_bf16(Bt[n][k], At[m][k], acc[ai][bj][m][n], 0, 0, 0); __builtin_amdgcn_s_setprio(0); } while (0)
#define PG8_WAIT_V(n) asm volatile("s_waitcnt vmcnt(" #n ")" ::: "memory")
#define PG8_WAIT_L(n) asm volatile("s_waitcnt lgkmcnt(" #n ")" ::: "memory")
#define PG8_BAR __builtin_amdgcn_s_barrier()
#define PG8_SCHED __builtin_amdgcn_sched_barrier(0)
    Unit cur, nxt; int ui = 0;
    if (!S.next(0, cur)) return;
    f32x4 acc[2][2][4][2];
#pragma unroll
    for (int a = 0; a < 2; ++a)
#pragma unroll
        for (int b = 0; b < 2; ++b)
#pragma unroll
            for (int m = 0; m < 4; ++m)
#pragma unroll
                for (int n = 0; n < 2; ++n) acc[a][b][m][n] = (f32x4){0.f, 0.f, 0.f, 0.f};
    bf16x8 At[4][2], B0[2][2], B1[2][2];
    const char* cA = (const char*)g.A + (size_t)cur.pm * tstep; const char* cB = (const char*)g.Bt + (size_t)cur.pn * tstep;
    PG8_STAGE(PG8_SB(0, 0), cB, voffB); PG8_STAGE(PG8_SA(0, 0), cA, voffA); PG8_STAGE(PG8_SB(0, 1), cB + hstep, voffB); PG8_STAGE(PG8_SA(0, 1), cA + hstep, voffA);
    if (wr == 1) PG8_BAR;
    PG8_WAIT_V(4); PG8_BAR;
    PG8_STAGE(PG8_SB(1, 0), cB + kstep, voffB); PG8_STAGE(PG8_SA(1, 0), cA + kstep, voffA); PG8_STAGE(PG8_SB(1, 1), cB + hstep + kstep, voffB);
    PG8_WAIT_V(6); PG8_BAR;
    for (;;) {
        const bool has_next = S.next(ui + 1, nxt);
        const char* nA = has_next ? (const char*)g.A + (size_t)nxt.pm * tstep : cA; const char* nB = has_next ? (const char*)g.Bt + (size_t)nxt.pn * tstep : cB;
        for (int t = 0; t < nt; t += 2) {
            const bool last = (t == nt - 2);
            const char* a1 = cA + (size_t)(t + 1) * kstep;
            const char* a2 = last ? nA : cA + (size_t)(t + 2) * kstep; const char* b2 = last ? nB : cB + (size_t)(t + 2) * kstep;
            const char* a3 = a2 + kstep; const char* b3 = b2 + kstep;
            PG8_LDB(B0, 0, 0); PG8_SCHED; PG8_LDA(At, 0, 0); PG8_STAGE(PG8_SA(1, 1), a1 + hstep, voffA);
            PG8_WAIT_L(8); PG8_BAR; PG8_WAIT_L(0); PG8_MMA(0, 0, At, B0); PG8_BAR; PG8_SCHED;
            PG8_LDB(B1, 0, 1); PG8_STAGE(PG8_SB(0, 0), b2, voffB);
            PG8_BAR; PG8_WAIT_L(0); PG8_MMA(0, 1, At, B1); PG8_BAR;
            PG8_LDA(At, 0, 1); PG8_STAGE(PG8_SA(0, 0), a2, voffA);
            PG8_BAR; PG8_WAIT_L(0); PG8_MMA(1, 0, At, B0); PG8_BAR; PG8_SCHED;
            PG8_STAGE(PG8_SB(0, 1), b2 + hstep, voffB);
            PG8_WAIT_V(6); PG8_BAR; PG8_MMA(1, 1, At, B1); PG8_BAR;
            PG8_LDB(B0, 1, 0); PG8_SCHED; PG8_LDA(At, 1, 0); PG8_STAGE(PG8_SA(0, 1), a2 + hstep, voffA);
            PG8_WAIT_L(8); PG8_BAR; PG8_WAIT_L(0); PG8_MMA(0, 0, At, B0); PG8_BAR; PG8_SCHED;
            PG8_LDB(B1, 1, 1); PG8_STAGE(PG8_SB(1, 0), b3, voffB);
            PG8_BAR; PG8_WAIT_L(0); PG8_MMA(0, 1, At, B1); PG8_BAR;
            PG8_LDA(At, 1, 1); PG8_STAGE(PG8_SA(1, 0), a3, voffA);
            PG8_BAR; PG8_WAIT_L(0); PG8_MMA(1, 0, At, B0); PG8_BAR; PG8_SCHED;
            PG8_STAGE(PG8_SB(1, 1), b3 + hstep, voffB);
            PG8_WAIT_V(6); PG8_BAR; PG8_MMA(1, 1, At, B1); PG8_BAR;
        }
        if constexpr (Epi::AFTER_DRAIN) { if (has_next) E(acc, cur, wr, wc, fr, fq); } else E(acc, cur, wr, wc, fr, fq);
        if (!has_next) break;
#pragma unroll
        for (int a = 0; a < 2; ++a)
#pragma unroll
            for (int b = 0; b < 2; ++b)
#pragma unroll
                for (int m = 0; m < 4; ++m)
#pragma unroll
                    for (int n = 0; n < 2; ++n) acc[a][b][m][n] = (f32x4){0.f, 0.f, 0.f, 0.f};
        cur = nxt; cA = nA; cB = nB; ++ui;
    }
    PG8_WAIT_V(0);
    if (wr == 0) PG8_BAR;
    PG8_BAR;
    if constexpr (Epi::AFTER_DRAIN) E.fused(acc, cur, wr, wc, fr, fq, lds, wid, lane);
#undef PG8_SA
#undef PG8_SB
#undef PG8_STAGE
#undef PG8_LDA
#undef PG8_LDB
#undef PG8_MMA
#undef PG8_WAIT_V
#undef PG8_WAIT_L
#undef PG8_BAR
#undef PG8_SCHED
}
struct EpiBf16 {
    static constexpr bool PERM = true, AFTER_DRAIN = false;
    bf16_t* O; int ldc; const u64* rss;
    __device__ __forceinline__ void operator()(const f32x4 (&acc)[2][2][4][2], const Unit& u, int wr, int wc, int fr, int fq) const {
        const int row0 = u.pm * BM + wr * 64 + fr, col0 = u.pn * BM + wc * 32 + 8 * fq;
        u64 rv[2][4];
#pragma unroll
        for (int ai = 0; ai < 2; ++ai)
#pragma unroll
            for (int m = 0; m < 4; ++m) rv[ai][m] = rss[row0 + ai * HALF + m * 16];
#pragma unroll
        for (int ai = 0; ai < 2; ++ai)
#pragma unroll
            for (int m = 0; m < 4; ++m) { const int row = row0 + ai * HALF + m * 16; bf16_t* rowp = O + (size_t)row * ldc + col0;
                const float rs = rstd_fix(rv[ai][m]);
#pragma unroll
                for (int bj = 0; bj < 2; ++bj) { const f32x4 v0 = acc[ai][bj][m][0] * rs, v1 = acc[ai][bj][m][1] * rs;
                    u32x4 w; w.x = pk2(v0[0], v0[1]); w.y = pk2(v0[2], v0[3]); w.z = pk2(v1[0], v1[1]); w.w = pk2(v1[2], v1[3]);
                    *(u32x4*)(rowp + bj * HALF) = w; } }
    }
};
struct EpiResid {
    static constexpr bool PERM = false, AFTER_DRAIN = true;
    int ldc; bf16_t* xb; u64* rss;
    __device__ __forceinline__ void operator()(const f32x4 (&acc)[2][2][4][2], const Unit& u, int wr, int wc, int fr, int fq) const {
        const int row0 = u.pm * BM + wr * 64 + fr, col0 = u.pn * BM + wc * 32 + 4 * fq, lane = fr | (fq << 4);
#pragma unroll
        for (int ai = 0; ai < 2; ++ai)
#pragma unroll
            for (int m = 0; m < 4; ++m) { const int row = row0 + ai * HALF + m * 16; bf16_t* xbp = xb + (size_t)row * ldc + col0;
                float ss = 0.f;
#pragma unroll
                for (int bj = 0; bj < 2; ++bj)
#pragma unroll
                    for (int n = 0; n < 2; ++n) { u32x2* pp = (u32x2*)(xbp + bj * HALF + n * 16); float o[4]; unpack4(*pp, o);
                        u32x2 w; w.x = pk2(o[0] + acc[ai][bj][m][n][0], o[1] + acc[ai][bj][m][n][1]); w.y = pk2(o[2] + acc[ai][bj][m][n][2], o[3] + acc[ai][bj][m][n][3]); *pp = w;
                        unpack4(w, o); ss += o[0] * o[0] + o[1] * o[1] + o[2] * o[2] + o[3] * o[3]; }
                ss += shfl_xor_(ss, 16, lane); ss += shfl_xor_(ss, 32, lane);
                if (fq == 0) atomicAdd(rss + row, ss_fix(ss)); }
    }
    __device__ __forceinline__ void fused(const f32x4 (&acc)[2][2][4][2], const Unit& u, int wr, int wc, int fr, int fq, LAS unsigned char* lds, int wid, int lane) const {
        LAS f32x4* t = (LAS f32x4*)lds;
#pragma unroll
        for (int ai = 0; ai < 2; ++ai) {
            const int rbase = u.pm * BM + ai * HALF + wid * 16, col = u.pn * BM + lane * 4;
            u32x2 xv[16];
#pragma unroll
            for (int i = 0; i < 16; ++i) xv[i] = *(const u32x2*)(xb + (size_t)(rbase + i) * ldc + col);
#pragma unroll
            for (int m = 0; m < 4; ++m)
#pragma unroll
                for (int bj = 0; bj < 2; ++bj)
#pragma unroll
                    for (int n = 0; n < 2; ++n) { const int r = 64 * wr + 16 * m + fr, chunk = 32 * bj + 8 * wc + 4 * n + fq; t[r * 64 + (chunk ^ (r & 15))] = acc[ai][bj][m][n]; }
            __syncthreads();
            float myss = 0.f;
#pragma unroll
            for (int i = 0; i < 16; ++i) { const int r = wid * 16 + i;
                const f32x4 a = t[r * 64 + (lane ^ (r & 15))]; float o[4]; unpack4(xv[i], o);
                u32x2 w; w.x = pk2(o[0] + a[0], o[1] + a[1]); w.y = pk2(o[2] + a[2], o[3] + a[3]); *(u32x2*)(xb + (size_t)(rbase + i) * ldc + col) = w;
                unpack4(w, o);
                const float ss = wave_sum(o[0] * o[0] + o[1] * o[1] + o[2] * o[2] + o[3] * o[3], lane);
                if (lane == i) myss = ss; }
            if (lane < 16) atomicAdd(rss + rbase + lane, ss_fix(myss));
            __syncthreads();
        }
    }
};
struct EpiAct {
    static constexpr bool PERM = true, AFTER_DRAIN = false;
    bf16_t* act; const u64* rss; const float* cw; const float* cb; bf16_t* gs01; bf16_t* us01; bf16_t* gs23; float* fcp;
    __device__ __forceinline__ void operator()(const f32x4 (&acc)[2][2][4][2], const Unit& u, int wr, int wc, int fr, int fq) const {
        const int row0 = u.pm * BM + wr * 64 + fr, f0 = u.pn * HALF + wc * 32 + 8 * fq;
        float w0[8], w1[8], w2[8], bb[8];
        *(f32x4*)w0 = *(const f32x4*)(cw + f0); *(f32x4*)(w0 + 4) = *(const f32x4*)(cw + f0 + 4);
        *(f32x4*)w1 = *(const f32x4*)(cw + DFF + f0); *(f32x4*)(w1 + 4) = *(const f32x4*)(cw + DFF + f0 + 4);
        *(f32x4*)w2 = *(const f32x4*)(cw + 2 * DFF + f0); *(f32x4*)(w2 + 4) = *(const f32x4*)(cw + 2 * DFF + f0 + 4);
        *(f32x4*)bb = *(const f32x4*)(cb + f0); *(f32x4*)(bb + 4) = *(const f32x4*)(cb + f0 + 4);
        u64 rv[2][4];
#pragma unroll
        for (int ai = 0; ai < 2; ++ai)
#pragma unroll
            for (int m = 0; m < 4; ++m) rv[ai][m] = rss[row0 + ai * HALF + m * 16];
#pragma unroll
        for (int ai = 0; ai < 2; ++ai) {
            float gp[8];
#pragma unroll
            for (int e = 0; e < 8; ++e) gp[e] = 0.f;
#pragma unroll
            for (int m = 0; m < 4; ++m) {
                const int row = row0 + ai * HALF + m * 16;
                const float rs = rstd_fix(rv[ai][m]);
                float g[8], up[8], o[8];
#pragma unroll
                for (int e = 0; e < 8; ++e) { g[e] = acc[ai][0][m][e >> 2][e & 3] * rs; up[e] = acc[ai][1][m][e >> 2][e & 3] * rs; }
#pragma unroll
                for (int e = 0; e < 8; ++e) {
                    const float g1 = dpp_shr<1>(dpp_ror<1>(gp[e]), g[e]);
                    const float g2 = dpp_shr<2>(dpp_ror<2>(gp[e]), g[e]);
                    const float y = bb[e] + w0[e] * g2 + w1[e] * g1 + w2[e] * g[e];
                    o[e] = geluf_(y) * up[e];
                }
                if (m == 0 && fr < 2) {
                    const size_t so = ((size_t)(row >> 6) * 2 + fr) * DFF + f0;
                    *(u32x4*)(gs01 + so) = pack8(g); *(u32x4*)(us01 + so) = pack8(up);
                } else *(u32x4*)(act + (size_t)row * DFF + f0) = pack8(o);
                if (m == 3 && fr >= 14) *(u32x4*)(gs23 + ((size_t)(row >> 6) * 2 + (fr - 14)) * DFF + f0) = pack8(g);
                const int ts = row & (SEQ - 1);
                if (ts >= SEQ - 2) { float* fo = fcp + ((size_t)(row >> 11) * 2 + (ts - (SEQ - 2))) * DFF + f0;
                    *(f32x4*)fo = (f32x4){g[0], g[1], g[2], g[3]}; *(f32x4*)(fo + 4) = (f32x4){g[4], g[5], g[6], g[7]}; }
#pragma unroll
                for (int e = 0; e < 8; ++e) gp[e] = g[e];
            }
        }
    }
};
struct EpiDry {
    static constexpr bool PERM = false, AFTER_DRAIN = false;
    float* C;
    __device__ __forceinline__ void operator()(const f32x4 (&acc)[2][2][4][2], const Unit& u, int wr, int wc, int fr, int fq) const {
        float s = 0.f;
#pragma unroll
        for (int ai = 0; ai < 2; ++ai)
#pragma unroll
            for (int bj = 0; bj < 2; ++bj)
#pragma unroll
                for (int m = 0; m < 4; ++m)
#pragma unroll
                    for (int n = 0; n < 2; ++n) s += acc[ai][bj][m][n][0] + acc[ai][bj][m][n][1] + acc[ai][bj][m][n][2] + acc[ai][bj][m][n][3];
        if (s != s) C[0] = s;
    }
};
}

template <int K, int MODE  >
__device__ __forceinline__ void thin_gemm(LAS unsigned char* lds, const bf16_t* A, const bf16_t* Bt, int N, void* out, int ldc, bf16_t* xb, u64* rss) {
    const int tid = TIDX, wid = tid >> 6, lane = tid & 63, fr = lane & 15, fq = lane >> 4;
    constexpr int KW = K / 8, STEPS = KW / 32;
    const int ntask = (N / 16) * 8;
    LAS f32x4* red = (LAS f32x4*)lds;
    const int per = (ntask + (int)gridDim.x - 1) / (int)gridDim.x, t0 = blockIdx.x * per, t1 = min(ntask, t0 + per);
    for (int base = t0; base < t1; base += 8) {
        const int nr = min(8, t1 - base);
#pragma unroll (STEPS <= 4 ? 4 : 2)
        for (int i = 0; i < nr; ++i) {
            const int t = base + i, ct = t >> 3, rt = t & 7;
            const bf16_t* ap = A + (size_t)(rt * 16 + fr) * K + wid * KW + 8 * fq;
            const bf16_t* bp = Bt + (size_t)(ct * 16 + fr) * K + wid * KW + 8 * fq;
            bf16x8 a[STEPS], b[STEPS];
#pragma unroll
            for (int s = 0; s < STEPS; ++s) { a[s] = *(const bf16x8*)(ap + 32 * s); b[s] = *(const bf16x8*)(bp + 32 * s); }
            f32x4 acc = {0.f, 0.f, 0.f, 0.f};
#pragma unroll
            for (int s = 0; s < STEPS; ++s) acc = MFMA(b[s], a[s], acc);
            red[(i * 8 + wid) * 64 + lane] = acc;
        }
        __syncthreads();
        if (wid < nr) {
            const int t = base + wid, ct = t >> 3, rt = t & 7;
            f32x4 s = red[(wid * 8) * 64 + lane];
#pragma unroll
            for (int w = 1; w < 8; ++w) s = s + red[(wid * 8 + w) * 64 + lane];
            const int row = rt * 16 + fr, col = ct * 16 + 4 * fq;
            if (MODE == 0) { const float rs = rstd_fix(rss[row]);
                u32x2 w2; w2.x = pk2(s[0] * rs, s[1] * rs); w2.y = pk2(s[2] * rs, s[3] * rs); *(u32x2*)((bf16_t*)out + (size_t)row * ldc + col) = w2; }
            else { u32x2* pp = (u32x2*)(xb + (size_t)row * ldc + col); float o[4]; unpack4(*pp, o);
                u32x2 w2; w2.x = pk2(o[0] + s[0], o[1] + s[1]); w2.y = pk2(o[2] + s[2], o[3] + s[3]); *pp = w2;
                unpack4(w2, o);
                float ss = o[0] * o[0] + o[1] * o[1] + o[2] * o[2] + o[3] * o[3];
                ss += shfl_xor_(ss, 16, lane); ss += shfl_xor_(ss, 32, lane);
                if (fq == 0) atomicAdd(rss + row, ss_fix(ss)); }
        }
        __syncthreads();
    }
}

__device__ __forceinline__ void thin_gemm_act(LAS unsigned char* lds, const bf16_t* A, const bf16_t* Bt, const u64* rss, const float* cw, const float* cb, const float* st, float* fo, bf16_t* act) {
    const int tid = TIDX, wid = tid >> 6, lane = tid & 63, fr = lane & 15, fq = lane >> 4;
    constexpr int K = DM, KW = K / 8, STEPS = KW / 32;
    const int ntask = (DFF / 16) * 8;
    LAS f32x4* red = (LAS f32x4*)lds;
    const int per = (ntask + (int)gridDim.x - 1) / (int)gridDim.x, t0 = blockIdx.x * per, t1 = min(ntask, t0 + per);
    for (int base = t0; base < t1; base += 8) {
        const int nr = min(8, t1 - base);
#pragma unroll 2
        for (int i = 0; i < nr; ++i) {
            const int t = base + i, ft = t >> 3, rt = t & 7;
            const int f = ft * 16 + fr, wrow = 256 * (f >> 7) + (f & 127);
            const bf16_t* ap = A + (size_t)(rt * 16 + fr) * K + wid * KW + 8 * fq;
            const bf16_t* bg = Bt + (size_t)wrow * K + wid * KW + 8 * fq;
            const bf16_t* bu = bg + (size_t)128 * K;
            bf16x8 a[STEPS], b1[STEPS], b2[STEPS];
#pragma unroll
            for (int s = 0; s < STEPS; ++s) { a[s] = *(const bf16x8*)(ap + 32 * s); b1[s] = *(const bf16x8*)(bg + 32 * s); b2[s] = *(const bf16x8*)(bu + 32 * s); }
            f32x4 ag = {0.f, 0.f, 0.f, 0.f}, au = {0.f, 0.f, 0.f, 0.f};
#pragma unroll
            for (int s = 0; s < STEPS; ++s) { ag = MFMA(b1[s], a[s], ag); au = MFMA(b2[s], a[s], au); }
            red[(i * 8 + wid) * 64 + lane] = ag; red[4096 + (i * 8 + wid) * 64 + lane] = au;
        }
        __syncthreads();
        if (wid < nr) {
            const int t = base + wid, ft = t >> 3, rt = t & 7;
            f32x4 g = red[(wid * 8) * 64 + lane], up = red[4096 + (wid * 8) * 64 + lane];
#pragma unroll
            for (int w = 1; w < 8; ++w) { g = g + red[(wid * 8 + w) * 64 + lane]; up = up + red[4096 + (wid * 8 + w) * 64 + lane]; }
            const int s = rt * 16 + fr, f = ft * 16 + 4 * fq;
            const float rs = rstd_fix(rss[s]);
            g = g * rs; up = up * rs;
            const f32x4 p0 = *(const f32x4*)(st + ((size_t)s * 2 + 0) * DFF + f), p1 = *(const f32x4*)(st + ((size_t)s * 2 + 1) * DFF + f);
            const f32x4 c0 = *(const f32x4*)(cw + f), c1 = *(const f32x4*)(cw + DFF + f), c2 = *(const f32x4*)(cw + 2 * DFF + f), cbv = *(const f32x4*)(cb + f);
            float o[4];
#pragma unroll
            for (int e = 0; e < 4; ++e) o[e] = geluf_(cbv[e] + c0[e] * p0[e] + c1[e] * p1[e] + c2[e] * g[e]) * up[e];
            u32x2 w2; w2.x = pk2(o[0], o[1]); w2.y = pk2(o[2], o[3]); *(u32x2*)(act + (size_t)s * DFF + f) = w2;
            *(f32x4*)(fo + ((size_t)s * 2 + 0) * DFF + f) = p1; *(f32x4*)(fo + ((size_t)s * 2 + 1) * DFF + f) = g;
        }
        __syncthreads();
    }
}
__device__ __forceinline__ void act_fixup(const Params& p, int l, int pm) {
    const bf16_t* gs01 = (const bf16_t*)(p.ws + W_GS01); const bf16_t* us01 = (const bf16_t*)(p.ws + W_US01); const bf16_t* gs23 = (const bf16_t*)(p.ws + W_GS23);
    bf16_t* act = (bf16_t*)(p.ws + W_DS);
    const float* cw = p.in[27] + (size_t)l * 3 * DFF; const float* cb = p.in[28] + (size_t)l * DFF;
    const int tid = TIDX;
    constexpr int NU = 8 * (DFF / 8), NK = (NU + 511) / 512;
    u32x4 rg[NK], ru[NK], r1[NK], r2[NK];
#pragma unroll
    for (int k = 0; k < NK; ++k) {
        const int idx = tid + 512 * k;
        rg[k] = ru[k] = r1[k] = r2[k] = (u32x4){0u, 0u, 0u, 0u};
        if (idx < NU) {
            const int rsel = idx / (DFF / 8), c0 = (idx % (DFF / 8)) * 8, blk = pm * 4 + (rsel >> 1), rr = rsel & 1;
            const bool seq0 = (blk & 31) == 0;
            rg[k] = *(const u32x4*)(gs01 + ((size_t)blk * 2 + rr) * DFF + c0);
            ru[k] = *(const u32x4*)(us01 + ((size_t)blk * 2 + rr) * DFF + c0);
            if (rr == 0) { if (!seq0) { r1[k] = *(const u32x4*)(gs23 + ((size_t)(blk - 1) * 2 + 1) * DFF + c0); r2[k] = *(const u32x4*)(gs23 + ((size_t)(blk - 1) * 2 + 0) * DFF + c0); } }
            else { r1[k] = *(const u32x4*)(gs01 + ((size_t)blk * 2 + 0) * DFF + c0); if (!seq0) r2[k] = *(const u32x4*)(gs23 + ((size_t)(blk - 1) * 2 + 1) * DFF + c0); }
        }
    }
#pragma unroll
    for (int k = 0; k < NK; ++k) {
        const int idx = tid + 512 * k;
        if (idx < NU) {
            const int rsel = idx / (DFF / 8), c0 = (idx % (DFF / 8)) * 8, blk = pm * 4 + (rsel >> 1), rr = rsel & 1;
            float g[8], up[8], g1[8], g2[8], o[8];
            unpack8(rg[k], g); unpack8(ru[k], up); unpack8(r1[k], g1); unpack8(r2[k], g2);
#pragma unroll
            for (int e = 0; e < 8; ++e) o[e] = geluf_(cb[c0 + e] + cw[c0 + e] * g2[e] + cw[DFF + c0 + e] * g1[e] + cw[2 * DFF + c0 + e] * g[e]) * up[e];
            *(u32x4*)(act + ((size_t)blk * 64 + rr) * DFF + c0) = pack8(o);
        }
    }
}

__device__ void phase_prep(const Params& p, LAS unsigned char* lds) {
    const int tid = TIDX;
    LAS float* tl = (LAS float*)lds;
    for (int grp = blockIdx.x; grp < DEPTH * 3520 / 4; grp += gridDim.x) {
        const float* src[4]; bf16_t* dst[4]; int Ks[4], ldns[4]; const float* gs[4];
        f32x4 v[4][2];
#pragma unroll
        for (int q = 0; q < 4; ++q) {
            const int idx = grp * 4 + q;
            const int l = idx / 3520; int r = idx % 3520;
            int kt, nt;
            if (r < 1024) { gs[q] = p.in[8] + l * DM; src[q] = p.in[9] + (size_t)l * DM * DIN; ldns[q] = DIN; Ks[q] = DM; dst[q] = (bf16_t*)(p.ws + W_WIN) + (size_t)l * NPROJ * DM; nt = r % 64; kt = r / 64; }
            else if (r < 1408) { r -= 1024; gs[q] = nullptr; src[q] = p.in[24] + (size_t)l * DMIX * DM; ldns[q] = DM; Ks[q] = DMIX; dst[q] = (bf16_t*)(p.ws + W_WOUT) + (size_t)l * DM * DMIX; nt = r % 16; kt = r / 16; }
            else if (r < 2816) { r -= 1408; gs[q] = p.in[25] + l * DM; src[q] = p.in[26] + (size_t)l * DM * DGU; ldns[q] = DGU; Ks[q] = DM; dst[q] = (bf16_t*)(p.ws + W_WUP) + (size_t)l * DGU * DM; nt = r % 88; kt = r / 88; }
            else { r -= 2816; gs[q] = nullptr; src[q] = p.in[29] + (size_t)l * DFF * DM; ldns[q] = DM; Ks[q] = DFF; dst[q] = (bf16_t*)(p.ws + W_WDOWN) + (size_t)l * DM * DFF; nt = r % 16; kt = r / 16; }
            int drow = nt * 64;
            if (ldns[q] == DGU) { const int f = drow < DFF ? drow : drow - DFF; drow = 256 * (f >> 7) + (f & 127) + (drow < DFF ? 0 : 128); }
            src[q] += (size_t)(kt * 64) * ldns[q] + nt * 64; dst[q] += (size_t)drow * Ks[q] + kt * 64;
#pragma unroll
            for (int ps = 0; ps < 2; ++ps) { v[q][ps] = __builtin_nontemporal_load((const f32x4*)(src[q] + (size_t)((tid >> 4) + ps * 32) * ldns[q] + (tid & 15) * 4)); if (gs[q]) v[q][ps] = v[q][ps] * gs[q][kt * 64 + (tid >> 4) + ps * 32]; }
        }
#pragma unroll
        for (int q = 0; q < 4; ++q)
#pragma unroll
            for (int ps = 0; ps < 2; ++ps) { LAS float* t = tl + q * 4160 + ((tid >> 4) + ps * 32) * 65 + (tid & 15) * 4; t[0] = v[q][ps][0]; t[1] = v[q][ps][1]; t[2] = v[q][ps][2]; t[3] = v[q][ps][3]; }
        __syncthreads();
#pragma unroll
        for (int q = 0; q < 4; ++q) {
            const int n = tid >> 3, kq = tid & 7;
            float f[8];
#pragma unroll
            for (int e = 0; e < 8; ++e) f[e] = tl[q * 4160 + (8 * kq + e) * 65 + n];
            *(u32x4*)(dst[q] + (size_t)n * Ks[q] + 8 * kq) = pack8(f);
        }
        __syncthreads();
    }
    const int gt = blockIdx.x * 512 + tid, gn = gridDim.x * 512;
    {
        bf16_t* wrT = (bf16_t*)(p.ws + W_LRUW); bf16_t* wiT = wrT + DEPTH * 8 * 64 * 64;
        for (int i = gt; i < DEPTH * 8 * 64 * 64; i += gn) {
            const int lh = i >> 12, j = (i >> 6) & 63, ii = i & 63;
            wrT[i] = f2bf(p.in[12][(size_t)lh * 4096 + ii * 64 + j]);
            wiT[i] = f2bf(p.in[14][(size_t)lh * 4096 + ii * 64 + j]);
        }
    }
    {
        float* rc = (float*)(p.ws + W_ROPE); float* rs = rc + 2049 * 32;
        for (int i = gt; i < 2049 * 32; i += gn) {
            const int pos = (i >> 5) < 2048 ? (i >> 5) : 16384; const int d = i & 31;
            const float freq = powf(10000.f, -(float)d / 32.f);
            const float ang = (float)pos * freq;
            rc[i] = cosf(ang); rs[i] = sinf(ang);
        }
    }
    {
        bf16_t* wdt = (bf16_t*)(p.ws + W_WDT);
        for (int i = gt; i < DEPTH * 16 * DM; i += gn) {
            const int l = i >> 14, j = (i >> 10) & 15, k = i & 1023;
            wdt[i] = j < 8 ? f2bf(p.in[8][l * DM + k] * p.in[9][((size_t)l * DM + k) * DIN + NPROJ + j]) : (bf16_t)0;
        }
    }
    {
        u64* rss = (u64*)(p.ws + W_RSS);
        for (int i = gt; i < 8 * TT; i += gn) rss[TT + i] = 0ull;
    }
    {
        const int wid = tid >> 6, lane = tid & 63;
        bf16_t* xb = (bf16_t*)(p.ws + W_XB); u64* rss = (u64*)(p.ws + W_RSS);
        const int nw = gridDim.x * 8;
        for (int row0 = blockIdx.x * 8 + wid; row0 < TT; row0 += 4 * nw) {
            f32x4 v[4][4];
#pragma unroll
            for (int r = 0; r < 4; ++r) { const int row = row0 + r * nw; const float* src = row < TP ? p.in[0] + (size_t)row * DM : p.in[1] + (size_t)(row - TP) * DM;
#pragma unroll
                for (int i = 0; i < 4; ++i) v[r][i] = row < TT ? __builtin_nontemporal_load((const f32x4*)(src + i * 256 + lane * 4)) : (f32x4){0.f, 0.f, 0.f, 0.f}; }
#pragma unroll
            for (int r = 0; r < 4; ++r) { const int row = row0 + r * nw; float ss = 0.f;
                if (row < TT) {
#pragma unroll
                    for (int i = 0; i < 4; ++i) { u32x2 w; w.x = pk2(v[r][i][0], v[r][i][1]); w.y = pk2(v[r][i][2], v[r][i][3]); *(u32x2*)(xb + (size_t)row * DM + i * 256 + lane * 4) = w;
                        float o[4]; unpack4(w, o); ss += o[0] * o[0] + o[1] * o[1] + o[2] * o[2] + o[3] * o[3]; }
                }
                ss = wave_sum(ss, lane);
                if (lane == 0 && row < TT) rss[row] = ss_fix(ss);
            }
        }
    }
}

__device__ void phase_dt(const Params& p, int l) {
    const int tid = TIDX, wid = tid >> 6, lane = tid & 63, fr = lane & 15, fq = lane >> 4;
    const bf16_t* xb = (const bf16_t*)(p.ws + W_XB); const bf16_t* wdt = (const bf16_t*)(p.ws + W_WDT) + (size_t)l * 16 * DM;
    const u64* rss = (const u64*)(p.ws + W_RSS) + (size_t)(2 * l) * TT; float* dtraw = (float*)(p.ws + W_DT);
    for (int tile = blockIdx.x * 8 + wid; tile < TT / 16; tile += gridDim.x * 8) {
        const bf16_t* ap = xb + (size_t)(tile * 16 + fr) * DM + 8 * fq; const bf16_t* bp = wdt + (size_t)fr * DM + 8 * fq;
        f32x4 acc = {0.f, 0.f, 0.f, 0.f};
#pragma unroll 16
        for (int s = 0; s < 32; ++s) acc = MFMA(*(const bf16x8*)(bp + 32 * s), *(const bf16x8*)(ap + 32 * s), acc);
        const int row = tile * 16 + fr;
        if (fq < 2) { const float rs = rstd_fix(rss[row]); *(f32x4*)(dtraw + (size_t)row * 8 + 4 * fq) = acc * rs; }
    }
}

__device__ void phase_final(const Params& p) {
    const int tid = TIDX, wid = tid >> 6, lane = tid & 63;
    const bf16_t* xb = (const bf16_t*)(p.ws + W_XB);
    const float* g = p.in[30];
    f32x4 g4[4];
#pragma unroll
    for (int i = 0; i < 4; ++i) g4[i] = *(const f32x4*)(g + i * 256 + lane * 4);
    const int nw = gridDim.x * 8;
    for (int row0 = blockIdx.x * 8 + wid; row0 < TT; row0 += 4 * nw) {
        u32x2 raw[4][4];
#pragma unroll
        for (int r = 0; r < 4; ++r) { const int row = row0 + r * nw;
#pragma unroll
            for (int i = 0; i < 4; ++i) raw[r][i] = row < TT ? *(const u32x2*)(xb + (size_t)row * DM + i * 256 + lane * 4) : (u32x2){0u, 0u}; }
#pragma unroll
        for (int r = 0; r < 4; ++r) { const int row = row0 + r * nw;
            f32x4 v[4]; float ss = 0.f;
#pragma unroll
            for (int i = 0; i < 4; ++i) { float o[4]; unpack4(raw[r][i], o); v[i] = (f32x4){o[0], o[1], o[2], o[3]}; ss += o[0] * o[0] + o[1] * o[1] + o[2] * o[2] + o[3] * o[3]; }
            ss = wave_sum(ss, lane);
            const float rstd = rsqrtf(ss * (1.f / DM) + EPS);
            if (row < TT) {
#pragma unroll
                for (int i = 0; i < 4; ++i) __builtin_nontemporal_store(v[i] * rstd * g4[i], (f32x4*)(p.out + (size_t)row * DM + i * 256 + lane * 4));
            }
        }
    }
}


__device__ __forceinline__ float ret_logg(int h) { return log1pf(-exp2f(-5.f - (float)h)); }

template <class CM, class F>
__device__ __forceinline__ void conv64(const bf16_t* proj, int row0, int tseq0, int pc0, const float* cw, const float* cb, int C, int nchunks, CM&& chmap, F&& emit) {
    for (int u = TIDX; u < nchunks * 8; u += 512) {
        const int q = u % nchunks, seg = u / nchunks, c = chmap(q), j0 = seg * 8;
        const bf16_t* src = proj + (size_t)(row0 + j0) * NPROJ + pc0 + c;
        u32x4 raw[11];
        if (tseq0 + j0 == 0) { raw[0] = (u32x4){0u, 0u, 0u, 0u}; raw[1] = raw[0]; raw[2] = raw[0]; }
        else { raw[0] = *(const u32x4*)(src - 3 * NPROJ); raw[1] = *(const u32x4*)(src - 2 * NPROJ); raw[2] = *(const u32x4*)(src - NPROJ); }
#pragma unroll
        for (int j = 0; j < 8; ++j) raw[3 + j] = *(const u32x4*)(src + (size_t)j * NPROJ);
        float w0[8], w1[8], w2[8], w3[8], bb[8];
#pragma unroll
        for (int e = 0; e < 8; ++e) { w0[e] = cw[c + e]; w1[e] = cw[C + c + e]; w2[e] = cw[2 * C + c + e]; w3[e] = cw[3 * C + c + e]; bb[e] = cb[c + e]; }
        float h3[8], h2[8], h1[8];
        unpack8(raw[0], h3); unpack8(raw[1], h2); unpack8(raw[2], h1);
#pragma unroll
        for (int j = 0; j < 8; ++j) {
            float cur[8], y[8];
            unpack8(raw[3 + j], cur);
#pragma unroll
            for (int e = 0; e < 8; ++e) y[e] = bb[e] + w0[e] * h3[e] + w1[e] * h2[e] + w2[e] * h1[e] + w3[e] * cur[e];
            emit(j0 + j, q, c, y);
#pragma unroll
            for (int e = 0; e < 8; ++e) { h3[e] = h2[e]; h2[e] = h1[e]; h1[e] = cur[e]; }
        }
    }
}

__device__ __forceinline__ void rot16(const bf16_t* src, const float* rc, const float* rs, float scale, LAS bf16_t* dst) {
    float x1[16], x2[16], o1[16], o2[16];
    unpack8(*(const u32x4*)src, x1); unpack8(*(const u32x4*)(src + 8), x1 + 8);
    unpack8(*(const u32x4*)(src + 32), x2); unpack8(*(const u32x4*)(src + 40), x2 + 8);
#pragma unroll
    for (int e = 0; e < 16; ++e) { const float c = rc[e], s = rs[e]; o1[e] = (x1[e] * c - x2[e] * s) * scale; o2[e] = (x1[e] * s + x2[e] * c) * scale; }
    *(LAS u32x4*)dst = pack8(o1); *(LAS u32x4*)(dst + 8) = pack8(o1 + 8);
    *(LAS u32x4*)(dst + 32) = pack8(o2); *(LAS u32x4*)(dst + 40) = pack8(o2 + 8);
}

__device__ void ret_m1(const Params& p, LAS unsigned char* lds, int b, int c) {
    const int tid = TIDX, wid = tid >> 6, lane = tid & 63, fr = lane & 15, fq = lane >> 4;
    const bf16_t* proj = (const bf16_t*)(p.ws + W_PROJ);
    const float* rc = (const float*)(p.ws + W_ROPE); const float* rs = rc + 2049 * 32;
    float* dS = (float*)(p.ws + W_DS);
    LAS bf16_t* Kt = (LAS bf16_t*)lds;
    LAS bf16_t* Vt = (LAS bf16_t*)(lds + 33792);
    const int row0 = b * SEQ + c * 64, pos0 = c * 64;
    {
        const int j = tid >> 3, sub = tid & 7, h = sub >> 1, d0 = (sub & 1) * 16;
        const float scale = 0.125f * fexp_((float)(63 - j) * ret_logg(h));
        rot16(proj + (size_t)(row0 + j) * NPROJ + PC_K + h * 64 + d0, rc + (pos0 + j) * 32 + d0, rs + (pos0 + j) * 32 + d0, scale, Kt + j * 264 + h * 64 + d0);
#pragma unroll
        for (int i = 0; i < 8; ++i) { const int id = tid + 512 * i, jj = id >> 6, cc = id & 63;
            *(LAS u32x4*)(Vt + jj * 520 + cc * 8) = *(const u32x4*)(proj + (size_t)(row0 + jj) * NPROJ + PC_V + cc * 8); }
    }
    __syncthreads();
    {
        const int h = wid >> 1, vh = wid & 1;
        bf16x8 X[4][2];
#pragma unroll
        for (int kt = 0; kt < 4; ++kt)
#pragma unroll
            for (int kk = 0; kk < 2; ++kk) X[kt][kk] = frag_tr(Kt, 264, kk * 32, h * 64 + kt * 16, fr, fq);
        float* out = dS + ((size_t)((b * 4 + h) * NCH + c)) * 8192;
#pragma unroll
        for (int vt = 0; vt < 4; ++vt) {
            bf16x8 Y[2];
#pragma unroll
            for (int kk = 0; kk < 2; ++kk) Y[kk] = frag_tr(Vt, 520, kk * 32, h * 128 + vh * 64 + vt * 16, fr, fq);
#pragma unroll
            for (int kt = 0; kt < 4; ++kt) {
                f32x4 a = {0.f, 0.f, 0.f, 0.f};
                a = MFMA(X[kt][0], Y[0], a); a = MFMA(X[kt][1], Y[1], a);
                *(f32x4*)(out + (vh * 64 + vt * 16 + fr) * 64 + kt * 16 + 4 * fq) = a;
            }
        }
    }
    __syncthreads();
}

template <int NH>
__device__ __forceinline__ void ssd_dt_cum(const Params& p, int l, int row0, int h0, LAS float* dtv, LAS float* cum) {
    const int tid = TIDX, hl = tid >> 6, j = tid & 63;
    const float* dtraw = (const float*)(p.ws + W_DT);
    if (hl < NH) {
        const int h = h0 + hl;
        const float dt = softplusf_(dtraw[(size_t)(row0 + j) * 8 + h] + p.in[20][l * 8 + h]);
        float v = -dt * fexp_(p.in[21][l * 8 + h]);
#pragma unroll
        for (int o = 1; o < 64; o <<= 1) { const float t = shfl_up_(v, o, j); if (j >= o) v += t; }
        dtv[hl * 64 + j] = dt; cum[hl * 64 + j] = v;
    }
    __syncthreads();
}

__device__ void ssd_m1(const Params& p, LAS unsigned char* lds, int l, int b, int c) {
    const int tid = TIDX, wid = tid >> 6, lane = tid & 63, fr = lane & 15, fq = lane >> 4;
    const bf16_t* proj = (const bf16_t*)(p.ws + W_PROJ);
    float* dS = (float*)(p.ws + W_DSSSD); float* dec = (float*)(p.ws + W_DEC);
    LAS bf16_t* Xs = (LAS bf16_t*)lds;
    LAS bf16_t* Bm = (LAS bf16_t*)(lds + 66560);
    LAS float* dtv = (LAS float*)(lds + 100352);
    LAS float* cum = dtv + 512;
    LAS float* wl = cum + 512;
    const int row0 = b * SEQ + c * 64;
    ssd_dt_cum<8>(p, l, row0, 0, dtv, cum);
    { const int h = tid >> 6, j = tid & 63; wl[tid] = fexp_(cum[h * 64 + 63] - cum[tid]) * dtv[tid]; if (j == 63) dec[(b * 8 + h) * NCH + c] = fexp_(cum[h * 64 + 63]); }
    __syncthreads();
    conv64(proj, row0, c * 64, PC_XBC, p.in[18] + (size_t)l * 4 * 1024, p.in[19] + l * 1024, 1024, 96, [](int q) { return q * 8; },
           [&](int j, int q, int ch, float* y) {
               float s[8];
               if (ch < 512) { const float w = wl[(ch >> 6) * 64 + j];
#pragma unroll
                   for (int e = 0; e < 8; ++e) s[e] = siluf_(y[e]) * w;
                   *(LAS u32x4*)(Xs + j * 520 + ch) = pack8(s);
               } else {
#pragma unroll
                   for (int e = 0; e < 8; ++e) s[e] = siluf_(y[e]);
                   *(LAS u32x4*)(Bm + j * 264 + ch - 512) = pack8(s);
               }
           });
    __syncthreads();
    {
        const int h = wid, g = h >> 2;
        bf16x8 Y[4][2];
#pragma unroll
        for (int pt = 0; pt < 4; ++pt)
#pragma unroll
            for (int kk = 0; kk < 2; ++kk) Y[pt][kk] = frag_tr(Xs, 520, kk * 32, h * 64 + pt * 16, fr, fq);
        float* out = dS + ((size_t)((b * 8 + h) * NCH + c)) * 8192;
#pragma unroll
        for (int nt = 0; nt < 8; ++nt) {
            bf16x8 X[2];
#pragma unroll
            for (int kk = 0; kk < 2; ++kk) X[kk] = frag_tr(Bm, 264, kk * 32, g * 128 + nt * 16, fr, fq);
#pragma unroll
            for (int pt = 0; pt < 4; ++pt) {
                f32x4 a = {0.f, 0.f, 0.f, 0.f};
                a = MFMA(X[0], Y[pt][0], a); a = MFMA(X[1], Y[pt][1], a);
                *(f32x4*)(out + (pt * 16 + fr) * 128 + nt * 16 + 4 * fq) = a;
            }
        }
    }
    __syncthreads();
}

template <int PASS>
__device__ void lru_item(const Params& p, LAS unsigned char* lds, int l, int b, int c) {
    const int tid = TIDX, wid = tid >> 6, lane = tid & 63, fr = lane & 15, fq = lane >> 4;
    const bf16_t* proj = (const bf16_t*)(p.ws + W_PROJ);
    LAS bf16_t* xc = (LAS bf16_t*)lds;
    const int row0 = b * SEQ + c * 64;
    const int h = wid;
    const bf16_t* wrT = (const bf16_t*)(p.ws + W_LRUW) + (size_t)(l * 8 + h) * 4096;
    const bf16_t* wiT = wrT + DEPTH * 8 * 4096;
    bf16x8 BrA[4][2], BiA[4][2]; float brA[4], biA[4], lamA[4], hinA[4];
#pragma unroll
    for (int n = 0; n < 4; ++n) {
#pragma unroll
        for (int kk = 0; kk < 2; ++kk) { BrA[n][kk] = *(const bf16x8*)(wrT + (n * 16 + fr) * 64 + kk * 32 + 8 * fq); BiA[n][kk] = *(const bf16x8*)(wiT + (n * 16 + fr) * 64 + kk * 32 + 8 * fq); }
        const int ch = h * 64 + n * 16 + fr;
        brA[n] = p.in[13][l * 512 + ch]; biA[n] = p.in[15][l * 512 + ch]; lamA[n] = p.in[16][l * 512 + ch];
        hinA[n] = PASS == 2 ? ((const float*)(p.ws + W_LRUHIN))[(size_t)(b * NCH + c) * 512 + ch] : 0.f;
    }
    conv64(proj, row0, c * 64, PC_LX, p.in[10] + (size_t)l * 4 * 512, p.in[11] + l * 512, 512, 64, [](int q) { return q * 8; },
           [&](int j, int q, int ch, float* y) { *(LAS u32x4*)(xc + j * 520 + ch) = pack8(y); });
    __syncthreads();
    bf16x8 Af[4][2];
#pragma unroll
    for (int m = 0; m < 4; ++m)
#pragma unroll
        for (int kk = 0; kk < 2; ++kk) Af[m][kk] = frag_row(xc, 520, m * 16, h * 64 + kk * 32, fr, fq);
    float* lruAB = (float*)(p.ws + W_LRUAB); const float* hin = (const float*)(p.ws + W_LRUHIN);
    bf16_t* mix = (bf16_t*)(p.ws + W_HB);
#pragma unroll
    for (int n = 0; n < 4; ++n) {
        f32x4 ar[4], ai[4];
        {
            bf16x8 Br[2], Bi[2];
#pragma unroll
            for (int kk = 0; kk < 2; ++kk) { Br[kk] = BrA[n][kk]; Bi[kk] = BiA[n][kk]; }
#pragma unroll
            for (int m = 0; m < 4; ++m) {
                f32x4 a = {0.f, 0.f, 0.f, 0.f}, bq = {0.f, 0.f, 0.f, 0.f};
                a = MFMA(Af[m][0], Br[0], a); a = MFMA(Af[m][1], Br[1], a);
                bq = MFMA(Af[m][0], Bi[0], bq); bq = MFMA(Af[m][1], Bi[1], bq);
                ar[m] = a; ai[m] = bq;
            }
        }
        const int ch = h * 64 + n * 16 + fr;
        const float br = brA[n], bi = biA[n];
        const float sp = log1pf(fexp_(-lamA[n]));
#pragma unroll
        for (int m = 0; m < 4; ++m)
#pragma unroll
            for (int i = 0; i < 4; ++i) {
                const int t = m * 16 + 4 * fq + i;
                const float xv = bf2f(xc[t * 520 + ch]);
                const float r = sigmoidf_(ar[m][i] + br), ig = sigmoidf_(ai[m][i] + bi);
                const float la = -8.f * r * sp;
                const float av = fexp_(la);
                ar[m][i] = av;
                ai[m][i] = __builtin_amdgcn_sqrtf(fmaxf(1.f - av * av, 0.f)) * ig * xv;
            }
        float carry = 0.f, Atot = 1.f;
        if (PASS == 2) carry = hinA[n];
#pragma unroll
        for (int m = 0; m < 4; ++m) {
            const float a0 = ar[m][0], a1 = ar[m][1], a2 = ar[m][2], a3 = ar[m][3];
            const float b0 = ai[m][0], b1 = ai[m][1], b2 = ai[m][2], b3 = ai[m][3];
            float Al = a0 * a1 * a2 * a3, Bl = ((b0 * a1 + b1) * a2 + b2) * a3 + b3;
            float Ap = shfl_up_(Al, 16, lane), Bp = shfl_up_(Bl, 16, lane);
            if (fq >= 1) { Bl = Bp * Al + Bl; Al = Ap * Al; }
            Ap = shfl_up_(Al, 32, lane); Bp = shfl_up_(Bl, 32, lane);
            if (fq >= 2) { Bl = Bp * Al + Bl; Al = Ap * Al; }
            float Aex = shfl_up_(Al, 16, lane), Bex = shfl_up_(Bl, 16, lane);
            if (fq == 0) { Aex = 1.f; Bex = 0.f; }
            const float At = shfl_idx(Al, fr + 48), Bt = shfl_idx(Bl, fr + 48);
            if (PASS == 2) {
                float hh = Aex * carry + Bex;
                hh = a0 * hh + b0; ai[m][0] = hh;
                hh = a1 * hh + b1; ai[m][1] = hh;
                hh = a2 * hh + b2; ai[m][2] = hh;
                hh = a3 * hh + b3; ai[m][3] = hh;
            }
            carry = At * carry + Bt; Atot *= At;
        }
        if (PASS == 1) {
            if (fq == 0) { f32x2 v = {Atot, carry}; *(f32x2*)(lruAB + ((size_t)(b * NCH + c) * 512 + ch) * 2) = v; }
        } else {
            bf16_t gv[4][4];
#pragma unroll
            for (int m = 0; m < 4; ++m)
#pragma unroll
                for (int i = 0; i < 4; ++i) gv[m][i] = proj[(size_t)(row0 + m * 16 + 4 * fq + i) * NPROJ + PC_LG + ch];
#pragma unroll
            for (int m = 0; m < 4; ++m)
#pragma unroll
                for (int i = 0; i < 4; ++i) {
                    const size_t t = row0 + m * 16 + 4 * fq + i;
                    mix[t * DMIX + ch] = f2bf(ai[m][i] * geluf_(bf2f(gv[m][i])));
                }
        }
    }
    __syncthreads();
}

__device__ void phase_m15(const Params& p, int l) {
    const int gt = blockIdx.x * 512 + TIDX, gn = gridDim.x * 512;
    const float* dSr = (const float*)(p.ws + W_DS); const float* dSs = (const float*)(p.ws + W_DSSSD); const float* dec = (const float*)(p.ws + W_DEC);
    bf16_t* spr = (bf16_t*)(p.ws + W_SPR); bf16_t* sps = (bf16_t*)(p.ws + W_SPS);
    for (int u = gt; u < (32 + 64) * 4096; u += gn) {
        float zz = 0.f; asm volatile("" : "+v"(zz));
        f32x2 S = {zz, zz};
        f32x2 tv[NCH];
        if (u < 32 * 4096) {
            const int bh = u >> 12, e2 = u & 4095, h = bh & 3;
            const float* ptr = dSr + (size_t)bh * NCH * 8192 + e2 * 2; bf16_t* sp = spr + (size_t)bh * NCH * 8192 + e2 * 2;
            const float d = fexp_(64.f * ret_logg(h));
#pragma unroll
            for (int c = 0; c < NCH; ++c) tv[c] = *(const f32x2*)(ptr + (size_t)c * 8192);
#pragma unroll
            for (int c = 0; c < NCH; ++c) { *(unsigned*)(sp + (size_t)c * 8192) = pk2(S[0], S[1]); S = S * d + tv[c]; }
            float* o = p.out + O_RP + ((size_t)(l * NB * 4 + bh)) * 8192;
#pragma unroll
            for (int i = 0; i < 2; ++i) { const int e = e2 * 2 + i, v = e >> 6, k = e & 63; o[k * 128 + v] = S[i]; }
        } else {
            const int uu = u - 32 * 4096, bh = uu >> 12, e2 = uu & 4095;
            const float* ptr = dSs + (size_t)bh * NCH * 8192 + e2 * 2; bf16_t* sp = sps + (size_t)bh * NCH * 8192 + e2 * 2;
            float dc[NCH];
#pragma unroll
            for (int c = 0; c < NCH; ++c) { tv[c] = *(const f32x2*)(ptr + (size_t)c * 8192); dc[c] = dec[bh * NCH + c]; }
#pragma unroll
            for (int c = 0; c < NCH; ++c) { *(unsigned*)(sp + (size_t)c * 8192) = pk2(S[0], S[1]); S = S * dc[c] + tv[c]; }
            *(f32x2*)(p.out + O_SP + ((size_t)(l * NB * 8 + bh)) * 8192 + e2 * 2) = S;
        }
    }
    const float* lruAB = (const float*)(p.ws + W_LRUAB); float* hin = (float*)(p.ws + W_LRUHIN);
    for (int u = gt; u < NB * 512; u += gn) {
        const int b = u >> 9, ch = u & 511; float h = 0.f;
        f32x2 ab[NCH];
#pragma unroll
        for (int c = 0; c < NCH; ++c) ab[c] = *(const f32x2*)(lruAB + ((size_t)(b * NCH + c) * 512 + ch) * 2);
#pragma unroll
        for (int c = 0; c < NCH; ++c) { hin[(size_t)(b * NCH + c) * 512 + ch] = h; h = ab[c][0] * h + ab[c][1]; }
        p.out[O_LHP + (size_t)(l * NB + b) * 512 + ch] = h;
    }
}

__device__ void ret_m2(const Params& p, LAS unsigned char* lds, int l, int b, int c, int hp) {
    const int tid = TIDX, wid = tid >> 6, lane = tid & 63, fr = lane & 15, fq = lane >> 4;
    const bf16_t* proj = (const bf16_t*)(p.ws + W_PROJ);
    const float* rc = (const float*)(p.ws + W_ROPE); const float* rs = rc + 2049 * 32;
    const bf16_t* sp = (const bf16_t*)(p.ws + W_SPR);
    bf16_t* mix = (bf16_t*)(p.ws + W_HB);
    const int row0 = b * SEQ + c * 64, pos0 = c * 64;
    constexpr int HB = 63488;
    {
        const int j = tid >> 3, sub = tid & 7, hh = sub >> 2, which = (sub >> 1) & 1, d0 = (sub & 1) * 16, h = 2 * hp + hh;
        LAS bf16_t* dst = (LAS bf16_t*)(lds + hh * HB + which * 9216) + j * 72 + d0;
        rot16(proj + (size_t)(row0 + j) * NPROJ + (which ? PC_K : PC_Q) + h * 64 + d0, rc + (pos0 + j) * 32 + d0, rs + (pos0 + j) * 32 + d0, which ? 0.125f : 1.f, dst);
#pragma unroll
        for (int i = 0; i < 4; ++i) { const int id = tid + 512 * i, h2 = id >> 10, jj = (id >> 4) & 63, cc = id & 15;
            *(LAS u32x4*)((LAS bf16_t*)(lds + h2 * HB + 18432) + jj * 136 + cc * 8) = *(const u32x4*)(proj + (size_t)(row0 + jj) * NPROJ + PC_V + (2 * hp + h2) * 128 + cc * 8); }
#pragma unroll
        for (int i = 0; i < 4; ++i) { const int id = tid + 512 * i, h2 = id >> 10, v = (id >> 3) & 127, kc = id & 7;
            *(LAS u32x4*)((LAS bf16_t*)(lds + h2 * HB + 35840) + v * 72 + kc * 8) = *(const u32x4*)(sp + ((size_t)((b * 4 + 2 * hp + h2) * NCH + c)) * 8192 + v * 64 + kc * 8); }
    }
    __syncthreads();
    const int hh = wid >> 2, it = wid & 3, i0 = it * 16, h = 2 * hp + hh;
    const float lg = ret_logg(h);
    LAS bf16_t* Q = (LAS bf16_t*)(lds + hh * HB); LAS bf16_t* Kk = Q + 64 * 72; LAS bf16_t* V = (LAS bf16_t*)(lds + hh * HB + 18432);
    LAS bf16_t* S = (LAS bf16_t*)(lds + hh * HB + 35840); LAS bf16_t* P = (LAS bf16_t*)(lds + hh * HB + 54272);
    bf16x8 Yq[2];
#pragma unroll
    for (int kk = 0; kk < 2; ++kk) Yq[kk] = frag_row(Q, 72, i0, kk * 32, fr, fq);
    const int irow = i0 + fr;
#pragma unroll
    for (int jt = 0; jt < 4; ++jt) {
        f32x4 sc = {0.f, 0.f, 0.f, 0.f};
#pragma unroll
        for (int kk = 0; kk < 2; ++kk) sc = MFMA(frag_row(Kk, 72, jt * 16, kk * 32, fr, fq), Yq[kk], sc);
        float v[4];
#pragma unroll
        for (int i = 0; i < 4; ++i) { const int j = jt * 16 + 4 * fq + i; v[i] = j <= irow ? sc[i] * fexp_((float)(irow - j) * lg) : 0.f; }
        u32x2 w; w.x = pk2(v[0], v[1]); w.y = pk2(v[2], v[3]);
        *(LAS u32x2*)(P + irow * 72 + jt * 16 + 4 * fq) = w;
    }
    __syncthreads();
    const size_t t = row0 + irow;
    u32x2 rgv[8]; f32x4 ngv[8];
#pragma unroll
    for (int vt = 0; vt < 8; ++vt) { rgv[vt] = *(const u32x2*)(proj + t * NPROJ + PC_RG + h * 128 + vt * 16 + 4 * fq); ngv[vt] = *(const f32x4*)(p.in[17] + l * 512 + h * 128 + vt * 16 + 4 * fq); }
    bf16x8 Yp[2];
#pragma unroll
    for (int kk = 0; kk < 2; ++kk) Yp[kk] = frag_row(P, 72, i0, kk * 32, fr, fq);
    const float qdec = fexp_((float)(irow + 1) * lg);
    f32x4 o[8]; float ssq = 0.f;
#pragma unroll
    for (int vt = 0; vt < 8; ++vt) {
        f32x4 a1 = {0.f, 0.f, 0.f, 0.f}, a2 = {0.f, 0.f, 0.f, 0.f};
#pragma unroll
        for (int kk = 0; kk < 2; ++kk) { a1 = MFMA(frag_tr(V, 136, kk * 32, vt * 16, fr, fq), Yp[kk], a1); a2 = MFMA(frag_row(S, 72, vt * 16, kk * 32, fr, fq), Yq[kk], a2); }
        o[vt] = a1 + a2 * qdec;
        ssq += o[vt][0] * o[vt][0] + o[vt][1] * o[vt][1] + o[vt][2] * o[vt][2] + o[vt][3] * o[vt][3];
    }
    ssq += shfl_xor_(ssq, 16, lane); ssq += shfl_xor_(ssq, 32, lane);
    const float rstd = rsqrtf(ssq * (1.f / 128.f) + EPS);
#pragma unroll
    for (int vt = 0; vt < 8; ++vt) {
        const int v = vt * 16 + 4 * fq;
        float gt[4]; unpack4(rgv[vt], gt);
        const f32x4 ng = ngv[vt];
        float y[4];
#pragma unroll
        for (int i = 0; i < 4; ++i) y[i] = siluf_(gt[i]) * (o[vt][i] * rstd * ng[i]);
        u32x2 w; w.x = pk2(y[0], y[1]); w.y = pk2(y[2], y[3]);
        *(u32x2*)(mix + t * DMIX + 512 + h * 128 + v) = w;
    }
    __syncthreads();
}

__device__ void ssd_m2(const Params& p, LAS unsigned char* lds, int l, int b, int c, int g) {
    const int tid = TIDX, wid = tid >> 6, lane = tid & 63, fr = lane & 15, fq = lane >> 4;
    const bf16_t* proj = (const bf16_t*)(p.ws + W_PROJ);
    const bf16_t* sp = (const bf16_t*)(p.ws + W_SPS);
    bf16_t* mix = (bf16_t*)(p.ws + W_HB);
    const int row0 = b * SEQ + c * 64;
    LAS bf16_t* Cm = (LAS bf16_t*)lds;
    LAS bf16_t* Bm = (LAS bf16_t*)(lds + 17408);
    constexpr int PB = 34816, HB = 35840;
    LAS float* dtv = (LAS float*)(lds + 106496);
    LAS float* cum = dtv + 256;
    LAS float* ssqb = cum + 256;
    ssd_dt_cum<4>(p, l, row0, 4 * g, dtv, cum);
    const float* cw = p.in[18] + (size_t)l * 4 * 1024; const float* cb = p.in[19] + l * 1024;
    conv64(proj, row0, c * 64, PC_XBC, cw, cb, 1024, 32, [g](int q) { return (q < 16 ? 512 : 768 - 128) + g * 128 + q * 8; },
           [&](int j, int q, int ch, float* y) {
               float s[8];
#pragma unroll
               for (int e = 0; e < 8; ++e) s[e] = siluf_(y[e]);
               if (q < 16) *(LAS u32x4*)(Bm + j * 136 + q * 8) = pack8(s); else *(LAS u32x4*)(Cm + j * 136 + (q - 16) * 8) = pack8(s);
           });
    const int hh = wid >> 2, it = wid & 3, i0 = it * 16, irow = i0 + fr;
    const size_t t = row0 + irow;
    f32x4 gy[2][4]; float ssq = 0.f;
#pragma unroll
    for (int pr = 0; pr < 2; ++pr) {
        const int hbase = 4 * g + 2 * pr;
        conv64(proj, row0, c * 64, PC_XBC, cw, cb, 1024, 16, [hbase](int q) { return hbase * 64 + q * 8; },
               [&](int j, int q, int ch, float* y) {
                   float s[8];
#pragma unroll
                   for (int e = 0; e < 8; ++e) s[e] = siluf_(y[e]);
                   *(LAS u32x4*)((LAS bf16_t*)(lds + PB + (q >> 3) * HB + 9216) + j * 72 + (q & 7) * 8) = pack8(s);
               });
#pragma unroll
        for (int i = 0; i < 4; ++i) { const int id = tid + 512 * i, h2 = id >> 10, pp = (id >> 4) & 63, nc = id & 15;
            *(LAS u32x4*)((LAS bf16_t*)(lds + PB + h2 * HB + 18432) + pp * 136 + nc * 8) = *(const u32x4*)(sp + ((size_t)((b * 8 + hbase + h2) * NCH + c)) * 8192 + pp * 128 + nc * 8); }
        __syncthreads();
        const int h = hbase + hh, hl = 2 * pr + hh;
        LAS bf16_t* P = (LAS bf16_t*)(lds + PB + hh * HB); LAS bf16_t* X = P + 64 * 72; LAS bf16_t* S = (LAS bf16_t*)(lds + PB + hh * HB + 18432);
        bf16x8 Yc[4];
#pragma unroll
        for (int kk = 0; kk < 4; ++kk) Yc[kk] = frag_row(Cm, 136, i0, kk * 32, fr, fq);
        const float cumi = cum[hl * 64 + irow];
#pragma unroll
        for (int jh = 0; jh < 2; ++jh) {
            bf16x8 Xb[2][4]; f32x4 cj[2], dj[2];
#pragma unroll
            for (int q = 0; q < 2; ++q) {
#pragma unroll
                for (int kk = 0; kk < 4; ++kk) Xb[q][kk] = frag_row(Bm, 136, (2 * jh + q) * 16, kk * 32, fr, fq);
                cj[q] = *(const LAS f32x4*)(cum + hl * 64 + (2 * jh + q) * 16 + 4 * fq); dj[q] = *(const LAS f32x4*)(dtv + hl * 64 + (2 * jh + q) * 16 + 4 * fq);
            }
#pragma unroll
            for (int q = 0; q < 2; ++q) {
                const int jt = 2 * jh + q;
                f32x4 sc = {0.f, 0.f, 0.f, 0.f};
#pragma unroll
                for (int kk = 0; kk < 4; ++kk) sc = MFMA(Xb[q][kk], Yc[kk], sc);
                float v[4];
#pragma unroll
                for (int i = 0; i < 4; ++i) { const int j = jt * 16 + 4 * fq + i; v[i] = j <= irow ? sc[i] * fexp_(cumi - cj[q][i]) * dj[q][i] : 0.f; }
                u32x2 w; w.x = pk2(v[0], v[1]); w.y = pk2(v[2], v[3]);
                *(LAS u32x2*)(P + irow * 72 + jt * 16 + 4 * fq) = w;
            }
        }
        __syncthreads();
        u32x2 zraw[4];
#pragma unroll
        for (int pt = 0; pt < 4; ++pt) zraw[pt] = *(const u32x2*)(proj + t * NPROJ + PC_Z + h * 64 + pt * 16 + 4 * fq);
        bf16x8 Yp[2];
#pragma unroll
        for (int kk = 0; kk < 2; ++kk) Yp[kk] = frag_row(P, 72, i0, kk * 32, fr, fq);
        const float ecum = fexp_(cumi), Dh = p.in[22][l * 8 + h];
#pragma unroll
        for (int pt = 0; pt < 4; ++pt) {
            f32x4 a1 = {0.f, 0.f, 0.f, 0.f}, a2 = {0.f, 0.f, 0.f, 0.f};
#pragma unroll
            for (int kk = 0; kk < 2; ++kk) a1 = MFMA(frag_tr(X, 72, kk * 32, pt * 16, fr, fq), Yp[kk], a1);
#pragma unroll
            for (int kk = 0; kk < 4; ++kk) a2 = MFMA(frag_row(S, 136, pt * 16, kk * 32, fr, fq), Yc[kk], a2);
            const int pp = pt * 16 + 4 * fq;
            float xv[4], zv[4]; unpack4(*(const LAS u32x2*)(X + irow * 72 + pp), xv);
            unpack4(zraw[pt], zv);
            f32x4 r;
#pragma unroll
            for (int i = 0; i < 4; ++i) { const float y = a1[i] + ecum * a2[i] + Dh * xv[i]; r[i] = y * siluf_(zv[i]); ssq += r[i] * r[i]; }
            gy[pr][pt] = r;
        }
        __syncthreads();
    }
    f32x4 ngv[2][4];
#pragma unroll
    for (int pr = 0; pr < 2; ++pr)
#pragma unroll
        for (int pt = 0; pt < 4; ++pt) ngv[pr][pt] = *(const f32x4*)(p.in[23] + l * 512 + g * 256 + (2 * pr + hh) * 64 + pt * 16 + 4 * fq);
    ssq += shfl_xor_(ssq, 16, lane); ssq += shfl_xor_(ssq, 32, lane);
    if (fq == 0) ssqb[irow * 2 + hh] = ssq;
    __syncthreads();
    const float rstd = rsqrtf((ssqb[irow * 2] + ssqb[irow * 2 + 1]) * (1.f / 256.f) + EPS);
#pragma unroll
    for (int pr = 0; pr < 2; ++pr)
#pragma unroll
        for (int pt = 0; pt < 4; ++pt) {
            const int chn = g * 256 + (2 * pr + hh) * 64 + pt * 16 + 4 * fq;
            const f32x4 ng = ngv[pr][pt];
            u32x2 w; w.x = pk2(gy[pr][pt][0] * rstd * ng[0], gy[pr][pt][1] * rstd * ng[1]); w.y = pk2(gy[pr][pt][2] * rstd * ng[2], gy[pr][pt][3] * rstd * ng[3]);
            *(u32x2*)(mix + t * DMIX + 1024 + chn) = w;
        }
    __syncthreads();
}

__device__ void sample_item(const Params& p, LAS unsigned char* lds, int l, int s, int g) {
    const int tid = TIDX, wid = tid >> 6, lane = tid & 63;
    const bf16_t* proj = (const bf16_t*)(p.ws + W_PROJ);
    bf16_t* mix = (bf16_t*)(p.ws + W_HB);
    const size_t t = TP + s;
    const bf16_t* prow = proj + t * NPROJ;
    LAS float* sv = (LAS float*)lds;
    LAS float* sdt = sv + 512;
    LAS float* gy = sv + 520;
    LAS float* sq = sv + 776;
    LAS float* ro = sv + 1032;
    LAS float* sxc = sv + 2304;
    f32x4 ssd0[4][4], ret0[2][4];
    {
        const int n4 = (tid & 31) * 4, pr = tid >> 5;
#pragma unroll
        for (int hl = 0; hl < 4; ++hl)
#pragma unroll
            for (int ps = 0; ps < 4; ++ps) ssd0[hl][ps] = __builtin_nontemporal_load((const f32x4*)(p.in[6] + ((size_t)(l * NS + s) * 8 + 4 * g + hl) * 8192 + (ps * 16 + pr) * 128 + n4));
#pragma unroll
        for (int hh = 0; hh < 2; ++hh)
#pragma unroll
            for (int ps = 0; ps < 4; ++ps) ret0[hh][ps] = __builtin_nontemporal_load((const f32x4*)(p.in[4] + ((size_t)(l * NS + s) * 4 + 2 * g + hh) * 8192 + (ps * 16 + pr) * 128 + n4));
    }
    {
        const int ch = tid < 256 ? g * 256 + tid : (tid < 384 ? 512 + g * 128 + (tid - 256) : 768 + g * 128 + (tid - 384));
        const float* cw = p.in[18] + (size_t)l * 4 * 1024; const float* st = p.in[5] + (size_t)(l * NS + s) * 3 * 1024;
        const float cur = bf2f(prow[PC_XBC + ch]);
        const float s0 = st[ch], s1 = st[1024 + ch], s2 = st[2048 + ch];
        const float y = p.in[19][l * 1024 + ch] + cw[ch] * s0 + cw[1024 + ch] * s1 + cw[2048 + ch] * s2 + cw[3072 + ch] * cur;
        sv[tid] = siluf_(y);
        float* so = p.out + O_SCS + (size_t)(l * NS + s) * 3 * 1024;
        so[ch] = s1; so[1024 + ch] = s2; so[2048 + ch] = cur;
        if (tid < 4) {
            const int h = 4 * g + tid;
            const float dt = softplusf_(((const float*)(p.ws + W_DT))[t * 8 + h] + p.in[20][l * 8 + h]);
            sdt[tid] = dt; sdt[4 + tid] = fexp_(-dt * fexp_(p.in[21][l * 8 + h]));
        }
    }
    __syncthreads();
    {
        const int n4 = (tid & 31) * 4, pr = tid >> 5;
        const f32x4 bv = *(const LAS f32x4*)(sv + 256 + n4), cv = *(const LAS f32x4*)(sv + 384 + n4);
        float part[4][4]; bf16_t zr[4][4];
#pragma unroll
        for (int hl = 0; hl < 4; ++hl)
#pragma unroll
            for (int ps = 0; ps < 4; ++ps) zr[hl][ps] = prow[PC_Z + (4 * g + hl) * 64 + ps * 16 + pr];
#pragma unroll
        for (int hl = 0; hl < 4; ++hl) {
            const int h = 4 * g + hl;
            const float dt = sdt[hl], eda = sdt[4 + hl];
            float* S1 = p.out + O_SS + ((size_t)(l * NS + s) * 8 + h) * 8192;
#pragma unroll
            for (int ps = 0; ps < 4; ++ps) {
                const int pp = ps * 16 + pr;
                const float xp = sv[hl * 64 + pp];
                const f32x4 sn = ssd0[hl][ps] * eda + bv * (dt * xp);
                __builtin_nontemporal_store(sn, (f32x4*)(S1 + pp * 128 + n4));
                part[hl][ps] = cv[0] * sn[0] + cv[1] * sn[1] + cv[2] * sn[2] + cv[3] * sn[3];
            }
        }
#pragma unroll
        for (int o = 16; o >= 1; o >>= 1)
#pragma unroll
            for (int hl = 0; hl < 4; ++hl)
#pragma unroll
                for (int ps = 0; ps < 4; ++ps) part[hl][ps] += shfl_xor_(part[hl][ps], o, lane);
        if ((tid & 31) == 0) {
#pragma unroll
            for (int hl = 0; hl < 4; ++hl)
#pragma unroll
                for (int ps = 0; ps < 4; ++ps) { const int pp = ps * 16 + pr; const float y = part[hl][ps] + p.in[22][l * 8 + 4 * g + hl] * sv[hl * 64 + pp]; gy[hl * 64 + pp] = y * siluf_(bf2f(zr[hl][ps])); }
        }
    }
    __syncthreads();
    {
        const f32x4 v = *(const LAS f32x4*)(gy + lane * 4);
        const float ssq = wave_sum(v[0] * v[0] + v[1] * v[1] + v[2] * v[2] + v[3] * v[3], lane);
        const float rstd = rsqrtf(ssq * (1.f / 256.f) + EPS);
        if (tid < 256) mix[t * DMIX + 1024 + g * 256 + tid] = f2bf(gy[tid] * rstd * p.in[23][l * 512 + g * 256 + tid]);
    }
    if (tid < 128) {
        const int hh = tid >> 6, w = (tid >> 5) & 1, d = tid & 31, h = 2 * g + hh;
        const int col = (w ? PC_K : PC_Q) + h * 64;
        const float x1 = bf2f(prow[col + d]), x2 = bf2f(prow[col + 32 + d]);
        const float* rc = (const float*)(p.ws + W_ROPE); const float* rs = rc + 2049 * 32;
        const float cs = rc[2048 * 32 + d], sn = rs[2048 * 32 + d], sc = w ? 0.125f : 1.f;
        sq[w * 128 + hh * 64 + d] = (x1 * cs - x2 * sn) * sc; sq[w * 128 + hh * 64 + 32 + d] = (x1 * sn + x2 * cs) * sc;
    }
    __syncthreads();
#pragma unroll
    for (int hh = 0; hh < 2; ++hh) {
        const int h = 2 * g + hh;
        const float gh = 1.f - exp2f(-5.f - (float)h);
        const int v4 = (tid & 31) * 4, kr = tid >> 5;
        float vv[4]; unpack4(*(const u32x2*)(prow + PC_V + h * 128 + v4), vv);
        const float* S0 = p.in[4] + ((size_t)(l * NS + s) * 4 + h) * 8192; float* S1 = p.out + O_RS + ((size_t)(l * NS + s) * 4 + h) * 8192;
        f32x4 part = {0.f, 0.f, 0.f, 0.f};
#pragma unroll
        for (int ps = 0; ps < 4; ++ps) {
            const int k = ps * 16 + kr;
            const float kk = sq[128 + hh * 64 + k], qq = sq[hh * 64 + k];
            const f32x4 s0 = ret0[hh][ps];
            f32x4 sn; sn[0] = gh * s0[0] + kk * vv[0]; sn[1] = gh * s0[1] + kk * vv[1]; sn[2] = gh * s0[2] + kk * vv[2]; sn[3] = gh * s0[3] + kk * vv[3];
            __builtin_nontemporal_store(sn, (f32x4*)(S1 + k * 128 + v4));
            part = part + sn * qq;
        }
#pragma unroll
        for (int i = 0; i < 4; ++i) part[i] += shfl_xor_(part[i], 32, lane);
        if (lane < 32) *(LAS f32x4*)(ro + wid * 128 + v4) = part;
        __syncthreads();
        if (tid < 128) {
            float o = 0.f;
#pragma unroll
            for (int w = 0; w < 8; ++w) o += ro[w * 128 + tid];
            float ssq = wave_sum(o * o, lane);
            ro[1024 + tid] = o; if (lane == 0) ro[1152 + wid] = ssq;
        }
        __syncthreads();
        if (tid < 128) {
            const float rstd = rsqrtf((ro[1152] + ro[1153]) * (1.f / 128.f) + EPS);
            const float o = ro[1024 + tid];
            mix[t * DMIX + 512 + h * 128 + tid] = f2bf(siluf_(bf2f(prow[PC_RG + h * 128 + tid])) * (o * rstd * p.in[17][l * 512 + h * 128 + tid]));
        }
        __syncthreads();
    }
    if (tid < 256) {
        const int ch = 256 * g + tid;
        const float* cw = p.in[10] + (size_t)l * 4 * 512; const float* st = p.in[2] + (size_t)(l * NS + s) * 3 * 512;
        const float cur = bf2f(prow[PC_LX + ch]);
        const float s0 = st[ch], s1 = st[512 + ch], s2 = st[1024 + ch];
        sxc[tid] = p.in[11][l * 512 + ch] + cw[ch] * s0 + cw[512 + ch] * s1 + cw[1024 + ch] * s2 + cw[1536 + ch] * cur;
        float* so = p.out + O_LCS + (size_t)(l * NS + s) * 3 * 512;
        so[ch] = s1; so[512 + ch] = s2; so[1024 + ch] = cur;
    }
    __syncthreads();
    if (tid < 256) {
        const int j = tid & 63, hl = tid >> 6, h = 4 * g + hl, ch = h * 64 + j;
        const float* wr = p.in[12] + (size_t)(l * 8 + h) * 4096; const float* wi = p.in[14] + (size_t)(l * 8 + h) * 4096;
        float r = 0.f, ig = 0.f;
        for (int i = 0; i < 64; ++i) { const float xv = sxc[hl * 64 + i]; r += xv * wr[i * 64 + j]; ig += xv * wi[i * 64 + j]; }
        r = sigmoidf_(r + p.in[13][l * 512 + ch]); ig = sigmoidf_(ig + p.in[15][l * 512 + ch]);
        const float sp = log1pf(fexp_(-p.in[16][l * 512 + ch]));
        const float la = -8.f * r * sp, a = fexp_(la);
        const float hn = a * p.in[3][(size_t)(l * NS + s) * 512 + ch] + __builtin_amdgcn_sqrtf(fmaxf(-expm1f(2.f * la), 0.f)) * ig * sxc[tid];
        p.out[O_LHS + (size_t)(l * NS + s) * 512 + ch] = hn;
        mix[t * DMIX + ch] = f2bf(hn * geluf_(bf2f(prow[PC_LG + ch])));
    }
    __syncthreads();
}

#ifndef ITMASK
#define ITMASK 0xFF
#endif
#define IT_EN(x) (((ITMASK) >> (x)) & 1)
#ifndef REP_ITEM
#define REP_ITEM 0
#endif
__device__ void phase_m1(const Params& p, LAS unsigned char* lds, int l) {
    for (int rr = 0; rr < 1 + ((REP_ITEM >> 0) & 1); ++rr) { if (IT_EN(0)) for (int it = blockIdx.x; it < 256; it += gridDim.x) ret_m1(p, lds, it >> 5, it & 31); }
    for (int rr = 0; rr < 1 + ((REP_ITEM >> 1) & 1); ++rr) { if (IT_EN(1)) for (int it = blockIdx.x; it < 256; it += gridDim.x) ssd_m1(p, lds, l, it >> 5, it & 31); }
    for (int rr = 0; rr < 1 + ((REP_ITEM >> 2) & 1); ++rr) { if (IT_EN(2)) for (int it = blockIdx.x; it < 256; it += gridDim.x) lru_item<1>(p, lds, l, it >> 5, it & 31); }
    for (int rr = 0; rr < 1 + ((REP_ITEM >> 3) & 1); ++rr) { if (IT_EN(3)) for (int it = blockIdx.x; it < 256; it += gridDim.x) sample_item(p, lds, l, it >> 1, it & 1); }
    const bf16_t* proj = (const bf16_t*)(p.ws + W_PROJ);
    const int gt = blockIdx.x * 512 + TIDX, gn = gridDim.x * 512;
    for (int u = gt; u < NB * 3 * 1536; u += gn) {
        const int b = u / (3 * 1536), r = u % (3 * 1536), k = r / 1536, cc = r % 1536;
        const size_t row = (size_t)b * SEQ + SEQ - 3 + k;
        if (cc < 512) p.out[O_LCP + ((size_t)(l * NB + b) * 3 + k) * 512 + cc] = bf2f(proj[row * NPROJ + PC_LX + cc]);
        else p.out[O_SCP + ((size_t)(l * NB + b) * 3 + k) * 1024 + cc - 512] = bf2f(proj[row * NPROJ + PC_XBC + cc - 512]);
    }
}
__device__ void phase_m2(const Params& p, LAS unsigned char* lds, int l) {
    for (int rr = 0; rr < 1 + ((REP_ITEM >> 4) & 1); ++rr) { if (IT_EN(4)) for (int it = blockIdx.x; it < 512; it += gridDim.x) ret_m2(p, lds, l, it >> 6, (it >> 1) & 31, it & 1); }
    for (int rr = 0; rr < 1 + ((REP_ITEM >> 5) & 1); ++rr) { if (IT_EN(5)) for (int it = blockIdx.x; it < 512; it += gridDim.x) ssd_m2(p, lds, l, it >> 6, (it >> 1) & 31, it & 1); }
    for (int rr = 0; rr < 1 + ((REP_ITEM >> 6) & 1); ++rr) { if (IT_EN(6)) for (int it = blockIdx.x; it < 256; it += gridDim.x) lru_item<2>(p, lds, l, it >> 5, it & 31); }
}


#define XB_TMO      128
#define XB_XCNT(j)  (256  + 64 * (j))
#define XB_XSUB(j)  (1280 + 64 * (j))
#define XB_XGEN(j)  (2304 + 64 * (j))
#define XB_TOP      3328
#define XB_TOPGEN   3392
#define XCD_BAR_WORDS 3456
#define XB_SPIN_CAP (1u << 22)
__device__ __forceinline__ unsigned xb_ld(unsigned* p)              { return __hip_atomic_load(p, __ATOMIC_RELAXED, __HIP_MEMORY_SCOPE_AGENT); }
__device__ __forceinline__ unsigned xb_add(unsigned* p, unsigned v) { return __hip_atomic_fetch_add(p, v, __ATOMIC_RELAXED, __HIP_MEMORY_SCOPE_AGENT); }
__device__ __forceinline__ unsigned xb_xcc_id() { return (unsigned)__builtin_amdgcn_s_getreg((3 << 11) | 20) & 0xFu; }
#define XB_SPIN(cond, bar) do { unsigned _sp = 0; while (cond) { __builtin_amdgcn_s_sleep(1); \
    if ((++_sp & 255u) == 0u) { if (xb_ld(&(bar)[XB_TMO])) break; if (_sp > XB_SPIN_CAP) { atomicAdd(&(bar)[XB_TMO], 1u); break; } } } } while (0)
struct XcdBarrier { unsigned* bar; unsigned x; volatile LAS unsigned* st; };
__device__ __forceinline__ XcdBarrier xcd_barrier_post(unsigned* bar, volatile LAS unsigned* st) {
    XcdBarrier b; b.bar = bar; b.x = xb_xcc_id(); b.st = st;
    if (threadIdx.x == 0) (void)xb_add(&bar[XB_XCNT(b.x)], 1u);
    return b;
}
__device__ __forceinline__ void xcd_barrier_complete(unsigned* bar, unsigned x, unsigned& nloc, unsigned& nx) {
    const unsigned G = gridDim.x * gridDim.y * gridDim.z;
    unsigned sum, cnt, mine, sp = 0u;
    for (;;) {
        sum = 0u; cnt = 0u; mine = 0u;
#pragma unroll
        for (unsigned j = 0; j < 16; ++j) { const unsigned c = xb_ld(&bar[XB_XCNT(j)]); sum += c; cnt += (c > 0u) ? 1u : 0u; mine = (j == x) ? c : mine; }
        if (sum == G) break;
        __builtin_amdgcn_s_sleep(1);
        if ((++sp & 255u) == 0u) { if (xb_ld(&bar[XB_TMO])) break; if (sp > XB_SPIN_CAP) { atomicAdd(&bar[XB_TMO], 1u); break; } }
    }
    nloc = mine > 0u ? mine : 1u; nx = cnt > 0u ? cnt : 1u;
}
__device__ __forceinline__ void xcd_barrier(const XcdBarrier& b) {
    asm volatile("s_waitcnt vmcnt(0)" ::: "memory");
    __syncthreads();
    if (threadIdx.x == 0) {
        unsigned* bar = b.bar;
        __builtin_amdgcn_s_waitcnt(0);
        unsigned nloc = b.st[0], nx = b.st[1];
        if (nloc == 0u) { xcd_barrier_complete(bar, b.x, nloc, nx); b.st[0] = nloc; b.st[1] = nx; }
        const unsigned old = xb_add(&bar[XB_XSUB(b.x)], 1u);
        const unsigned gen = old / nloc;
        if (old + 1u == (gen + 1u) * nloc) {
            __builtin_amdgcn_fence(__ATOMIC_RELEASE, "agent");
            asm volatile("s_waitcnt vmcnt(0)" ::: "memory");
            const unsigned og = xb_add(&bar[XB_TOP], 1u);
            const unsigned tg = og / nx;
            if (og + 1u == (tg + 1u) * nx) xb_add(&bar[XB_TOPGEN], 1u);
            else XB_SPIN(xb_ld(&bar[XB_TOPGEN]) == tg, bar);
            __builtin_amdgcn_fence(__ATOMIC_ACQUIRE, "agent");
            xb_add(&bar[XB_XGEN(b.x)], 1u);
            asm volatile("s_waitcnt vmcnt(0)" ::: "memory");
        } else {
            XB_SPIN(xb_ld(&bar[XB_XGEN(b.x)]) == gen, bar);
            __builtin_amdgcn_fence(__ATOMIC_ACQUIRE, "agent");
            asm volatile("s_waitcnt vmcnt(0)" ::: "memory");
        }
    }
    __syncthreads();
}

constexpr int NPHASE = 2 + 7 * DEPTH;
#ifndef PHMASK
#define PHMASK 0xFFF
#endif
#define PH_EN(x) (((PHMASK) >> (x)) & 1)
__device__ __forceinline__ void run_phase(const Params& p, LAS unsigned char* lds, int ph) {
    if (ph == 0) { if (PH_EN(10)) phase_prep(p, lds); return; }
    if (ph == NPHASE - 1) { if (PH_EN(11)) phase_final(p); return; }
    const int l = (ph - 1) / 7, s = (ph - 1) % 7;
    bf16_t* mix = (bf16_t*)(p.ws + W_HB); bf16_t* xb = (bf16_t*)(p.ws + W_XB); bf16_t* big = (bf16_t*)(p.ws + W_PROJ); bf16_t* act = (bf16_t*)(p.ws + W_DS);
    u64* rss = (u64*)(p.ws + W_RSS);
    pg8::StaticOrder S;
    switch (s) {
    case 0: if (PH_EN(1)) {
        const bf16_t* W = (const bf16_t*)(p.ws + W_WIN) + (size_t)l * NPROJ * DM;
        const u64* r = rss + (size_t)(2 * l) * TT;
        S.init(TP, NPROJ, gridDim.x, blockIdx.x);
        pg8::gemm_phase(lds, pg8::Gemm{xb, W, TP, NPROJ, DM}, S, pg8::EpiBf16{big, NPROJ, r});
        phase_dt(p, l);
        thin_gemm<DM, 0>(lds, xb + (size_t)TP * DM, W, NPROJ, big + (size_t)TP * NPROJ, NPROJ, nullptr, (u64*)r + TP);
    } break;
    case 1: if (PH_EN(2)) phase_m1(p, lds, l); break;
    case 2: if (PH_EN(3)) phase_m15(p, l); break;
    case 3: if (PH_EN(4)) phase_m2(p, lds, l); break;
    case 4: if (PH_EN(5)) {
        const bf16_t* W = (const bf16_t*)(p.ws + W_WOUT) + (size_t)l * DM * DMIX;
        u64* r = rss + (size_t)(2 * l + 1) * TT;
        S.init(TP, DM, gridDim.x, blockIdx.x);
        pg8::gemm_phase(lds, pg8::Gemm{mix, W, TP, DM, DMIX}, S, pg8::EpiResid{DM, xb, r});
        thin_gemm<DMIX, 1>(lds, mix + (size_t)TP * DMIX, W, DM, nullptr, DM, xb + (size_t)TP * DM, r + TP);
    } break;
    case 5: if (PH_EN(7)) {
        const bf16_t* W = (const bf16_t*)(p.ws + W_WUP) + (size_t)l * DGU * DM;
        const u64* r = rss + (size_t)(2 * l + 1) * TT;
        const float* cw = p.in[27] + (size_t)l * 3 * DFF; const float* cb = p.in[28] + (size_t)l * DFF;
        S.init(TP, DGU, gridDim.x, blockIdx.x);
        pg8::gemm_phase(lds, pg8::Gemm{xb, W, TP, DGU, DM}, S, pg8::EpiAct{act, r, cw, cb, (bf16_t*)(p.ws + W_GS01), (bf16_t*)(p.ws + W_US01), (bf16_t*)(p.ws + W_GS23), p.out + O_FCP + (size_t)l * NB * 2 * DFF});
        thin_gemm_act(lds, xb + (size_t)TP * DM, W, r + TP, cw, cb, p.in[7] + (size_t)l * NS * 2 * DFF, p.out + O_FCS + (size_t)l * NS * 2 * DFF, act + (size_t)TP * DFF);
    } break;
    case 6: if (PH_EN(9)) {
        const bf16_t* W = (const bf16_t*)(p.ws + W_WDOWN) + (size_t)l * DM * DFF;
        u64* r = rss + (size_t)(2 * l + 2) * TT;
        S.init(TP, DM, gridDim.x, blockIdx.x);
        { pg8::Unit uu; for (int i = 0; S.next(i, uu); ++i) act_fixup(p, l, uu.pm); __threadfence(); __syncthreads(); }
        pg8::gemm_phase(lds, pg8::Gemm{act, W, TP, DM, DFF}, S, pg8::EpiResid{DM, xb, r});
        thin_gemm<DFF, 1>(lds, act + (size_t)TP * DFF, W, DM, nullptr, DM, xb + (size_t)TP * DM, r + TP);
    } break;
    }
}

__global__ void __launch_bounds__(512, 2) mega(Params p, int ph0, int ph1, int coop) {
    extern __shared__ __attribute__((aligned(16))) unsigned char shm[];
    LAS unsigned char* lds = (LAS unsigned char*)shm;
    cg::grid_group grid = cg::this_grid();
    volatile LAS unsigned* st = (volatile LAS unsigned*)(lds + LDS_BYTES);
    if (threadIdx.x < 4) st[threadIdx.x] = 0u;
    __syncthreads();
    XcdBarrier xb = xcd_barrier_post((unsigned*)(p.ws + W_BAR), st);
    for (int ph = ph0; ph < ph1; ++ph) {
        int reps = 1;
#ifdef REP_MASK
        { const int s = (ph == 0) ? 10 : (ph == NPHASE - 1 ? 11 : (ph - 1) % 7); if ((REP_MASK >> s) & 1) reps = 2; }
#endif
        for (int r = 0; r < reps; ++r) { run_phase(p, lds, ph); if (reps > 1) __syncthreads(); }
        if (coop && ph + 1 < ph1) {
            if (coop == 2) grid.sync();
            xcd_barrier(xb);
#ifdef REP_SYNC
            xcd_barrier(xb);
#endif
        }
    }
}

extern "C" void kernel_launch(void* const* d_in, const int* in_sizes, int n_in, void* d_out, int out_size, void* d_ws, size_t ws_size, hipStream_t stream) {
    static int grid_blocks = 0;
    if (!grid_blocks) {
        int dev = 0, cus = 0, per_cu = 0;
        hipGetDevice(&dev);
        hipDeviceGetAttribute(&cus, hipDeviceAttributeMultiprocessorCount, dev);
        hipFuncSetAttribute((const void*)mega, hipFuncAttributeMaxDynamicSharedMemorySize, LDS_BYTES + 16);
        hipOccupancyMaxActiveBlocksPerMultiprocessor(&per_cu, (const void*)mega, 512, LDS_BYTES + 16);
        if (per_cu < 1) per_cu = 1;
        grid_blocks = cus * per_cu;
        if (grid_blocks > 256) grid_blocks = 256;
        if (ws_size < W_END) fprintf(stderr, "kernel_launch: workspace too small: %zu < %zu\n", ws_size, (size_t)W_END);
    }
    Params p{};
    for (int i = 0; i < 31; ++i) p.in[i] = (const float*)d_in[i];
    p.out = (float*)d_out; p.ws = (unsigned char*)d_ws;
    hipMemsetAsync((unsigned char*)d_ws + W_BAR, 0, XCD_BAR_WORDS * 4, stream);
    int ph0 = 0, ph1 = NPHASE, coop = 1;
    void* args[] = {&p, &ph0, &ph1, &coop};
    hipError_t e = hipLaunchCooperativeKernel((const void*)mega, dim3(grid_blocks), dim3(512), args, LDS_BYTES + 16, stream);
    if (e != hipSuccess) fprintf(stderr, "cooperative launch failed: %s (grid %d)\n", hipGetErrorString(e), grid_blocks);
}
```

```cpp
#include <hip/hip_runtime.h>
#include <hip/hip_cooperative_groups.h>
#include <cstdio>
namespace cg = cooperative_groups;

#define LAS __attribute__((address_space(3)))
typedef unsigned short bf16_t;
typedef short bf16x8 __attribute__((ext_vector_type(8)));
typedef short s16x4 __attribute__((ext_vector_type(4)));
typedef float f32x4 __attribute__((ext_vector_type(4)));
typedef float f32x2 __attribute__((ext_vector_type(2)));
typedef unsigned u32x4 __attribute__((ext_vector_type(4)));
typedef unsigned u32x2 __attribute__((ext_vector_type(2)));

constexpr int DM = 1024, NB = 8, SEQ = 2048, DEPTH = 4, NS = 128;
constexpr int TP = NB * SEQ;
constexpr int TT = TP + NS;
constexpr int DLRU = 512, DIN = 4104, NPROJ = 4096, DMIX = 1536, DFF = 2816, DGU = 5632;
constexpr int NCH = 32;
constexpr float EPS = 1e-6f;
constexpr int PC_LX = 0, PC_LG = 512, PC_Q = 1024, PC_K = 1280, PC_V = 1536, PC_RG = 2048, PC_Z = 2560, PC_XBC = 3072;

constexpr size_t O_Y = 0;
constexpr size_t O_LCP = (size_t)TT * DM;
constexpr size_t O_LCS = O_LCP + (size_t)DEPTH * NB * 3 * 512;
constexpr size_t O_LHP = O_LCS + (size_t)DEPTH * NS * 3 * 512;
constexpr size_t O_LHS = O_LHP + (size_t)DEPTH * NB * 512;
constexpr size_t O_RP = O_LHS + (size_t)DEPTH * NS * 512;
constexpr size_t O_RS = O_RP + (size_t)DEPTH * NB * 4 * 64 * 128;
constexpr size_t O_SCP = O_RS + (size_t)DEPTH * NS * 4 * 64 * 128;
constexpr size_t O_SCS = O_SCP + (size_t)DEPTH * NB * 3 * 1024;
constexpr size_t O_SP = O_SCS + (size_t)DEPTH * NS * 3 * 1024;
constexpr size_t O_SS = O_SP + (size_t)DEPTH * NB * 8 * 64 * 128;
constexpr size_t O_FCP = O_SS + (size_t)DEPTH * NS * 8 * 64 * 128;
constexpr size_t O_FCS = O_FCP + (size_t)DEPTH * NB * 2 * DFF;

constexpr size_t W_WIN = 0;
constexpr size_t W_WOUT = W_WIN + (size_t)DEPTH * NPROJ * DM * 2;
constexpr size_t W_WUP = W_WOUT + (size_t)DEPTH * DM * DMIX * 2;
constexpr size_t W_WDOWN = W_WUP + (size_t)DEPTH * DGU * DM * 2;
constexpr size_t W_LRUW = W_WDOWN + (size_t)DEPTH * DM * DFF * 2;
constexpr size_t W_ROPE = W_LRUW + (size_t)2 * DEPTH * 8 * 64 * 64 * 2;
constexpr size_t W_DT = W_ROPE + 524800;
constexpr size_t W_LRUAB = W_DT + (size_t)TT * 8 * 4;
constexpr size_t W_LRUHIN = W_LRUAB + (size_t)NB * NCH * 512 * 2 * 4;
constexpr size_t W_DEC = W_LRUHIN + (size_t)NB * NCH * 512 * 4;
constexpr size_t W_RSS = W_DEC + 8192;
constexpr size_t W_WDT = W_RSS + (size_t)9 * TT * 8;
constexpr size_t W_HB = W_WDT + (size_t)DEPTH * 16 * DM * 2;
constexpr size_t W_XB = W_HB + (size_t)TT * DMIX * 2;
constexpr size_t W_PROJ = W_XB + (size_t)TT * DM * 2;
constexpr size_t W_SPR = W_PROJ + (size_t)TT * NPROJ * 2;
constexpr size_t W_SPS = W_SPR + (size_t)NB * 4 * NCH * 8192 * 2;
static_assert(W_SPS + (size_t)NB * 8 * NCH * 8192 * 2 <= W_PROJ + (size_t)TT * DGU * 2, "Sp does not fit behind proj");
constexpr size_t W_DS = W_PROJ + (size_t)TT * DGU * 2;
constexpr size_t W_DSSSD = W_DS + (size_t)NB * 4 * NCH * 8192 * 4;
constexpr size_t W_BAR = W_DSSSD + (size_t)NB * 8 * NCH * 8192 * 4;
constexpr size_t W_GS01 = W_BAR + 16384;
constexpr size_t W_US01 = W_GS01 + (size_t)256 * 2 * DFF * 2;
constexpr size_t W_GS23 = W_US01 + (size_t)256 * 2 * DFF * 2;
constexpr size_t W_END = W_GS23 + (size_t)256 * 2 * DFF * 2;
static_assert(W_END <= (size_t)512 * 1024 * 1024, "workspace budget");
constexpr int LDS_BYTES = 131072;

struct Params { const float* in[31]; float* out; unsigned char* ws; };

typedef unsigned long long u64;
__device__ __forceinline__ u64 ss_fix(float ss) { return (u64)(ss * 1048576.f + 0.5f); }
__device__ __forceinline__ float rstd_fix(u64 v) { return rsqrtf((float)v * (1.f / (1048576.f * 1024.f)) + 1e-6f); }
__device__ __forceinline__ int opaque_tid() { int t = threadIdx.x; asm volatile("" : "+v"(t)); return t; }
#define TIDX opaque_tid()
__device__ __forceinline__ float bf2f(bf16_t v) { return __uint_as_float(((unsigned)v) << 16); }
__device__ __forceinline__ unsigned pk2(float lo, float hi) { unsigned r; asm volatile("v_cvt_pk_bf16_f32 %0, %1, %2" : "=v"(r) : "v"(lo), "v"(hi)); return r; }
__device__ __forceinline__ bf16_t f2bf(float f) { return (bf16_t)(pk2(f, 0.f) & 0xffffu); }
__device__ __forceinline__ void unpack8(u32x4 w, float* f) {
    f[0] = __uint_as_float(w.x << 16); f[1] = __uint_as_float(w.x & 0xffff0000u);
    f[2] = __uint_as_float(w.y << 16); f[3] = __uint_as_float(w.y & 0xffff0000u);
    f[4] = __uint_as_float(w.z << 16); f[5] = __uint_as_float(w.z & 0xffff0000u);
    f[6] = __uint_as_float(w.w << 16); f[7] = __uint_as_float(w.w & 0xffff0000u);
}
__device__ __forceinline__ void unpack4(u32x2 w, float* f) {
    f[0] = __uint_as_float(w.x << 16); f[1] = __uint_as_float(w.x & 0xffff0000u);
    f[2] = __uint_as_float(w.y << 16); f[3] = __uint_as_float(w.y & 0xffff0000u);
}
__device__ __forceinline__ u32x4 pack8(const float* f) { u32x4 w; w.x = pk2(f[0], f[1]); w.y = pk2(f[2], f[3]); w.z = pk2(f[4], f[5]); w.w = pk2(f[6], f[7]); return w; }
__device__ __forceinline__ float fexp_(float x) { return __builtin_amdgcn_exp2f(x * 1.44269504089f); }
__device__ __forceinline__ float sigmoidf_(float x) { return __builtin_amdgcn_rcpf(1.f + fexp_(-x)); }
__device__ __forceinline__ float siluf_(float x) { return x * __builtin_amdgcn_rcpf(1.f + fexp_(-x)); }
__device__ __forceinline__ float geluf_(float x) { const float z = x * __builtin_fmaf(x * x, 0.1029432397f, 2.302208198f); const float r = __builtin_amdgcn_rcpf(1.f + __builtin_amdgcn_exp2f(z)); return __builtin_fmaf(-x, r, x); }
__device__ __forceinline__ float softplusf_(float x) { return x > 20.f ? x : log1pf(fexp_(x)); }
__device__ __forceinline__ float shfl_idx(float v, int src) { return __int_as_float(__builtin_amdgcn_ds_bpermute(src << 2, __float_as_int(v))); }
__device__ __forceinline__ float shfl_xor_(float v, int o, int lane) { return shfl_idx(v, lane ^ o); }
__device__ __forceinline__ float shfl_up_(float v, int o, int lane) { return shfl_idx(v, (lane - o) & 63); }
__device__ __forceinline__ float wave_sum(float v, int lane) {
#pragma unroll
    for (int o = 32; o >= 1; o >>= 1) v += shfl_xor_(v, o, lane);
    return v;
}
template <int N> __device__ __forceinline__ float dpp_shr(float old, float src) { return __int_as_float(__builtin_amdgcn_update_dpp(__float_as_int(old), __float_as_int(src), 0x110 + N, 0xf, 0xf, false)); }
template <int N> __device__ __forceinline__ float dpp_ror(float src) { return __int_as_float(__builtin_amdgcn_update_dpp(0, __float_as_int(src), 0x120 + N, 0xf, 0xf, false)); }
__device__ __forceinline__ bf16x8 frag_row(const LAS bf16_t* t, int ld, int r0, int k0, int fr, int fq) {
    return *(const LAS bf16x8*)(t + (r0 + fr) * ld + k0 + 8 * fq);
}
__device__ __forceinline__ bf16x8 frag_tr(const LAS bf16_t* t, int ld, int k0, int c0, int fr, int fq) {
    const LAS bf16_t* p = t + (k0 + 8 * fq + (fr >> 2)) * ld + c0 + 4 * (fr & 3);
    s16x4 lo = __builtin_bit_cast(s16x4, __builtin_amdgcn_ds_read_tr16_b64_v4i16((LAS s16x4*)p));
    s16x4 hi = __builtin_bit_cast(s16x4, __builtin_amdgcn_ds_read_tr16_b64_v4i16((LAS s16x4*)(p + 4 * ld)));
    bf16x8 r; r[0] = lo[0]; r[1] = lo[1]; r[2] = lo[2]; r[3] = lo[3]; r[4] = hi[0]; r[5] = hi[1]; r[6] = hi[2]; r[7] = hi[3]; return r;
}
#define MFMA(X, Y, C) __builtin_amdgcn_mfma_f32_16x16x32_bf16((X), (Y), (C), 0, 0, 0)

namespace pg8 {
constexpr int BM = 256, BK = 64, HALF = 128, HTB = HALF * BK * 2, NXCD = 8, WGM = 8;
__device__ __forceinline__ int lds_byte(int r, int c) { const int st = (r >> 4) * 2 + (c >> 5), rr = r & 15, cc = c & 31, ob = rr * 64 + cc * 2; return st * 1024 + (ob ^ (((ob >> 9) & 1) << 5)); }
__device__ __forceinline__ void stage_rc(int b, int& R, int& C) { const int st = b / 1024, sb = b % 1024, swz = sb ^ (((sb >> 9) & 1) << 5); R = (st >> 1) * 16 + swz / 64; C = (st & 1) * 32 + (swz % 64) / 2; }
__device__ __forceinline__ int perm32(int rho) { const int n = rho >> 4, i = rho & 15; return 8 * (i >> 2) + 4 * n + (i & 3); }
struct Unit { int pm, pn; };
struct Gemm { const bf16_t* A; const bf16_t* Bt; int M, N, K; };
struct StaticOrder {
    int nM, nN, nwg, G, c;
    __device__ void init(int M, int N, int G_, int c_) { nM = M / BM; nN = N / BM; nwg = nM * nN; G = G_; c = c_; }
    __device__ bool next(int i, Unit& u) const {
        const long L = (long)i * G + c; if (L >= nwg) return false;
        int wgid = (int)L; { const int q = nwg / NXCD, r = nwg % NXCD, xcd = wgid % NXCD, off = wgid / NXCD; wgid = (xcd < r ? xcd * (q + 1) : r * (q + 1) + (xcd - r) * q) + off; }
        const int nig = WGM * nN, gid = wgid / nig, fm = gid * WGM, gsz = (nM - fm) < WGM ? (nM - fm) : WGM;
        u.pm = fm + ((wgid % nig) % gsz); u.pn = (wgid % nig) / gsz; return true;
    }
};
template <class Epi>
__device__ __forceinline__ void gemm_phase(LAS unsigned char* lds, const Gemm g, const StaticOrder& S, const Epi& E) {
    const int tid = TIDX, wid = __builtin_amdgcn_readfirstlane(tid >> 6), lane = tid & 63, wr = wid >> 2, wc = wid & 3, fr = lane & 15, fq = lane >> 4;
    const int K = g.K, nt = K / BK;
    unsigned voffA[2], voffB[2];
#pragma unroll
    for (int i = 0; i < 2; ++i) { int R, C; stage_rc(tid * 16 + i * 8192, R, C); const int Rb = Epi::PERM ? ((R & ~31) + perm32(R & 31)) : R;
        voffA[i] = (unsigned)(R * K + C) * 2u; voffB[i] = (unsigned)(Rb * K + C) * 2u; }
    const size_t kstep = (size_t)(BK * 2);
    const size_t hstep = (size_t)HALF * K * 2;
    const size_t tstep = 2 * hstep;
    const unsigned ldsw = (unsigned)wid * 1024u;
    const int aoff = lds_byte(wr * 64 + fr, fq * 8), boff = lds_byte(wc * 32 + fr, fq * 8);
#define PG8_SA(b, h) (((b) * 2 + (h)) * HTB)
#define PG8_SB(b, h) ((4 + (b) * 2 + (h)) * HTB)
#define PG8_STAGE(bufoff, gbase, voff) do { _Pragma("unroll") for (int _i = 0; _i < 2; ++_i) \
        __builtin_amdgcn_global_load_lds((const unsigned*)((const char*)(gbase) + (voff)[_i]), (LAS unsigned*)(lds + (bufoff) + ldsw + _i * 8192), 16, 0, 0); } while (0)
#define PG8_LDA(dst, b, h) do { _Pragma("unroll") for (int m = 0; m < 4; ++m) _Pragma("unroll") for (int k = 0; k < 2; ++k) dst[m][k] = *(const LAS bf16x8*)(lds + PG8_SA(b, h) + aoff + m * 2048 + k * 1024); } while (0)
#define PG8_LDB(dst, b, h) do { _Pragma("unroll") for (int n = 0; n < 2; ++n) _Pragma("unroll") for (int k = 0; k < 2; ++k) dst[n][k] = *(const LAS bf16x8*)(lds + PG8_SB(b, h) + boff + n * 2048 + k * 1024); } while (0)
#define PG8_MMA(ai, bj, At, Bt) do { __builtin_amdgcn_s_setprio(1); _Pragma("unroll") for (int m = 0; m < 4; ++m) _Pragma("unroll") for (int n = 0; n < 2; ++n) _Pragma("unroll") for (int k = 0; k < 2; ++k) \
        acc[ai][bj][m][n] = __builtin_amdgcn_mfma_f32_16x16x32_bf16(Bt[n][k], At[m][k], acc[ai][bj][m][n], 0, 0, 0); __builtin_amdgcn_s_setprio(0); } while (0)
#define PG8_WAIT_V(n) asm volatile("s_waitcnt vmcnt(" #n ")" ::: "memory")
#define PG8_WAIT_L(n) asm volatile("s_waitcnt lgkmcnt(" #n ")" ::: "memory")
#define PG8_BAR __builtin_amdgcn_s_barrier()
#define PG8_SCHED __builtin_amdgcn_sched_barrier(0)
    Unit cur, nxt; int ui = 0;
    if (!S.next(0, cur)) return;
    f32x4 acc[2][2][4][2];
#pragma unroll
    for (int a = 0; a < 2; ++a)
#pragma unroll
        for (int b = 0; b < 2; ++b)
#pragma unroll
            for (int m = 0; m < 4; ++m)
#pragma unroll
                for (int n = 0; n < 2; ++n) acc[a][b][m][n] = (f32x4){0.f, 0.f, 0.f, 0.f};
    bf16x8 At[4][2], B0[2][2], B1[2][2];
    const char* cA = (const char*)g.A + (size_t)cur.pm * tstep; const char* cB = (const char*)g.Bt + (size_t)cur.pn * tstep;
    PG8_STAGE(PG8_SB(0, 0), cB, voffB); PG8_STAGE(PG8_SA(0, 0), cA, voffA); PG8_STAGE(PG8_SB(0, 1), cB + hstep, voffB); PG8_STAGE(PG8_SA(0, 1), cA + hstep, voffA);
    if (wr == 1) PG8_BAR;
    PG8_WAIT_V(4); PG8_BAR;
    PG8_STAGE(PG8_SB(1, 0), cB + kstep, voffB); PG8_STAGE(PG8_SA(1, 0), cA + kstep, voffA); PG8_STAGE(PG8_SB(1, 1), cB + hstep + kstep, voffB);
    PG8_WAIT_V(6); PG8_BAR;
    for (;;) {
        const bool has_next = S.next(ui + 1, nxt);
        const char* nA = has_next ? (const char*)g.A + (size_t)nxt.pm * tstep : cA; const char* nB = has_next ? (const char*)g.Bt + (size_t)nxt.pn * tstep : cB;
        for (int t = 0; t < nt; t += 2) {
            const bool last = (t == nt - 2);
            const char* a1 = cA + (size_t)(t + 1) * kstep;
            const char* a2 = last ? nA : cA + (size_t)(t + 2) * kstep; const char* b2 = last ? nB : cB + (size_t)(t + 2) * kstep;
            const char* a3 = a2 + kstep; const char* b3 = b2 + kstep;
            PG8_LDB(B0, 0, 0); PG8_SCHED; PG8_LDA(At, 0, 0); PG8_STAGE(PG8_SA(1, 1), a1 + hstep, voffA);
            PG8_WAIT_L(8); PG8_BAR; PG8_WAIT_L(0); PG8_MMA(0, 0, At, B0); PG8_BAR; PG8_SCHED;
            PG8_LDB(B1, 0, 1); PG8_STAGE(PG8_SB(0, 0), b2, voffB);
            PG8_BAR; PG8_WAIT_L(0); PG8_MMA(0, 1, At, B1); PG8_BAR;
            PG8_LDA(At, 0, 1); PG8_STAGE(PG8_SA(0, 0), a2, voffA);
            PG8_BAR; PG8_WAIT_L(0); PG8_MMA(1, 0, At, B0); PG8_BAR; PG8_SCHED;
            PG8_STAGE(PG8_SB(0, 1), b2 + hstep, voffB);
            PG8_WAIT_V(6); PG8_BAR; PG8_MMA(1, 1, At, B1); PG8_BAR;
            PG8_LDB(B0, 1, 0); PG8_SCHED; PG8_LDA(At, 1, 0); PG8_STAGE(PG8_SA(0, 1), a2 + hstep, voffA);
            PG8_WAIT_L(8); PG8_BAR; PG8_WAIT_L(0); PG8_MMA(0, 0, At, B0); PG8_BAR; PG8_SCHED;
            PG8_LDB(B1, 1, 1); PG8_STAGE(PG8_SB(1, 0), b3, voffB);
            PG8_BAR; PG8_WAIT_L(0); PG8_MMA(0, 1, At, B1); PG8_BAR;
            PG8_LDA(At, 1, 1); PG8_STAGE(PG8_SA(1, 0), a3, voffA);
            PG8_BAR; PG8_WAIT_L(0); PG8_MMA(1, 0, At, B0); PG8_BAR; PG8_SCHED;
            PG8_STAGE(PG8_SB(1, 1), b3 + hstep, voffB);
            PG8_WAIT_V(6); PG8_BAR; PG8_MMA(1, 1, At, B1); PG8_BAR;
        }
        if constexpr (Epi::AFTER_DRAIN) { if (has_next) E(acc, cur, wr, wc, fr, fq); } else E(acc, cur, wr, wc, fr, fq);
        if (!has_next) break;
#pragma unroll
        for (int a = 0; a < 2; ++a)
#pragma unroll
            for (int b = 0; b < 2; ++b)
#pragma unroll
                for (int m = 0; m < 4; ++m)
#pragma unroll
                    for (int n = 0; n < 2; ++n) acc[a][b][m][n] = (f32x4){0.f, 0.f, 0.f, 0.f};
        cur = nxt; cA = nA; cB = nB; ++ui;
    }
    PG8_WAIT_V(0);
    if (wr == 0) PG8_BAR;
    PG8_BAR;
    if constexpr (Epi::AFTER_DRAIN) E.fused(acc, cur, wr, wc, fr, fq, lds, wid, lane);
#undef PG8_SA
#undef PG8_SB
#undef PG8_STAGE
#undef PG8_LDA
#undef PG8_LDB
#undef PG8_MMA
#undef PG8_WAIT_V
#undef PG8_WAIT_L
#undef PG8_BAR
#undef PG8_SCHED
}
struct EpiBf16 {
    static constexpr bool PERM = true, AFTER_DRAIN = false;
    bf16_t* O; int ldc; const u64* rss;
    __device__ __forceinline__ void operator()(const f32x4 (&acc)[2][2][4][2], const Unit& u, int wr, int wc, int fr, int fq) const {
        const int row0 = u.pm * BM + wr * 64 + fr, col0 = u.pn * BM + wc * 32 + 8 * fq;
        u64 rv[2][4];
#pragma unroll
        for (int ai = 0; ai < 2; ++ai)
#pragma unroll
            for (int m = 0; m < 4; ++m) rv[ai][m] = rss[row0 + ai * HALF + m * 16];
#pragma unroll
        for (int ai = 0; ai < 2; ++ai)
#pragma unroll
            for (int m = 0; m < 4; ++m) { const int row = row0 + ai * HALF + m * 16; bf16_t* rowp = O + (size_t)row * ldc + col0;
                const float rs = rstd_fix(rv[ai][m]);
#pragma unroll
                for (int bj = 0; bj < 2; ++bj) { const f32x4 v0 = acc[ai][bj][m][0] * rs, v1 = acc[ai][bj][m][1] * rs;
                    u32x4 w; w.x = pk2(v0[0], v0[1]); w.y = pk2(v0[2], v0[3]); w.z = pk2(v1[0], v1[1]); w.w = pk2(v1[2], v1[3]);
                    *(u32x4*)(rowp + bj * HALF) = w; } }
    }
};
struct EpiResid {
    static constexpr bool PERM = false, AFTER_DRAIN = true;
    int ldc; bf16_t* xb; u64* rss;
    __device__ __forceinline__ void operator()(const f32x4 (&acc)[2][2][4][2], const Unit& u, int wr, int wc, int fr, int fq) const {
        const int row0 = u.pm * BM + wr * 64 + fr, col0 = u.pn * BM + wc * 32 + 4 * fq, lane = fr | (fq << 4);
#pragma unroll
        for (int ai = 0; ai < 2; ++ai)
#pragma unroll
            for (int m = 0; m < 4; ++m) { const int row = row0 + ai * HALF + m * 16; bf16_t* xbp = xb + (size_t)row * ldc + col0;
                float ss = 0.f;
#pragma unroll
                for (int bj = 0; bj < 2; ++bj)
#pragma unroll
                    for (int n = 0; n < 2; ++n) { u32x2* pp = (u32x2*)(xbp + bj * HALF + n * 16); float o[4]; unpack4(*pp, o);
                        u32x2 w; w.x = pk2(o[0] + acc[ai][bj][m][n][0], o[1] + acc[ai][bj][m][n][1]); w.y = pk2(o[2] + acc[ai][bj][m][n][2], o[3] + acc[ai][bj][m][n][3]); *pp = w;
                        unpack4(w, o); ss += o[0] * o[0] + o[1] * o[1] + o[2] * o[2] + o[3] * o[3]; }
                ss += shfl_xor_(ss, 16, lane); ss += shfl_xor_(ss, 32, lane);
                if (fq == 0) atomicAdd(rss + row, ss_fix(ss)); }
    }
    __device__ __forceinline__ void fused(const f32x4 (&acc)[2][2][4][2], const Unit& u, int wr, int wc, int fr, int fq, LAS unsigned char* lds, int wid, int lane) const {
        LAS f32x4* t = (LAS f32x4*)lds;
#pragma unroll
        for (int ai = 0; ai < 2; ++ai) {
            const int rbase = u.pm * BM + ai * HALF + wid * 16, col = u.pn * BM + lane * 4;
            u32x2 xv[16];
#pragma unroll
            for (int i = 0; i < 16; ++i) xv[i] = *(const u32x2*)(xb + (size_t)(rbase + i) * ldc + col);
#pragma unroll
            for (int m = 0; m < 4; ++m)
#pragma unroll
                for (int bj = 0; bj < 2; ++bj)
#pragma unroll
                    for (int n = 0; n < 2; ++n) { const int r = 64 * wr + 16 * m + fr, chunk = 32 * bj + 8 * wc + 4 * n + fq; t[r * 64 + (chunk ^ (r & 15))] = acc[ai][bj][m][n]; }
            __syncthreads();
            float myss = 0.f;
#pragma unroll
            for (int i = 0; i < 16; ++i) { const int r = wid * 16 + i;
                const f32x4 a = t[r * 64 + (lane ^ (r & 15))]; float o[4]; unpack4(xv[i], o);
                u32x2 w; w.x = pk2(o[0] + a[0], o[1] + a[1]); w.y = pk2(o[2] + a[2], o[3] + a[3]); *(u32x2*)(xb + (size_t)(rbase + i) * ldc + col) = w;
                unpack4(w, o);
                const float ss = wave_sum(o[0] * o[0] + o[1] * o[1] + o[2] * o[2] + o[3] * o[3], lane);
                if (lane == i) myss = ss; }
            if (lane < 16) atomicAdd(rss + rbase + lane, ss_fix(myss));
            __syncthreads();
        }
    }
};
struct EpiAct {
    static constexpr bool PERM = true, AFTER_DRAIN = false;
    bf16_t* act; const u64* rss; const float* cw; const float* cb; bf16_t* gs01; bf16_t* us01; bf16_t* gs23; float* fcp;
    __device__ __forceinline__ void operator()(const f32x4 (&acc)[2][2][4][2], const Unit& u, int wr, int wc, int fr, int fq) const {
        const int row0 = u.pm * BM + wr * 64 + fr, f0 = u.pn * HALF + wc * 32 + 8 * fq;
        float w0[8], w1[8], w2[8], bb[8];
        *(f32x4*)w0 = *(const f32x4*)(cw + f0); *(f32x4*)(w0 + 4) = *(const f32x4*)(cw + f0 + 4);
        *(f32x4*)w1 = *(const f32x4*)(cw + DFF + f0); *(f32x4*)(w1 + 4) = *(const f32x4*)(cw + DFF + f0 + 4);
        *(f32x4*)w2 = *(const f32x4*)(cw + 2 * DFF + f0); *(f32x4*)(w2 + 4) = *(const f32x4*)(cw + 2 * DFF + f0 + 4);
        *(f32x4*)bb = *(const f32x4*)(cb + f0); *(f32x4*)(bb + 4) = *(const f32x4*)(cb + f0 + 4);
        u64 rv[2][4];
#pragma unroll
        for (int ai = 0; ai < 2; ++ai)
#pragma unroll
            for (int m = 0; m < 4; ++m) rv[ai][m] = rss[row0 + ai * HALF + m * 16];
#pragma unroll
        for (int ai = 0; ai < 2; ++ai) {
            float gp[8];
#pragma unroll
            for (int e = 0; e < 8; ++e) gp[e] = 0.f;
#pragma unroll
            for (int m = 0; m < 4; ++m) {
                const int row = row0 + ai * HALF + m * 16;
                const float rs = rstd_fix(rv[ai][m]);
                float g[8], up[8], o[8];
#pragma unroll
                for (int e = 0; e < 8; ++e) { g[e] = acc[ai][0][m][e >> 2][e & 3] * rs; up[e] = acc[ai][1][m][e >> 2][e & 3] * rs; }
#pragma unroll
                for (int e = 0; e < 8; ++e) {
                    const float g1 = dpp_shr<1>(dpp_ror<1>(gp[e]), g[e]);
                    const float g2 = dpp_shr<2>(dpp_ror<2>(gp[e]), g[e]);
                    const float y = bb[e] + w0[e] * g2 + w1[e] * g1 + w2[e] * g[e];
                    o[e] = geluf_(y) * up[e];
                }
                if (m == 0 && fr < 2) {
                    const size_t so = ((size_t)(row >> 6) * 2 + fr) * DFF + f0;
                    *(u32x4*)(gs01 + so) = pack8(g); *(u32x4*)(us01 + so) = pack8(up);
                } else *(u32x4*)(act + (size_t)row * DFF + f0) = pack8(o);
                if (m == 3 && fr >= 14) *(u32x4*)(gs23 + ((size_t)(row >> 6) * 2 + (fr - 14)) * DFF + f0) = pack8(g);
                const int ts = row & (SEQ - 1);
                if (ts >= SEQ - 2) { float* fo = fcp + ((size_t)(row >> 11) * 2 + (ts - (SEQ - 2))) * DFF + f0;
                    *(f32x4*)fo = (f32x4){g[0], g[1], g[2], g[3]}; *(f32x4*)(fo + 4) = (f32x4){g[4], g[5], g[6], g[7]}; }
#pragma unroll
                for (int e = 0; e < 8; ++e) gp[e] = g[e];
            }
        }
    }
};
struct EpiDry {
    static constexpr bool PERM = false, AFTER_DRAIN = false;
    float* C;
    __device__ __forceinline__ void operator()(const f32x4 (&acc)[2][2][4][2], const Unit& u, int wr, int wc, int fr, int fq) const {
        float s = 0.f;
#pragma unroll
        for (int ai = 0; ai < 2; ++ai)
#pragma unroll
            for (int bj = 0; bj < 2; ++bj)
#pragma unroll
                for (int m = 0; m < 4; ++m)
#pragma unroll
                    for (int n = 0; n < 2; ++n) s += acc[ai][bj][m][n][0] + acc[ai][bj][m][n][1] + acc[ai][bj][m][n][2] + acc[ai][bj][m][n][3];
        if (s != s) C[0] = s;
    }
};
}

template <int K, int MODE  >
__device__ __forceinline__ void thin_gemm(LAS unsigned char* lds, const bf16_t* A, const bf16_t* Bt, int N, void* out, int ldc, bf16_t* xb, u64* rss) {
    const int tid = TIDX, wid = tid >> 6, lane = tid & 63, fr = lane & 15, fq = lane >> 4;
    constexpr int KW = K / 8, STEPS = KW / 32;
    const int ntask = (N / 16) * 8;
    LAS f32x4* red = (LAS f32x4*)lds;
    const int per = (ntask + (int)gridDim.x - 1) / (int)gridDim.x, t0 = blockIdx.x * per, t1 = min(ntask, t0 + per);
    for (int base = t0; base < t1; base += 8) {
        const int nr = min(8, t1 - base);
#pragma unroll (STEPS <= 4 ? 4 : 2)
        for (int i = 0; i < nr; ++i) {
            const int t = base + i, ct = t >> 3, rt = t & 7;
            const bf16_t* ap = A + (size_t)(rt * 16 + fr) * K + wid * KW + 8 * fq;
            const bf16_t* bp = Bt + (size_t)(ct * 16 + fr) * K + wid * KW + 8 * fq;
            bf16x8 a[STEPS], b[STEPS];
#pragma unroll
            for (int s = 0; s < STEPS; ++s) { a[s] = *(const bf16x8*)(ap + 32 * s); b[s] = *(const bf16x8*)(bp + 32 * s); }
            f32x4 acc = {0.f, 0.f, 0.f, 0.f};
#pragma unroll
            for (int s = 0; s < STEPS; ++s) acc = MFMA(b[s], a[s], acc);
            red[(i * 8 + wid) * 64 + lane] = acc;
        }
        __syncthreads();
        if (wid < nr) {
            const int t = base + wid, ct = t >> 3, rt = t & 7;
            f32x4 s = red[(wid * 8) * 64 + lane];
#pragma unroll
            for (int w = 1; w < 8; ++w) s = s + red[(wid * 8 + w) * 64 + lane];
            const int row = rt * 16 + fr, col = ct * 16 + 4 * fq;
            if (MODE == 0) { const float rs = rstd_fix(rss[row]);
                u32x2 w2; w2.x = pk2(s[0] * rs, s[1] * rs); w2.y = pk2(s[2] * rs, s[3] * rs); *(u32x2*)((bf16_t*)out + (size_t)row * ldc + col) = w2; }
            else { u32x2* pp = (u32x2*)(xb + (size_t)row * ldc + col); float o[4]; unpack4(*pp, o);
                u32x2 w2; w2.x = pk2(o[0] + s[0], o[1] + s[1]); w2.y = pk2(o[2] + s[2], o[3] + s[3]); *pp = w2;
                unpack4(w2, o);
                float ss = o[0] * o[0] + o[1] * o[1] + o[2] * o[2] + o[3] * o[3];
                ss += shfl_xor_(ss, 16, lane); ss += shfl_xor_(ss, 32, lane);
                if (fq == 0) atomicAdd(rss + row, ss_fix(ss)); }
        }
        __syncthreads();
    }
}

__device__ __forceinline__ void thin_gemm_act(LAS unsigned char* lds, const bf16_t* A, const bf16_t* Bt, const u64* rss, const float* cw, const float* cb, const float* st, float* fo, bf16_t* act) {
    const int tid = TIDX, wid = tid >> 6, lane = tid & 63, fr = lane & 15, fq = lane >> 4;
    constexpr int K = DM, KW = K / 8, STEPS = KW / 32;
    const int ntask = (DFF / 16) * 8;
    LAS f32x4* red = (LAS f32x4*)lds;
    const int per = (ntask + (int)gridDim.x - 1) / (int)gridDim.x, t0 = blockIdx.x * per, t1 = min(ntask, t0 + per);
    for (int base = t0; base < t1; base += 8) {
        const int nr = min(8, t1 - base);
#pragma unroll 2
        for (int i = 0; i < nr; ++i) {
            const int t = base + i, ft = t >> 3, rt = t & 7;
            const int f = ft * 16 + fr, wrow = 256 * (f >> 7) + (f & 127);
            const bf16_t* ap = A + (size_t)(rt * 16 + fr) * K + wid * KW + 8 * fq;
            const bf16_t* bg = Bt + (size_t)wrow * K + wid * KW + 8 * fq;
            const bf16_t* bu = bg + (size_t)128 * K;
            bf16x8 a[STEPS], b1[STEPS], b2[STEPS];
#pragma unroll
            for (int s = 0; s < STEPS; ++s) { a[s] = *(const bf16x8*)(ap + 32 * s); b1[s] = *(const bf16x8*)(bg + 32 * s); b2[s] = *(const bf16x8*)(bu + 32 * s); }
            f32x4 ag = {0.f, 0.f, 0.f, 0.f}, au = {0.f, 0.f, 0.f, 0.f};
#pragma unroll
            for (int s = 0; s < STEPS; ++s) { ag = MFMA(b1[s], a[s], ag); au = MFMA(b2[s], a[s], au); }
            red[(i * 8 + wid) * 64 + lane] = ag; red[4096 + (i * 8 + wid) * 64 + lane] = au;
        }
        __syncthreads();
        if (wid < nr) {
            const int t = base + wid, ft = t >> 3, rt = t & 7;
            f32x4 g = red[(wid * 8) * 64 + lane], up = red[4096 + (wid * 8) * 64 + lane];
#pragma unroll
            for (int w = 1; w < 8; ++w) { g = g + red[(wid * 8 + w) * 64 + lane]; up = up + red[4096 + (wid * 8 + w) * 64 + lane]; }
            const int s = rt * 16 + fr, f = ft * 16 + 4 * fq;
            const float rs = rstd_fix(rss[s]);
            g = g * rs; up = up * rs;
            const f32x4 p0 = *(const f32x4*)(st + ((size_t)s * 2 + 0) * DFF + f), p1 = *(const f32x4*)(st + ((size_t)s * 2 + 1) * DFF + f);
            const f32x4 c0 = *(const f32x4*)(cw + f), c1 = *(const f32x4*)(cw + DFF + f), c2 = *(const f32x4*)(cw + 2 * DFF + f), cbv = *(const f32x4*)(cb + f);
            float o[4];
#pragma unroll
            for (int e = 0; e < 4; ++e) o[e] = geluf_(cbv[e] + c0[e] * p0[e] + c1[e] * p1[e] + c2[e] * g[e]) * up[e];
            u32x2 w2; w2.x = pk2(o[0], o[1]); w2.y = pk2(o[2], o[3]); *(u32x2*)(act + (size_t)s * DFF + f) = w2;
            *(f32x4*)(fo + ((size_t)s * 2 + 0) * DFF + f) = p1; *(f32x4*)(fo + ((size_t)s * 2 + 1) * DFF + f) = g;
        }
        __syncthreads();
    }
}
__device__ __forceinline__ void act_fixup(const Params& p, int l, int pm) {
    const bf16_t* gs01 = (const bf16_t*)(p.ws + W_GS01); const bf16_t* us01 = (const bf16_t*)(p.ws + W_US01); const bf16_t* gs23 = (const bf16_t*)(p.ws + W_GS23);
    bf16_t* act = (bf16_t*)(p.ws + W_DS);
    const float* cw = p.in[27] + (size_t)l * 3 * DFF; const float* cb = p.in[28] + (size_t)l * DFF;
    const int tid = TIDX;
    constexpr int NU = 8 * (DFF / 8), NK = (NU + 511) / 512;
    u32x4 rg[NK], ru[NK], r1[NK], r2[NK];
#pragma unroll
    for (int k = 0; k < NK; ++k) {
        const int idx = tid + 512 * k;
        rg[k] = ru[k] = r1[k] = r2[k] = (u32x4){0u, 0u, 0u, 0u};
        if (idx < NU) {
            const int rsel = idx / (DFF / 8), c0 = (idx % (DFF / 8)) * 8, blk = pm * 4 + (rsel >> 1), rr = rsel & 1;
            const bool seq0 = (blk & 31) == 0;
            rg[k] = *(const u32x4*)(gs01 + ((size_t)blk * 2 + rr) * DFF + c0);
            ru[k] = *(const u32x4*)(us01 + ((size_t)blk * 2 + rr) * DFF + c0);
            if (rr == 0) { if (!seq0) { r1[k] = *(const u32x4*)(gs23 + ((size_t)(blk - 1) * 2 + 1) * DFF + c0); r2[k] = *(const u32x4*)(gs23 + ((size_t)(blk - 1) * 2 + 0) * DFF + c0); } }
            else { r1[k] = *(const u32x4*)(gs01 + ((size_t)blk * 2 + 0) * DFF + c0); if (!seq0) r2[k] = *(const u32x4*)(gs23 + ((size_t)(blk - 1) * 2 + 1) * DFF + c0); }
        }
    }
#pragma unroll
    for (int k = 0; k < NK; ++k) {
        const int idx = tid + 512 * k;
        if (idx < NU) {
            const int rsel = idx / (DFF / 8), c0 = (idx % (DFF / 8)) * 8, blk = pm * 4 + (rsel >> 1), rr = rsel & 1;
            float g[8], up[8], g1[8], g2[8], o[8];
            unpack8(rg[k], g); unpack8(ru[k], up); unpack8(r1[k], g1); unpack8(r2[k], g2);
#pragma unroll
            for (int e = 0; e < 8; ++e) o[e] = geluf_(cb[c0 + e] + cw[c0 + e] * g2[e] + cw[DFF + c0 + e] * g1[e] + cw[2 * DFF + c0 + e] * g[e]) * up[e];
            *(u32x4*)(act + ((size_t)blk * 64 + rr) * DFF + c0) = pack8(o);
        }
    }
}

__device__ void phase_prep(const Params& p, LAS unsigned char* lds) {
    const int tid = TIDX;
    LAS float* tl = (LAS float*)lds;
    for (int grp = blockIdx.x; grp < DEPTH * 3520 / 4; grp += gridDim.x) {
        const float* src[4]; bf16_t* dst[4]; int Ks[4], ldns[4]; const float* gs[4];
        f32x4 v[4][2];
#pragma unroll
        for (int q = 0; q < 4; ++q) {
            const int idx = grp * 4 + q;
            const int l = idx / 3520; int r = idx % 3520;
            int kt, nt;
            if (r < 1024) { gs[q] = p.in[8] + l * DM; src[q] = p.in[9] + (size_t)l * DM * DIN; ldns[q] = DIN; Ks[q] = DM; dst[q] = (bf16_t*)(p.ws + W_WIN) + (size_t)l * NPROJ * DM; nt = r % 64; kt = r / 64; }
            else if (r < 1408) { r -= 1024; gs[q] = nullptr; src[q] = p.in[24] + (size_t)l * DMIX * DM; ldns[q] = DM; Ks[q] = DMIX; dst[q] = (bf16_t*)(p.ws + W_WOUT) + (size_t)l * DM * DMIX; nt = r % 16; kt = r / 16; }
            else if (r < 2816) { r -= 1408; gs[q] = p.in[25] + l * DM; src[q] = p.in[26] + (size_t)l * DM * DGU; ldns[q] = DGU; Ks[q] = DM; dst[q] = (bf16_t*)(p.ws + W_WUP) + (size_t)l * DGU * DM; nt = r % 88; kt = r / 88; }
            else { r -= 2816; gs[q] = nullptr; src[q] = p.in[29] + (size_t)l * DFF * DM; ldns[q] = DM; Ks[q] = DFF; dst[q] = (bf16_t*)(p.ws + W_WDOWN) + (size_t)l * DM * DFF; nt = r % 16; kt = r / 16; }
            int drow = nt * 64;
            if (ldns[q] == DGU) { const int f = drow < DFF ? drow : drow - DFF; drow = 256 * (f >> 7) + (f & 127) + (drow < DFF ? 0 : 128); }
            src[q] += (size_t)(kt * 64) * ldns[q] + nt * 64; dst[q] += (size_t)drow * Ks[q] + kt * 64;
#pragma unroll
            for (int ps = 0; ps < 2; ++ps) { v[q][ps] = __builtin_nontemporal_load((const f32x4*)(src[q] + (size_t)((tid >> 4) + ps * 32) * ldns[q] + (tid & 15) * 4)); if (gs[q]) v[q][ps] = v[q][ps] * gs[q][kt * 64 + (tid >> 4) + ps * 32]; }
        }
#pragma unroll
        for (int q = 0; q < 4; ++q)
#pragma unroll
            for (int ps = 0; ps < 2; ++ps) { LAS float* t = tl + q * 4160 + ((tid >> 4) + ps * 32) * 65 + (tid & 15) * 4; t[0] = v[q][ps][0]; t[1] = v[q][ps][1]; t[2] = v[q][ps][2]; t[3] = v[q][ps][3]; }
        __syncthreads();
#pragma unroll
        for (int q = 0; q < 4; ++q) {
            const int n = tid >> 3, kq = tid & 7;
            float f[8];
#pragma unroll
            for (int e = 0; e < 8; ++e) f[e] = tl[q * 4160 + (8 * kq + e) * 65 + n];
            *(u32x4*)(dst[q] + (size_t)n * Ks[q] + 8 * kq) = pack8(f);
        }
        __syncthreads();
    }
    const int gt = blockIdx.x * 512 + tid, gn = gridDim.x * 512;
    {
        bf16_t* wrT = (bf16_t*)(p.ws + W_LRUW); bf16_t* wiT = wrT + DEPTH * 8 * 64 * 64;
        for (int i = gt; i < DEPTH * 8 * 64 * 64; i += gn) {
            const int lh = i >> 12, j = (i >> 6) & 63, ii = i & 63;
            wrT[i] = f2bf(p.in[12][(size_t)lh * 4096 + ii * 64 + j]);
            wiT[i] = f2bf(p.in[14][(size_t)lh * 4096 + ii * 64 + j]);
        }
    }
    {
        float* rc = (float*)(p.ws + W_ROPE); float* rs = rc + 2049 * 32;
        for (int i = gt; i < 2049 * 32; i += gn) {
            const int pos = (i >> 5) < 2048 ? (i >> 5) : 16384; const int d = i & 31;
            const float freq = powf(10000.f, -(float)d / 32.f);
            const float ang = (float)pos * freq;
            rc[i] = cosf(ang); rs[i] = sinf(ang);
        }
    }
    {
        bf16_t* wdt = (bf16_t*)(p.ws + W_WDT);
        for (int i = gt; i < DEPTH * 16 * DM; i += gn) {
            const int l = i >> 14, j = (i >> 10) & 15, k = i & 1023;
            wdt[i] = j < 8 ? f2bf(p.in[8][l * DM + k] * p.in[9][((size_t)l * DM + k) * DIN + NPROJ + j]) : (bf16_t)0;
        }
    }
    {
        u64* rss = (u64*)(p.ws + W_RSS);
        for (int i = gt; i < 8 * TT; i += gn) rss[TT + i] = 0ull;
    }
    {
        const int wid = tid >> 6, lane = tid & 63;
        bf16_t* xb = (bf16_t*)(p.ws + W_XB); u64* rss = (u64*)(p.ws + W_RSS);
        const int nw = gridDim.x * 8;
        for (int row0 = blockIdx.x * 8 + wid; row0 < TT; row0 += 4 * nw) {
            f32x4 v[4][4];
#pragma unroll
            for (int r = 0; r < 4; ++r) { const int row = row0 + r * nw; const float* src = row < TP ? p.in[0] + (size_t)row * DM : p.in[1] + (size_t)(row - TP) * DM;
#pragma unroll
                for (int i = 0; i < 4; ++i) v[r][i] = row < TT ? __builtin_nontemporal_load((const f32x4*)(src + i * 256 + lane * 4)) : (f32x4){0.f, 0.f, 0.f, 0.f}; }
#pragma unroll
            for (int r = 0; r < 4; ++r) { const int row = row0 + r * nw; float ss = 0.f;
                if (row < TT) {
#pragma unroll
                    for (int i = 0; i < 4; ++i) { u32x2 w; w.x = pk2(v[r][i][0], v[r][i][1]); w.y = pk2(v[r][i][2], v[r][i][3]); *(u32x2*)(xb + (size_t)row * DM + i * 256 + lane * 4) = w;
                        float o[4]; unpack4(w, o); ss += o[0] * o[0] + o[1] * o[1] + o[2] * o[2] + o[3] * o[3]; }
                }
                ss = wave_sum(ss, lane);
                if (lane == 0 && row < TT) rss[row] = ss_fix(ss);
            }
        }
    }
}

__device__ void phase_dt(const Params& p, int l) {
    const int tid = TIDX, wid = tid >> 6, lane = tid & 63, fr = lane & 15, fq = lane >> 4;
    const bf16_t* xb = (const bf16_t*)(p.ws + W_XB); const bf16_t* wdt = (const bf16_t*)(p.ws + W_WDT) + (size_t)l * 16 * DM;
    const u64* rss = (const u64*)(p.ws + W_RSS) + (size_t)(2 * l) * TT; float* dtraw = (float*)(p.ws + W_DT);
    for (int tile = blockIdx.x * 8 + wid; tile < TT / 16; tile += gridDim.x * 8) {
        const bf16_t* ap = xb + (size_t)(tile * 16 + fr) * DM + 8 * fq; const bf16_t* bp = wdt + (size_t)fr * DM + 8 * fq;
        f32x4 acc = {0.f, 0.f, 0.f, 0.f};
#pragma unroll 16
        for (int s = 0; s < 32; ++s) acc = MFMA(*(const bf16x8*)(bp + 32 * s), *(const bf16x8*)(ap + 32 * s), acc);
        const int row = tile * 16 + fr;
        if (fq < 2) { const float rs = rstd_fix(rss[row]); *(f32x4*)(dtraw + (size_t)row * 8 + 4 * fq) = acc * rs; }
    }
}

__device__ void phase_final(const Params& p) {
    const int tid = TIDX, wid = tid >> 6, lane = tid & 63;
    const bf16_t* xb = (const bf16_t*)(p.ws + W_XB);
    const float* g = p.in[30];
    f32x4 g4[4];
#pragma unroll
    for (int i = 0; i < 4; ++i) g4[i] = *(const f32x4*)(g + i * 256 + lane * 4);
    const int nw = gridDim.x * 8;
    for (int row0 = blockIdx.x * 8 + wid; row0 < TT; row0 += 4 * nw) {
        u32x2 raw[4][4];
#pragma unroll
        for (int r = 0; r < 4; ++r) { const int row = row0 + r * nw;
#pragma unroll
            for (int i = 0; i < 4; ++i) raw[r][i] = row < TT ? *(const u32x2*)(xb + (size_t)row * DM + i * 256 + lane * 4) : (u32x2){0u, 0u}; }
#pragma unroll
        for (int r = 0; r < 4; ++r) { const int row = row0 + r * nw;
            f32x4 v[4]; float ss = 0.f;
#pragma unroll
            for (int i = 0; i < 4; ++i) { float o[4]; unpack4(raw[r][i], o); v[i] = (f32x4){o[0], o[1], o[2], o[3]}; ss += o[0] * o[0] + o[1] * o[1] + o[2] * o[2] + o[3] * o[3]; }
            ss = wave_sum(ss, lane);
            const float rstd = rsqrtf(ss * (1.f / DM) + EPS);
            if (row < TT) {
#pragma unroll
                for (int i = 0; i < 4; ++i) __builtin_nontemporal_store(v[i] * rstd * g4[i], (f32x4*)(p.out + (size_t)row * DM + i * 256 + lane * 4));
            }
        }
    }
}


__device__ __forceinline__ float ret_logg(int h) { return log1pf(-exp2f(-5.f - (float)h)); }

template <class CM, class F>
__device__ __forceinline__ void conv64(const bf16_t* proj, int row0, int tseq0, int pc0, const float* cw, const float* cb, int C, int nchunks, CM&& chmap, F&& emit) {
    for (int u = TIDX; u < nchunks * 8; u += 512) {
        const int q = u % nchunks, seg = u / nchunks, c = chmap(q), j0 = seg * 8;
        const bf16_t* src = proj + (size_t)(row0 + j0) * NPROJ + pc0 + c;
        u32x4 raw[11];
        if (tseq0 + j0 == 0) { raw[0] = (u32x4){0u, 0u, 0u, 0u}; raw[1] = raw[0]; raw[2] = raw[0]; }
        else { raw[0] = *(const u32x4*)(src - 3 * NPROJ); raw[1] = *(const u32x4*)(src - 2 * NPROJ); raw[2] = *(const u32x4*)(src - NPROJ); }
#pragma unroll
        for (int j = 0; j < 8; ++j) raw[3 + j] = *(const u32x4*)(src + (size_t)j * NPROJ);
        float w0[8], w1[8], w2[8], w3[8], bb[8];
#pragma unroll
        for (int e = 0; e < 8; ++e) { w0[e] = cw[c + e]; w1[e] = cw[C + c + e]; w2[e] = cw[2 * C + c + e]; w3[e] = cw[3 * C + c + e]; bb[e] = cb[c + e]; }
        float h3[8], h2[8], h1[8];
        unpack8(raw[0], h3); unpack8(raw[1], h2); unpack8(raw[2], h1);
#pragma unroll
        for (int j = 0; j < 8; ++j) {
            float cur[8], y[8];
            unpack8(raw[3 + j], cur);
#pragma unroll
            for (int e = 0; e < 8; ++e) y[e] = bb[e] + w0[e] * h3[e] + w1[e] * h2[e] + w2[e] * h1[e] + w3[e] * cur[e];
            emit(j0 + j, q, c, y);
#pragma unroll
            for (int e = 0; e < 8; ++e) { h3[e] = h2[e]; h2[e] = h1[e]; h1[e] = cur[e]; }
        }
    }
}

__device__ __forceinline__ void rot16(const bf16_t* src, const float* rc, const float* rs, float scale, LAS bf16_t* dst) {
    float x1[16], x2[16], o1[16], o2[16];
    unpack8(*(const u32x4*)src, x1); unpack8(*(const u32x4*)(src + 8), x1 + 8);
    unpack8(*(const u32x4*)(src + 32), x2); unpack8(*(const u32x4*)(src + 40), x2 + 8);
#pragma unroll
    for (int e = 0; e < 16; ++e) { const float c = rc[e], s = rs[e]; o1[e] = (x1[e] * c - x2[e] * s) * scale; o2[e] = (x1[e] * s + x2[e] * c) * scale; }
    *(LAS u32x4*)dst = pack8(o1); *(LAS u32x4*)(dst + 8) = pack8(o1 + 8);
    *(LAS u32x4*)(dst + 32) = pack8(o2); *(LAS u32x4*)(dst + 40) = pack8(o2 + 8);
}

__device__ void ret_m1(const Params& p, LAS unsigned char* lds, int b, int c) {
    const int tid = TIDX, wid = tid >> 6, lane = tid & 63, fr = lane & 15, fq = lane >> 4;
    const bf16_t* proj = (const bf16_t*)(p.ws + W_PROJ);
    const float* rc = (const float*)(p.ws + W_ROPE); const float* rs = rc + 2049 * 32;
    float* dS = (float*)(p.ws + W_DS);
    LAS bf16_t* Kt = (LAS bf16_t*)lds;
    LAS bf16_t* Vt = (LAS bf16_t*)(lds + 33792);
    const int row0 = b * SEQ + c * 64, pos0 = c * 64;
    {
        const int j = tid >> 3, sub = tid & 7, h = sub >> 1, d0 = (sub & 1) * 16;
        const float scale = 0.125f * fexp_((float)(63 - j) * ret_logg(h));
        rot16(proj + (size_t)(row0 + j) * NPROJ + PC_K + h * 64 + d0, rc + (pos0 + j) * 32 + d0, rs + (pos0 + j) * 32 + d0, scale, Kt + j * 264 + h * 64 + d0);
#pragma unroll
        for (int i = 0; i < 8; ++i) { const int id = tid + 512 * i, jj = id >> 6, cc = id & 63;
            *(LAS u32x4*)(Vt + jj * 520 + cc * 8) = *(const u32x4*)(proj + (size_t)(row0 + jj) * NPROJ + PC_V + cc * 8); }
    }
    __syncthreads();
    {
        const int h = wid >> 1, vh = wid & 1;
        bf16x8 X[4][2];
#pragma unroll
        for (int kt = 0; kt < 4; ++kt)
#pragma unroll
            for (int kk = 0; kk < 2; ++kk) X[kt][kk] = frag_tr(Kt, 264, kk * 32, h * 64 + kt * 16, fr, fq);
        float* out = dS + ((size_t)((b * 4 + h) * NCH + c)) * 8192;
#pragma unroll
        for (int vt = 0; vt < 4; ++vt) {
            bf16x8 Y[2];
#pragma unroll
            for (int kk = 0; kk < 2; ++kk) Y[kk] = frag_tr(Vt, 520, kk * 32, h * 128 + vh * 64 + vt * 16, fr, fq);
#pragma unroll
            for (int kt = 0; kt < 4; ++kt) {
                f32x4 a = {0.f, 0.f, 0.f, 0.f};
                a = MFMA(X[kt][0], Y[0], a); a = MFMA(X[kt][1], Y[1], a);
                *(f32x4*)(out + (vh * 64 + vt * 16 + fr) * 64 + kt * 16 + 4 * fq) = a;
            }
        }
    }
    __syncthreads();
}

template <int NH>
__device__ __forceinline__ void ssd_dt_cum(const Params& p, int l, int row0, int h0, LAS float* dtv, LAS float* cum) {
    const int tid = TIDX, hl = tid >> 6, j = tid & 63;
    const float* dtraw = (const float*)(p.ws + W_DT);
    if (hl < NH) {
        const int h = h0 + hl;
        const float dt = softplusf_(dtraw[(size_t)(row0 + j) * 8 + h] + p.in[20][l * 8 + h]);
        float v = -dt * fexp_(p.in[21][l * 8 + h]);
#pragma unroll
        for (int o = 1; o < 64; o <<= 1) { const float t = shfl_up_(v, o, j); if (j >= o) v += t; }
        dtv[hl * 64 + j] = dt; cum[hl * 64 + j] = v;
    }
    __syncthreads();
}

__device__ void ssd_m1(const Params& p, LAS unsigned char* lds, int l, int b, int c) {
    const int tid = TIDX, wid = tid >> 6, lane = tid & 63, fr = lane & 15, fq = lane >> 4;
    const bf16_t* proj = (const bf16_t*)(p.ws + W_PROJ);
    float* dS = (float*)(p.ws + W_DSSSD); float* dec = (float*)(p.ws + W_DEC);
    LAS bf16_t* Xs = (LAS bf16_t*)lds;
    LAS bf16_t* Bm = (LAS bf16_t*)(lds + 66560);
    LAS float* dtv = (LAS float*)(lds + 100352);
    LAS float* cum = dtv + 512;
    LAS float* wl = cum + 512;
    const int row0 = b * SEQ + c * 64;
    ssd_dt_cum<8>(p, l, row0, 0, dtv, cum);
    { const int h = tid >> 6, j = tid & 63; wl[tid] = fexp_(cum[h * 64 + 63] - cum[tid]) * dtv[tid]; if (j == 63) dec[(b * 8 + h) * NCH + c] = fexp_(cum[h * 64 + 63]); }
    __syncthreads();
    conv64(proj, row0, c * 64, PC_XBC, p.in[18] + (size_t)l * 4 * 1024, p.in[19] + l * 1024, 1024, 96, [](int q) { return q * 8; },
           [&](int j, int q, int ch, float* y) {
               float s[8];
               if (ch < 512) { const float w = wl[(ch >> 6) * 64 + j];
#pragma unroll
                   for (int e = 0; e < 8; ++e) s[e] = siluf_(y[e]) * w;
                   *(LAS u32x4*)(Xs + j * 520 + ch) = pack8(s);
               } else {
#pragma unroll
                   for (int e = 0; e < 8; ++e) s[e] = siluf_(y[e]);
                   *(LAS u32x4*)(Bm + j * 264 + ch - 512) = pack8(s);
               }
           });
    __syncthreads();
    {
        const int h = wid, g = h >> 2;
        bf16x8 Y[4][2];
#pragma unroll
        for (int pt = 0; pt < 4; ++pt)
#pragma unroll
            for (int kk = 0; kk < 2; ++kk) Y[pt][kk] = frag_tr(Xs, 520, kk * 32, h * 64 + pt * 16, fr, fq);
        float* out = dS + ((size_t)((b * 8 + h) * NCH + c)) * 8192;
#pragma unroll
        for (int nt = 0; nt < 8; ++nt) {
            bf16x8 X[2];
#pragma unroll
            for (int kk = 0; kk < 2; ++kk) X[kk] = frag_tr(Bm, 264, kk * 32, g * 128 + nt * 16, fr, fq);
#pragma unroll
            for (int pt = 0; pt < 4; ++pt) {
                f32x4 a = {0.f, 0.f, 0.f, 0.f};
                a = MFMA(X[0], Y[pt][0], a); a = MFMA(X[1], Y[pt][1], a);
                *(f32x4*)(out + (pt * 16 + fr) * 128 + nt * 16 + 4 * fq) = a;
            }
        }
    }
    __syncthreads();
}

template <int PASS>
__device__ void lru_item(const Params& p, LAS unsigned char* lds, int l, int b, int c) {
    const int tid = TIDX, wid = tid >> 6, lane = tid & 63, fr = lane & 15, fq = lane >> 4;
    const bf16_t* proj = (const bf16_t*)(p.ws + W_PROJ);
    LAS bf16_t* xc = (LAS bf16_t*)lds;
    const int row0 = b * SEQ + c * 64;
    const int h = wid;
    const bf16_t* wrT = (const bf16_t*)(p.ws + W_LRUW) + (size_t)(l * 8 + h) * 4096;
    const bf16_t* wiT = wrT + DEPTH * 8 * 4096;
    bf16x8 BrA[4][2], BiA[4][2]; float brA[4], biA[4], lamA[4], hinA[4];
#pragma unroll
    for (int n = 0; n < 4; ++n) {
#pragma unroll
        for (int kk = 0; kk < 2; ++kk) { BrA[n][kk] = *(const bf16x8*)(wrT + (n * 16 + fr) * 64 + kk * 32 + 8 * fq); BiA[n][kk] = *(const bf16x8*)(wiT + (n * 16 + fr) * 64 + kk * 32 + 8 * fq); }
        const int ch = h * 64 + n * 16 + fr;
        brA[n] = p.in[13][l * 512 + ch]; biA[n] = p.in[15][l * 512 + ch]; lamA[n] = p.in[16][l * 512 + ch];
        hinA[n] = PASS == 2 ? ((const float*)(p.ws + W_LRUHIN))[(size_t)(b * NCH + c) * 512 + ch] : 0.f;
    }
    conv64(proj, row0, c * 64, PC_LX, p.in[10] + (size_t)l * 4 * 512, p.in[11] + l * 512, 512, 64, [](int q) { return q * 8; },
           [&](int j, int q, int ch, float* y) { *(LAS u32x4*)(xc + j * 520 + ch) = pack8(y); });
    __syncthreads();
    bf16x8 Af[4][2];
#pragma unroll
    for (int m = 0; m < 4; ++m)
#pragma unroll
        for (int kk = 0; kk < 2; ++kk) Af[m][kk] = frag_row(xc, 520, m * 16, h * 64 + kk * 32, fr, fq);
    float* lruAB = (float*)(p.ws + W_LRUAB); const float* hin = (const float*)(p.ws + W_LRUHIN);
    bf16_t* mix = (bf16_t*)(p.ws + W_HB);
#pragma unroll
    for (int n = 0; n < 4; ++n) {
        f32x4 ar[4], ai[4];
        {
            bf16x8 Br[2], Bi[2];
#pragma unroll
            for (int kk = 0; kk < 2; ++kk) { Br[kk] = BrA[n][kk]; Bi[kk] = BiA[n][kk]; }
#pragma unroll
            for (int m = 0; m < 4; ++m) {
                f32x4 a = {0.f, 0.f, 0.f, 0.f}, bq = {0.f, 0.f, 0.f, 0.f};
                a = MFMA(Af[m][0], Br[0], a); a = MFMA(Af[m][1], Br[1], a);
                bq = MFMA(Af[m][0], Bi[0], bq); bq = MFMA(Af[m][1], Bi[1], bq);
                ar[m] = a; ai[m] = bq;
            }
        }
        const int ch = h * 64 + n * 16 + fr;
        const float br = brA[n], bi = biA[n];
        const float sp = log1pf(fexp_(-lamA[n]));
#pragma unroll
        for (int m = 0; m < 4; ++m)
#pragma unroll
            for (int i = 0; i < 4; ++i) {
                const int t = m * 16 + 4 * fq + i;
                const float xv = bf2f(xc[t * 520 + ch]);
                const float r = sigmoidf_(ar[m][i] + br), ig = sigmoidf_(ai[m][i] + bi);
                const float la = -8.f * r * sp;
                const float av = fexp_(la);
                ar[m][i] = av;
                ai[m][i] = __builtin_amdgcn_sqrtf(fmaxf(1.f - av * av, 0.f)) * ig * xv;
            }
        float carry = 0.f, Atot = 1.f;
        if (PASS == 2) carry = hinA[n];
#pragma unroll
        for (int m = 0; m < 4; ++m) {
            const float a0 = ar[m][0], a1 = ar[m][1], a2 = ar[m][2], a3 = ar[m][3];
            const float b0 = ai[m][0], b1 = ai[m][1], b2 = ai[m][2], b3 = ai[m][3];
            float Al = a0 * a1 * a2 * a3, Bl = ((b0 * a1 + b1) * a2 + b2) * a3 + b3;
            float Ap = shfl_up_(Al, 16, lane), Bp = shfl_up_(Bl, 16, lane);
            if (fq >= 1) { Bl = Bp * Al + Bl; Al = Ap * Al; }
            Ap = shfl_up_(Al, 32, lane); Bp = shfl_up_(Bl, 32, lane);
            if (fq >= 2) { Bl = Bp * Al + Bl; Al = Ap * Al; }
            float Aex = shfl_up_(Al, 16, lane), Bex = shfl_up_(Bl, 16, lane);
            if (fq == 0) { Aex = 1.f; Bex = 0.f; }
            const float At = shfl_idx(Al, fr + 48), Bt = shfl_idx(Bl, fr + 48);
            if (PASS == 2) {
                float hh = Aex * carry + Bex;
                hh = a0 * hh + b0; ai[m][0] = hh;
                hh = a1 * hh + b1; ai[m][1] = hh;
                hh = a2 * hh + b2; ai[m][2] = hh;
                hh = a3 * hh + b3; ai[m][3] = hh;
            }
            carry = At * carry + Bt; Atot *= At;
        }
        if (PASS == 1) {
            if (fq == 0) { f32x2 v = {Atot, carry}; *(f32x2*)(lruAB + ((size_t)(b * NCH + c) * 512 + ch) * 2) = v; }
        } else {
            bf16_t gv[4][4];
#pragma unroll
            for (int m = 0; m < 4; ++m)
#pragma unroll
                for (int i = 0; i < 4; ++i) gv[m][i] = proj[(size_t)(row0 + m * 16 + 4 * fq + i) * NPROJ + PC_LG + ch];
#pragma unroll
            for (int m = 0; m < 4; ++m)
#pragma unroll
                for (int i = 0; i < 4; ++i) {
                    const size_t t = row0 + m * 16 + 4 * fq + i;
                    mix[t * DMIX + ch] = f2bf(ai[m][i] * geluf_(bf2f(gv[m][i])));
                }
        }
    }
    __syncthreads();
}

__device__ void phase_m15(const Params& p, int l) {
    const int gt = blockIdx.x * 512 + TIDX, gn = gridDim.x * 512;
    const float* dSr = (const float*)(p.ws + W_DS); const float* dSs = (const float*)(p.ws + W_DSSSD); const float* dec = (const float*)(p.ws + W_DEC);
    bf16_t* spr = (bf16_t*)(p.ws + W_SPR); bf16_t* sps = (bf16_t*)(p.ws + W_SPS);
    for (int u = gt; u < (32 + 64) * 4096; u += gn) {
        float zz = 0.f; asm volatile("" : "+v"(zz));
        f32x2 S = {zz, zz};
        f32x2 tv[NCH];
        if (u < 32 * 4096) {
            const int bh = u >> 12, e2 = u & 4095, h = bh & 3;
            const float* ptr = dSr + (size_t)bh * NCH * 8192 + e2 * 2; bf16_t* sp = spr + (size_t)bh * NCH * 8192 + e2 * 2;
            const float d = fexp_(64.f * ret_logg(h));
#pragma unroll
            for (int c = 0; c < NCH; ++c) tv[c] = *(const f32x2*)(ptr + (size_t)c * 8192);
#pragma unroll
            for (int c = 0; c < NCH; ++c) { *(unsigned*)(sp + (size_t)c * 8192) = pk2(S[0], S[1]); S = S * d + tv[c]; }
            float* o = p.out + O_RP + ((size_t)(l * NB * 4 + bh)) * 8192;
#pragma unroll
            for (int i = 0; i < 2; ++i) { const int e = e2 * 2 + i, v = e >> 6, k = e & 63; o[k * 128 + v] = S[i]; }
        } else {
            const int uu = u - 32 * 4096, bh = uu >> 12, e2 = uu & 4095;
            const float* ptr = dSs + (size_t)bh * NCH * 8192 + e2 * 2; bf16_t* sp = sps + (size_t)bh * NCH * 8192 + e2 * 2;
            float dc[NCH];
#pragma unroll
            for (int c = 0; c < NCH; ++c) { tv[c] = *(const f32x2*)(ptr + (size_t)c * 8192); dc[c] = dec[bh * NCH + c]; }
#pragma unroll
            for (int c = 0; c < NCH; ++c) { *(unsigned*)(sp + (size_t)c * 8192) = pk2(S[0], S[1]); S = S * dc[c] + tv[c]; }
            *(f32x2*)(p.out + O_SP + ((size_t)(l * NB * 8 + bh)) * 8192 + e2 * 2) = S;
        }
    }
    const float* lruAB = (const float*)(p.ws + W_LRUAB); float* hin = (float*)(p.ws + W_LRUHIN);
    for (int u = gt; u < NB * 512; u += gn) {
        const int b = u >> 9, ch = u & 511; float h = 0.f;
        f32x2 ab[NCH];
#pragma unroll
        for (int c = 0; c < NCH; ++c) ab[c] = *(const f32x2*)(lruAB + ((size_t)(b * NCH + c) * 512 + ch) * 2);
#pragma unroll
        for (int c = 0; c < NCH; ++c) { hin[(size_t)(b * NCH + c) * 512 + ch] = h; h = ab[c][0] * h + ab[c][1]; }
        p.out[O_LHP + (size_t)(l * NB + b) * 512 + ch] = h;
    }
}

__device__ void ret_m2(const Params& p, LAS unsigned char* lds, int l, int b, int c, int hp) {
    const int tid = TIDX, wid = tid >> 6, lane = tid & 63, fr = lane & 15, fq = lane >> 4;
    const bf16_t* proj = (const bf16_t*)(p.ws + W_PROJ);
    const float* rc = (const float*)(p.ws + W_ROPE); const float* rs = rc + 2049 * 32;
    const bf16_t* sp = (const bf16_t*)(p.ws + W_SPR);
    bf16_t* mix = (bf16_t*)(p.ws + W_HB);
    const int row0 = b * SEQ + c * 64, pos0 = c * 64;
    constexpr int HB = 63488;
    {
        const int j = tid >> 3, sub = tid & 7, hh = sub >> 2, which = (sub >> 1) & 1, d0 = (sub & 1) * 16, h = 2 * hp + hh;
        LAS bf16_t* dst = (LAS bf16_t*)(lds + hh * HB + which * 9216) + j * 72 + d0;
        rot16(proj + (size_t)(row0 + j) * NPROJ + (which ? PC_K : PC_Q) + h * 64 + d0, rc + (pos0 + j) * 32 + d0, rs + (pos0 + j) * 32 + d0, which ? 0.125f : 1.f, dst);
#pragma unroll
        for (int i = 0; i < 4; ++i) { const int id = tid + 512 * i, h2 = id >> 10, jj = (id >> 4) & 63, cc = id & 15;
            *(LAS u32x4*)((LAS bf16_t*)(lds + h2 * HB + 18432) + jj * 136 + cc * 8) = *(const u32x4*)(proj + (size_t)(row0 + jj) * NPROJ + PC_V + (2 * hp + h2) * 128 + cc * 8); }
#pragma unroll
        for (int i = 0; i < 4; ++i) { const int id = tid + 512 * i, h2 = id >> 10, v = (id >> 3) & 127, kc = id & 7;
            *(LAS u32x4*)((LAS bf16_t*)(lds + h2 * HB + 35840) + v * 72 + kc * 8) = *(const u32x4*)(sp + ((size_t)((b * 4 + 2 * hp + h2) * NCH + c)) * 8192 + v * 64 + kc * 8); }
    }
    __syncthreads();
    const int hh = wid >> 2, it = wid & 3, i0 = it * 16, h = 2 * hp + hh;
    const float lg = ret_logg(h);
    LAS bf16_t* Q = (LAS bf16_t*)(lds + hh * HB); LAS bf16_t* Kk = Q + 64 * 72; LAS bf16_t* V = (LAS bf16_t*)(lds + hh * HB + 18432);
    LAS bf16_t* S = (LAS bf16_t*)(lds + hh * HB + 35840); LAS bf16_t* P = (LAS bf16_t*)(lds + hh * HB + 54272);
    bf16x8 Yq[2];
#pragma unroll
    for (int kk = 0; kk < 2; ++kk) Yq[kk] = frag_row(Q, 72, i0, kk * 32, fr, fq);
    const int irow = i0 + fr;
#pragma unroll
    for (int jt = 0; jt < 4; ++jt) {
        f32x4 sc = {0.f, 0.f, 0.f, 0.f};
#pragma unroll
        for (int kk = 0; kk < 2; ++kk) sc = MFMA(frag_row(Kk, 72, jt * 16, kk * 32, fr, fq), Yq[kk], sc);
        float v[4];
#pragma unroll
        for (int i = 0; i < 4; ++i) { const int j = jt * 16 + 4 * fq + i; v[i] = j <= irow ? sc[i] * fexp_((float)(irow - j) * lg) : 0.f; }
        u32x2 w; w.x = pk2(v[0], v[1]); w.y = pk2(v[2], v[3]);
        *(LAS u32x2*)(P + irow * 72 + jt * 16 + 4 * fq) = w;
    }
    __syncthreads();
    const size_t t = row0 + irow;
    u32x2 rgv[8]; f32x4 ngv[8];
#pragma unroll
    for (int vt = 0; vt < 8; ++vt) { rgv[vt] = *(const u32x2*)(proj + t * NPROJ + PC_RG + h * 128 + vt * 16 + 4 * fq); ngv[vt] = *(const f32x4*)(p.in[17] + l * 512 + h * 128 + vt * 16 + 4 * fq); }
    bf16x8 Yp[2];
#pragma unroll
    for (int kk = 0; kk < 2; ++kk) Yp[kk] = frag_row(P, 72, i0, kk * 32, fr, fq);
    const float qdec = fexp_((float)(irow + 1) * lg);
    f32x4 o[8]; float ssq = 0.f;
#pragma unroll
    for (int vt = 0; vt < 8; ++vt) {
        f32x4 a1 = {0.f, 0.f, 0.f, 0.f}, a2 = {0.f, 0.f, 0.f, 0.f};
#pragma unroll
        for (int kk = 0; kk < 2; ++kk) { a1 = MFMA(frag_tr(V, 136, kk * 32, vt * 16, fr, fq), Yp[kk], a1); a2 = MFMA(frag_row(S, 72, vt * 16, kk * 32, fr, fq), Yq[kk], a2); }
        o[vt] = a1 + a2 * qdec;
        ssq += o[vt][0] * o[vt][0] + o[vt][1] * o[vt][1] + o[vt][2] * o[vt][2] + o[vt][3] * o[vt][3];
    }
    ssq += shfl_xor_(ssq, 16, lane); ssq += shfl_xor_(ssq, 32, lane);
    const float rstd = rsqrtf(ssq * (1.f / 128.f) + EPS);
#pragma unroll
    for (int vt = 0; vt < 8; ++vt) {
        const int v = vt * 16 + 4 * fq;
        float gt[4]; unpack4(rgv[vt], gt);
        const f32x4 ng = ngv[vt];
        float y[4];
#pragma unroll
        for (int i = 0; i < 4; ++i) y[i] = siluf_(gt[i]) * (o[vt][i] * rstd * ng[i]);
        u32x2 w; w.x = pk2(y[0], y[1]); w.y = pk2(y[2], y[3]);
        *(u32x2*)(mix + t * DMIX + 512 + h * 128 + v) = w;
    }
    __syncthreads();
}

__device__ void ssd_m2(const Params& p, LAS unsigned char* lds, int l, int b, int c, int g) {
    const int tid = TIDX, wid = tid >> 6, lane = tid & 63, fr = lane & 15, fq = lane >> 4;
    const bf16_t* proj = (const bf16_t*)(p.ws + W_PROJ);
    const bf16_t* sp = (const bf16_t*)(p.ws + W_SPS);
    bf16_t* mix = (bf16_t*)(p.ws + W_HB);
    const int row0 = b * SEQ + c * 64;
    LAS bf16_t* Cm = (LAS bf16_t*)lds;
    LAS bf16_t* Bm = (LAS bf16_t*)(lds + 17408);
    constexpr int PB = 34816, HB = 35840;
    LAS float* dtv = (LAS float*)(lds + 106496);
    LAS float* cum = dtv + 256;
    LAS float* ssqb = cum + 256;
    ssd_dt_cum<4>(p, l, row0, 4 * g, dtv, cum);
    const float* cw = p.in[18] + (size_t)l * 4 * 1024; const float* cb = p.in[19] + l * 1024;
    conv64(proj, row0, c * 64, PC_XBC, cw, cb, 1024, 32, [g](int q) { return (q < 16 ? 512 : 768 - 128) + g * 128 + q * 8; },
           [&](int j, int q, int ch, float* y) {
               float s[8];
#pragma unroll
               for (int e = 0; e < 8; ++e) s[e] = siluf_(y[e]);
               if (q < 16) *(LAS u32x4*)(Bm + j * 136 + q * 8) = pack8(s); else *(LAS u32x4*)(Cm + j * 136 + (q - 16) * 8) = pack8(s);
           });
    const int hh = wid >> 2, it = wid & 3, i0 = it * 16, irow = i0 + fr;
    const size_t t = row0 + irow;
    f32x4 gy[2][4]; float ssq = 0.f;
#pragma unroll
    for (int pr = 0; pr < 2; ++pr) {
        const int hbase = 4 * g + 2 * pr;
        conv64(proj, row0, c * 64, PC_XBC, cw, cb, 1024, 16, [hbase](int q) { return hbase * 64 + q * 8; },
               [&](int j, int q, int ch, float* y) {
                   float s[8];
#pragma unroll
                   for (int e = 0; e < 8; ++e) s[e] = siluf_(y[e]);
                   *(LAS u32x4*)((LAS bf16_t*)(lds + PB + (q >> 3) * HB + 9216) + j * 72 + (q & 7) * 8) = pack8(s);
               });
#pragma unroll
        for (int i = 0; i < 4; ++i) { const int id = tid + 512 * i, h2 = id >> 10, pp = (id >> 4) & 63, nc = id & 15;
            *(LAS u32x4*)((LAS bf16_t*)(lds + PB + h2 * HB + 18432) + pp * 136 + nc * 8) = *(const u32x4*)(sp + ((size_t)((b * 8 + hbase + h2) * NCH + c)) * 8192 + pp * 128 + nc * 8); }
        __syncthreads();
        const int h = hbase + hh, hl = 2 * pr + hh;
        LAS bf16_t* P = (LAS bf16_t*)(lds + PB + hh * HB); LAS bf16_t* X = P + 64 * 72; LAS bf16_t* S = (LAS bf16_t*)(lds + PB + hh * HB + 18432);
        bf16x8 Yc[4];
#pragma unroll
        for (int kk = 0; kk < 4; ++kk) Yc[kk] = frag_row(Cm, 136, i0, kk * 32, fr, fq);
        const float cumi = cum[hl * 64 + irow];
#pragma unroll
        for (int jh = 0; jh < 2; ++jh) {
            bf16x8 Xb[2][4]; f32x4 cj[2], dj[2];
#pragma unroll
            for (int q = 0; q < 2; ++q) {
#pragma unroll
                for (int kk = 0; kk < 4; ++kk) Xb[q][kk] = frag_row(Bm, 136, (2 * jh + q) * 16, kk * 32, fr, fq);
                cj[q] = *(const LAS f32x4*)(cum + hl * 64 + (2 * jh + q) * 16 + 4 * fq); dj[q] = *(const LAS f32x4*)(dtv + hl * 64 + (2 * jh + q) * 16 + 4 * fq);
            }
#pragma unroll
            for (int q = 0; q < 2; ++q) {
                const int jt = 2 * jh + q;
                f32x4 sc = {0.f, 0.f, 0.f, 0.f};
#pragma unroll
                for (int kk = 0; kk < 4; ++kk) sc = MFMA(Xb[q][kk], Yc[kk], sc);
                float v[4];
#pragma unroll
                for (int i = 0; i < 4; ++i) { const int j = jt * 16 + 4 * fq + i; v[i] = j <= irow ? sc[i] * fexp_(cumi - cj[q][i]) * dj[q][i] : 0.f; }
                u32x2 w; w.x = pk2(v[0], v[1]); w.y = pk2(v[2], v[3]);
                *(LAS u32x2*)(P + irow * 72 + jt * 16 + 4 * fq) = w;
            }
        }
        __syncthreads();
        u32x2 zraw[4];
#pragma unroll
        for (int pt = 0; pt < 4; ++pt) zraw[pt] = *(const u32x2*)(proj + t * NPROJ + PC_Z + h * 64 + pt * 16 + 4 * fq);
        bf16x8 Yp[2];
#pragma unroll
        for (int kk = 0; kk < 2; ++kk) Yp[kk] = frag_row(P, 72, i0, kk * 32, fr, fq);
        const float ecum = fexp_(cumi), Dh = p.in[22][l * 8 + h];
#pragma unroll
        for (int pt = 0; pt < 4; ++pt) {
            f32x4 a1 = {0.f, 0.f, 0.f, 0.f}, a2 = {0.f, 0.f, 0.f, 0.f};
#pragma unroll
            for (int kk = 0; kk < 2; ++kk) a1 = MFMA(frag_tr(X, 72, kk * 32, pt * 16, fr, fq), Yp[kk], a1);
#pragma unroll
            for (int kk = 0; kk < 4; ++kk) a2 = MFMA(frag_row(S, 136, pt * 16, kk * 32, fr, fq), Yc[kk], a2);
            const int pp = pt * 16 + 4 * fq;
            float xv[4], zv[4]; unpack4(*(const LAS u32x2*)(X + irow * 72 + pp), xv);
            unpack4(zraw[pt], zv);
            f32x4 r;
#pragma unroll
            for (int i = 0; i < 4; ++i) { const float y = a1[i] + ecum * a2[i] + Dh * xv[i]; r[i] = y * siluf_(zv[i]); ssq += r[i] * r[i]; }
            gy[pr][pt] = r;
        }
        __syncthreads();
    }
    f32x4 ngv[2][4];
#pragma unroll
    for (int pr = 0; pr < 2; ++pr)
#pragma unroll
        for (int pt = 0; pt < 4; ++pt) ngv[pr][pt] = *(const f32x4*)(p.in[23] + l * 512 + g * 256 + (2 * pr + hh) * 64 + pt * 16 + 4 * fq);
    ssq += shfl_xor_(ssq, 16, lane); ssq += shfl_xor_(ssq, 32, lane);
    if (fq == 0) ssqb[irow * 2 + hh] = ssq;
    __syncthreads();
    const float rstd = rsqrtf((ssqb[irow * 2] + ssqb[irow * 2 + 1]) * (1.f / 256.f) + EPS);
#pragma unroll
    for (int pr = 0; pr < 2; ++pr)
#pragma unroll
        for (int pt = 0; pt < 4; ++pt) {
            const int chn = g * 256 + (2 * pr + hh) * 64 + pt * 16 + 4 * fq;
            const f32x4 ng = ngv[pr][pt];
            u32x2 w; w.x = pk2(gy[pr][pt][0] * rstd * ng[0], gy[pr][pt][1] * rstd * ng[1]); w.y = pk2(gy[pr][pt][2] * rstd * ng[2], gy[pr][pt][3] * rstd * ng[3]);
            *(u32x2*)(mix + t * DMIX + 1024 + chn) = w;
        }
    __syncthreads();
}

__device__ void sample_item(const Params& p, LAS unsigned char* lds, int l, int s, int g) {
    const int tid = TIDX, wid = tid >> 6, lane = tid & 63;
    const bf16_t* proj = (const bf16_t*)(p.ws + W_PROJ);
    bf16_t* mix = (bf16_t*)(p.ws + W_HB);
    const size_t t = TP + s;
    const bf16_t* prow = proj + t * NPROJ;
    LAS float* sv = (LAS float*)lds;
    LAS float* sdt = sv + 512;
    LAS float* gy = sv + 520;
    LAS float* sq = sv + 776;
    LAS float* ro = sv + 1032;
    LAS float* sxc = sv + 2304;
    f32x4 ssd0[4][4], ret0[2][4];
    {
        const int n4 = (tid & 31) * 4, pr = tid >> 5;
#pragma unroll
        for (int hl = 0; hl < 4; ++hl)
#pragma unroll
            for (int ps = 0; ps < 4; ++ps) ssd0[hl][ps] = __builtin_nontemporal_load((const f32x4*)(p.in[6] + ((size_t)(l * NS + s) * 8 + 4 * g + hl) * 8192 + (ps * 16 + pr) * 128 + n4));
#pragma unroll
        for (int hh = 0; hh < 2; ++hh)
#pragma unroll
            for (int ps = 0; ps < 4; ++ps) ret0[hh][ps] = __builtin_nontemporal_load((const f32x4*)(p.in[4] + ((size_t)(l * NS + s) * 4 + 2 * g + hh) * 8192 + (ps * 16 + pr) * 128 + n4));
    }
    {
        const int ch = tid < 256 ? g * 256 + tid : (tid < 384 ? 512 + g * 128 + (tid - 256) : 768 + g * 128 + (tid - 384));
        const float* cw = p.in[18] + (size_t)l * 4 * 1024; const float* st = p.in[5] + (size_t)(l * NS + s) * 3 * 1024;
        const float cur = bf2f(prow[PC_XBC + ch]);
        const float s0 = st[ch], s1 = st[1024 + ch], s2 = st[2048 + ch];
        const float y = p.in[19][l * 1024 + ch] + cw[ch] * s0 + cw[1024 + ch] * s1 + cw[2048 + ch] * s2 + cw[3072 + ch] * cur;
        sv[tid] = siluf_(y);
        float* so = p.out + O_SCS + (size_t)(l * NS + s) * 3 * 1024;
        so[ch] = s1; so[1024 + ch] = s2; so[2048 + ch] = cur;
        if (tid < 4) {
            const int h = 4 * g + tid;
            const float dt = softplusf_(((const float*)(p.ws + W_DT))[t * 8 + h] + p.in[20][l * 8 + h]);
            sdt[tid] = dt; sdt[4 + tid] = fexp_(-dt * fexp_(p.in[21][l * 8 + h]));
        }
    }
    __syncthreads();
    {
        const int n4 = (tid & 31) * 4, pr = tid >> 5;
        const f32x4 bv = *(const LAS f32x4*)(sv + 256 + n4), cv = *(const LAS f32x4*)(sv + 384 + n4);
        float part[4][4]; bf16_t zr[4][4];
#pragma unroll
        for (int hl = 0; hl < 4; ++hl)
#pragma unroll
            for (int ps = 0; ps < 4; ++ps) zr[hl][ps] = prow[PC_Z + (4 * g + hl) * 64 + ps * 16 + pr];
#pragma unroll
        for (int hl = 0; hl < 4; ++hl) {
            const int h = 4 * g + hl;
            const float dt = sdt[hl], eda = sdt[4 + hl];
            float* S1 = p.out + O_SS + ((size_t)(l * NS + s) * 8 + h) * 8192;
#pragma unroll
            for (int ps = 0; ps < 4; ++ps) {
                const int pp = ps * 16 + pr;
                const float xp = sv[hl * 64 + pp];
                const f32x4 sn = ssd0[hl][ps] * eda + bv * (dt * xp);
                __builtin_nontemporal_store(sn, (f32x4*)(S1 + pp * 128 + n4));
                part[hl][ps] = cv[0] * sn[0] + cv[1] * sn[1] + cv[2] * sn[2] + cv[3] * sn[3];
            }
        }
#pragma unroll
        for (int o = 16; o >= 1; o >>= 1)
#pragma unroll
            for (int hl = 0; hl < 4; ++hl)
#pragma unroll
                for (int ps = 0; ps < 4; ++ps) part[hl][ps] += shfl_xor_(part[hl][ps], o, lane);
        if ((tid & 31) == 0) {
#pragma unroll
            for (int hl = 0; hl < 4; ++hl)
#pragma unroll
                for (int ps = 0; ps < 4; ++ps) { const int pp = ps * 16 + pr; const float y = part[hl][ps] + p.in[22][l * 8 + 4 * g + hl] * sv[hl * 64 + pp]; gy[hl * 64 + pp] = y * siluf_(bf2f(zr[hl][ps])); }
        }
    }
    __syncthreads();
    {
        const f32x4 v = *(const LAS f32x4*)(gy + lane * 4);
        const float ssq = wave_sum(v[0] * v[0] + v[1] * v[1] + v[2] * v[2] + v[3] * v[3], lane);
        const float rstd = rsqrtf(ssq * (1.f / 256.f) + EPS);
        if (tid < 256) mix[t * DMIX + 1024 + g * 256 + tid] = f2bf(gy[tid] * rstd * p.in[23][l * 512 + g * 256 + tid]);
    }
    if (tid < 128) {
        const int hh = tid >> 6, w = (tid >> 5) & 1, d = tid & 31, h = 2 * g + hh;
        const int col = (w ? PC_K : PC_Q) + h * 64;
        const float x1 = bf2f(prow[col + d]), x2 = bf2f(prow[col + 32 + d]);
        const float* rc = (const float*)(p.ws + W_ROPE); const float* rs = rc + 2049 * 32;
        const float cs = rc[2048 * 32 + d], sn = rs[2048 * 32 + d], sc = w ? 0.125f : 1.f;
        sq[w * 128 + hh * 64 + d] = (x1 * cs - x2 * sn) * sc; sq[w * 128 + hh * 64 + 32 + d] = (x1 * sn + x2 * cs) * sc;
    }
    __syncthreads();
#pragma unroll
    for (int hh = 0; hh < 2; ++hh) {
        const int h = 2 * g + hh;
        const float gh = 1.f - exp2f(-5.f - (float)h);
        const int v4 = (tid & 31) * 4, kr = tid >> 5;
        float vv[4]; unpack4(*(const u32x2*)(prow + PC_V + h * 128 + v4), vv);
        const float* S0 = p.in[4] + ((size_t)(l * NS + s) * 4 + h) * 8192; float* S1 = p.out + O_RS + ((size_t)(l * NS + s) * 4 + h) * 8192;
        f32x4 part = {0.f, 0.f, 0.f, 0.f};
#pragma unroll
        for (int ps = 0; ps < 4; ++ps) {
            const int k = ps * 16 + kr;
            const float kk = sq[128 + hh * 64 + k], qq = sq[hh * 64 + k];
            const f32x4 s0 = ret0[hh][ps];
            f32x4 sn; sn[0] = gh * s0[0] + kk * vv[0]; sn[1] = gh * s0[1] + kk * vv[1]; sn[2] = gh * s0[2] + kk * vv[2]; sn[3] = gh * s0[3] + kk * vv[3];
            __builtin_nontemporal_store(sn, (f32x4*)(S1 + k * 128 + v4));
            part = part + sn * qq;
        }
#pragma unroll
        for (int i = 0; i < 4; ++i) part[i] += shfl_xor_(part[i], 32, lane);
        if (lane < 32) *(LAS f32x4*)(ro + wid * 128 + v4) = part;
        __syncthreads();
        if (tid < 128) {
            float o = 0.f;
#pragma unroll
            for (int w = 0; w < 8; ++w) o += ro[w * 128 + tid];
            float ssq = wave_sum(o * o, lane);
            ro[1024 + tid] = o; if (lane == 0) ro[1152 + wid] = ssq;
        }
        __syncthreads();
        if (tid < 128) {
            const float rstd = rsqrtf((ro[1152] + ro[1153]) * (1.f / 128.f) + EPS);
            const float o = ro[1024 + tid];
            mix[t * DMIX + 512 + h * 128 + tid] = f2bf(siluf_(bf2f(prow[PC_RG + h * 128 + tid])) * (o * rstd * p.in[17][l * 512 + h * 128 + tid]));
        }
        __syncthreads();
    }
    if (tid < 256) {
        const int ch = 256 * g + tid;
        const float* cw = p.in[10] + (size_t)l * 4 * 512; const float* st = p.in[2] + (size_t)(l * NS + s) * 3 * 512;
        const float cur = bf2f(prow[PC_LX + ch]);
        const float s0 = st[ch], s1 = st[512 + ch], s2 = st[1024 + ch];
        sxc[tid] = p.in[11][l * 512 + ch] + cw[ch] * s0 + cw[512 + ch] * s1 + cw[1024 + ch] * s2 + cw[1536 + ch] * cur;
        float* so = p.out + O_LCS + (size_t)(l * NS + s) * 3 * 512;
        so[ch] = s1; so[512 + ch] = s2; so[1024 + ch] = cur;
    }
    __syncthreads();
    if (tid < 256) {
        const int j = tid & 63, hl = tid >> 6, h = 4 * g + hl, ch = h * 64 + j;
        const float* wr = p.in[12] + (size_t)(l * 8 + h) * 4096; const float* wi = p.in[14] + (size_t)(l * 8 + h) * 4096;
        float r = 0.f, ig = 0.f;
        for (int i = 0; i < 64; ++i) { const float xv = sxc[hl * 64 + i]; r += xv * wr[i * 64 + j]; ig += xv * wi[i * 64 + j]; }
        r = sigmoidf_(r + p.in[13][l * 512 + ch]); ig = sigmoidf_(ig + p.in[15][l * 512 + ch]);
        const float sp = log1pf(fexp_(-p.in[16][l * 512 + ch]));
        const float la = -8.f * r * sp, a = fexp_(la);
        const float hn = a * p.in[3][(size_t)(l * NS + s) * 512 + ch] + __builtin_amdgcn_sqrtf(fmaxf(-expm1f(2.f * la), 0.f)) * ig * sxc[tid];
        p.out[O_LHS + (size_t)(l * NS + s) * 512 + ch] = hn;
        mix[t * DMIX + ch] = f2bf(hn * geluf_(bf2f(prow[PC_LG + ch])));
    }
    __syncthreads();
}

#ifndef ITMASK
#define ITMASK 0xFF
#endif
#define IT_EN(x) (((ITMASK) >> (x)) & 1)
#ifndef REP_ITEM
#define REP_ITEM 0
#endif
__device__ void phase_m1(const Params& p, LAS unsigned char* lds, int l) {
    for (int rr = 0; rr < 1 + ((REP_ITEM >> 0) & 1); ++rr) { if (IT_EN(0)) for (int it = blockIdx.x; it < 256; it += gridDim.x) ret_m1(p, lds, it >> 5, it & 31); }
    for (int rr = 0; rr < 1 + ((REP_ITEM >> 1) & 1); ++rr) { if (IT_EN(1)) for (int it = blockIdx.x; it < 256; it += gridDim.x) ssd_m1(p, lds, l, it >> 5, it & 31); }
    for (int rr = 0; rr < 1 + ((REP_ITEM >> 2) & 1); ++rr) { if (IT_EN(2)) for (int it = blockIdx.x; it < 256; it += gridDim.x) lru_item<1>(p, lds, l, it >> 5, it & 31); }
    for (int rr = 0; rr < 1 + ((REP_ITEM >> 3) & 1); ++rr) { if (IT_EN(3)) for (int it = blockIdx.x; it < 256; it += gridDim.x) sample_item(p, lds, l, it >> 1, it & 1); }
    const bf16_t* proj = (const bf16_t*)(p.ws + W_PROJ);
    const int gt = blockIdx.x * 512 + TIDX, gn = gridDim.x * 512;
    for (int u = gt; u < NB * 3 * 1536; u += gn) {
        const int b = u / (3 * 1536), r = u % (3 * 1536), k = r / 1536, cc = r % 1536;
        const size_t row = (size_t)b * SEQ + SEQ - 3 + k;
        if (cc < 512) p.out[O_LCP + ((size_t)(l * NB + b) * 3 + k) * 512 + cc] = bf2f(proj[row * NPROJ + PC_LX + cc]);
        else p.out[O_SCP + ((size_t)(l * NB + b) * 3 + k) * 1024 + cc - 512] = bf2f(proj[row * NPROJ + PC_XBC + cc - 512]);
    }
}
__device__ void phase_m2(const Params& p, LAS unsigned char* lds, int l) {
    for (int rr = 0; rr < 1 + ((REP_ITEM >> 4) & 1); ++rr) { if (IT_EN(4)) for (int it = blockIdx.x; it < 512; it += gridDim.x) ret_m2(p, lds, l, it >> 6, (it >> 1) & 31, it & 1); }
    for (int rr = 0; rr < 1 + ((REP_ITEM >> 5) & 1); ++rr) { if (IT_EN(5)) for (int it = blockIdx.x; it < 512; it += gridDim.x) ssd_m2(p, lds, l, it >> 6, (it >> 1) & 31, it & 1); }
    for (int rr = 0; rr < 1 + ((REP_ITEM >> 6) & 1); ++rr) { if (IT_EN(6)) for (int it = blockIdx.x; it < 256; it += gridDim.x) lru_item<2>(p, lds, l, it >> 5, it & 31); }
}


#define XB_TMO      128
#define XB_XCNT(j)  (256  + 64 * (j))
#define XB_XSUB(j)  (1280 + 64 * (j))
#define XB_XGEN(j)  (2304 + 64 * (j))
#define XB_TOP      3328
#define XB_TOPGEN   3392
#define XCD_BAR_WORDS 3456
#define XB_SPIN_CAP (1u << 22)
__device__ __forceinline__ unsigned xb_ld(unsigned* p)              { return __hip_atomic_load(p, __ATOMIC_RELAXED, __HIP_MEMORY_SCOPE_AGENT); }
__device__ __forceinline__ unsigned xb_add(unsigned* p, unsigned v) { return __hip_atomic_fetch_add(p, v, __ATOMIC_RELAXED, __HIP_MEMORY_SCOPE_AGENT); }
__device__ __forceinline__ unsigned xb_xcc_id() { return (unsigned)__builtin_amdgcn_s_getreg((3 << 11) | 20) & 0xFu; }
#define XB_SPIN(cond, bar) do { unsigned _sp = 0; while (cond) { __builtin_amdgcn_s_sleep(1); \
    if ((++_sp & 255u) == 0u) { if (xb_ld(&(bar)[XB_TMO])) break; if (_sp > XB_SPIN_CAP) { atomicAdd(&(bar)[XB_TMO], 1u); break; } } } } while (0)
struct XcdBarrier { unsigned* bar; unsigned x; volatile LAS unsigned* st; };
__device__ __forceinline__ XcdBarrier xcd_barrier_post(unsigned* bar, volatile LAS unsigned* st) {
    XcdBarrier b; b.bar = bar; b.x = xb_xcc_id(); b.st = st;
    if (threadIdx.x == 0) (void)xb_add(&bar[XB_XCNT(b.x)], 1u);
    return b;
}
__device__ __forceinline__ void xcd_barrier_complete(unsigned* bar, unsigned x, unsigned& nloc, unsigned& nx) {
    const unsigned G = gridDim.x * gridDim.y * gridDim.z;
    unsigned sum, cnt, mine, sp = 0u;
    for (;;) {
        sum = 0u; cnt = 0u; mine = 0u;
#pragma unroll
        for (unsigned j = 0; j < 16; ++j) { const unsigned c = xb_ld(&bar[XB_XCNT(j)]); sum += c; cnt += (c > 0u) ? 1u : 0u; mine = (j == x) ? c : mine; }
        if (sum == G) break;
        __builtin_amdgcn_s_sleep(1);
        if ((++sp & 255u) == 0u) { if (xb_ld(&bar[XB_TMO])) break; if (sp > XB_SPIN_CAP) { atomicAdd(&bar[XB_TMO], 1u); break; } }
    }
    nloc = mine > 0u ? mine : 1u; nx = cnt > 0u ? cnt : 1u;
}
__device__ __forceinline__ void xcd_barrier(const XcdBarrier& b) {
    asm volatile("s_waitcnt vmcnt(0)" ::: "memory");
    __syncthreads();
    if (threadIdx.x == 0) {
        unsigned* bar = b.bar;
        __builtin_amdgcn_s_waitcnt(0);
        unsigned nloc = b.st[0], nx = b.st[1];
        if (nloc == 0u) { xcd_barrier_complete(bar, b.x, nloc, nx); b.st[0] = nloc; b.st[1] = nx; }
        const unsigned old = xb_add(&bar[XB_XSUB(b.x)], 1u);
        const unsigned gen = old / nloc;
        if (old + 1u == (gen + 1u) * nloc) {
            __builtin_amdgcn_fence(__ATOMIC_RELEASE, "agent");
            asm volatile("s_waitcnt vmcnt(0)" ::: "memory");
            const unsigned og = xb_add(&bar[XB_TOP], 1u);
            const unsigned tg = og / nx;
            if (og + 1u == (tg + 1u) * nx) xb_add(&bar[XB_TOPGEN], 1u);
            else XB_SPIN(xb_ld(&bar[XB_TOPGEN]) == tg, bar);
            __builtin_amdgcn_fence(__ATOMIC_ACQUIRE, "agent");
            xb_add(&bar[XB_XGEN(b.x)], 1u);
            asm volatile("s_waitcnt vmcnt(0)" ::: "memory");
        } else {
            XB_SPIN(xb_ld(&bar[XB_XGEN(b.x)]) == gen, bar);
            __builtin_amdgcn_fence(__ATOMIC_ACQUIRE, "agent");
            asm volatile("s_waitcnt vmcnt(0)" ::: "memory");
        }
    }
    __syncthreads();
}

constexpr int NPHASE = 2 + 7 * DEPTH;
#ifndef PHMASK
#define PHMASK 0xFFF
#endif
#define PH_EN(x) (((PHMASK) >> (x)) & 1)
__device__ __forceinline__ void run_phase(const Params& p, LAS unsigned char* lds, int ph) {
    if (ph == 0) { if (PH_EN(10)) phase_prep(p, lds); return; }
    if (ph == NPHASE - 1) { if (PH_EN(11)) phase_final(p); return; }
    const int l = (ph - 1) / 7, s = (ph - 1) % 7;
    bf16_t* mix = (bf16_t*)(p.ws + W_HB); bf16_t* xb = (bf16_t*)(p.ws + W_XB); bf16_t* big = (bf16_t*)(p.ws + W_PROJ); bf16_t* act = (bf16_t*)(p.ws + W_DS);
    u64* rss = (u64*)(p.ws + W_RSS);
    pg8::StaticOrder S;
    switch (s) {
    case 0: if (PH_EN(1)) {
        const bf16_t* W = (const bf16_t*)(p.ws + W_WIN) + (size_t)l * NPROJ * DM;
        const u64* r = rss + (size_t)(2 * l) * TT;
        S.init(TP, NPROJ, gridDim.x, blockIdx.x);
        pg8::gemm_phase(lds, pg8::Gemm{xb, W, TP, NPROJ, DM}, S, pg8::EpiBf16{big, NPROJ, r});
        phase_dt(p, l);
        thin_gemm<DM, 0>(lds, xb + (size_t)TP * DM, W, NPROJ, big + (size_t)TP * NPROJ, NPROJ, nullptr, (u64*)r + TP);
    } break;
    case 1: if (PH_EN(2)) phase_m1(p, lds, l); break;
    case 2: if (PH_EN(3)) phase_m15(p, l); break;
    case 3: if (PH_EN(4)) phase_m2(p, lds, l); break;
    case 4: if (PH_EN(5)) {
        const bf16_t* W = (const bf16_t*)(p.ws + W_WOUT) + (size_t)l * DM * DMIX;
        u64* r = rss + (size_t)(2 * l + 1) * TT;
        S.init(TP, DM, gridDim.x, blockIdx.x);
        pg8::gemm_phase(lds, pg8::Gemm{mix, W, TP, DM, DMIX}, S, pg8::EpiResid{DM, xb, r});
        thin_gemm<DMIX, 1>(lds, mix + (size_t)TP * DMIX, W, DM, nullptr, DM, xb + (size_t)TP * DM, r + TP);
    } break;
    case 5: if (PH_EN(7)) {
        const bf16_t* W = (const bf16_t*)(p.ws + W_WUP) + (size_t)l * DGU * DM;
        const u64* r = rss + (size_t)(2 * l + 1) * TT;
        const float* cw = p.in[27] + (size_t)l * 3 * DFF; const float* cb = p.in[28] + (size_t)l * DFF;
        S.init(TP, DGU, gridDim.x, blockIdx.x);
        pg8::gemm_phase(lds, pg8::Gemm{xb, W, TP, DGU, DM}, S, pg8::EpiAct{act, r, cw, cb, (bf16_t*)(p.ws + W_GS01), (bf16_t*)(p.ws + W_US01), (bf16_t*)(p.ws + W_GS23), p.out + O_FCP + (size_t)l * NB * 2 * DFF});
        thin_gemm_act(lds, xb + (size_t)TP * DM, W, r + TP, cw, cb, p.in[7] + (size_t)l * NS * 2 * DFF, p.out + O_FCS + (size_t)l * NS * 2 * DFF, act + (size_t)TP * DFF);
    } break;
    case 6: if (PH_EN(9)) {
        const bf16_t* W = (const bf16_t*)(p.ws + W_WDOWN) + (size_t)l * DM * DFF;
        u64* r = rss + (size_t)(2 * l + 2) * TT;
        S.init(TP, DM, gridDim.x, blockIdx.x);
        { pg8::Unit uu; for (int i = 0; S.next(i, uu); ++i) act_fixup(p, l, uu.pm); __threadfence(); __syncthreads(); }
        pg8::gemm_phase(lds, pg8::Gemm{act, W, TP, DM, DFF}, S, pg8::EpiResid{DM, xb, r});
        thin_gemm<DFF, 1>(lds, act + (size_t)TP * DFF, W, DM, nullptr, DM, xb + (size_t)TP * DM, r + TP);
    } break;
    }
}

__global__ void __launch_bounds__(512, 2) mega(Params p, int ph0, int ph1, int coop) {
    extern __shared__ __attribute__((aligned(16))) unsigned char shm[];
    LAS unsigned char* lds = (LAS unsigned char*)shm;
    cg::grid_group grid = cg::this_grid();
    volatile LAS unsigned* st = (volatile LAS unsigned*)(lds + LDS_BYTES);
    if (threadIdx.x < 4) st[threadIdx.x] = 0u;
    __syncthreads();
    XcdBarrier xb = xcd_barrier_post((unsigned*)(p.ws + W_BAR), st);
    for (int ph = ph0; ph < ph1; ++ph) {
        int reps = 1;
#ifdef REP_MASK
        { const int s = (ph == 0) ? 10 : (ph == NPHASE - 1 ? 11 : (ph - 1) % 7); if ((REP_MASK >> s) & 1) reps = 2; }
#endif
        for (int r = 0; r < reps; ++r) { run_phase(p, lds, ph); if (reps > 1) __syncthreads(); }
        if (coop && ph + 1 < ph1) {
            if (coop == 2) grid.sync();
            xcd_barrier(xb);
#ifdef REP_SYNC
            xcd_barrier(xb);
#endif
        }
    }
}

extern "C" void kernel_launch(void* const* d_in, const int* in_sizes, int n_in, void* d_out, int out_size, void* d_ws, size_t ws_size, hipStream_t stream) {
    static int grid_blocks = 0;
    if (!grid_blocks) {
        int dev = 0, cus = 0, per_cu = 0;
        hipGetDevice(&dev);
        hipDeviceGetAttribute(&cus, hipDeviceAttributeMultiprocessorCount, dev);
        hipFuncSetAttribute((const void*)mega, hipFuncAttributeMaxDynamicSharedMemorySize, LDS_BYTES + 16);
        hipOccupancyMaxActiveBlocksPerMultiprocessor(&per_cu, (const void*)mega, 512, LDS_BYTES + 16);
        if (per_cu < 1) per_cu = 1;
        grid_blocks = cus * per_cu;
        if (grid_blocks > 256) grid_blocks = 256;
        if (ws_size < W_END) fprintf(stderr, "kernel_launch: workspace too small: %zu < %zu\n", ws_size, (size_t)W_END);
    }
    Params p{};
    for (int i = 0; i < 31; ++i) p.in[i] = (const float*)d_in[i];
    p.out = (float*)d_out; p.ws = (unsigned char*)d_ws;
    hipMemsetAsync((unsigned char*)d_ws + W_BAR, 0, XCD_BAR_WORDS * 4, stream);
    int ph0 = 0, ph1 = NPHASE, coop = 1;
    void* args[] = {&p, &ph0, &ph1, &coop};
    hipError_t e = hipLaunchCooperativeKernel((const void*)mega, dim3(grid_blocks), dim3(512), args, LDS_BYTES + 16, stream);
    if (e != hipSuccess) fprintf(stderr, "cooperative launch failed: %s (grid %d)\n", hipGetErrorString(e), grid_blocks);
}
```

```cpp
#include <hip/hip_runtime.h>
#include <hip/hip_cooperative_groups.h>
#include <cstdio>
namespace cg = cooperative_groups;

#define LAS __attribute__((address_space(3)))
typedef unsigned short bf16_t;
typedef short bf16x8 __attribute__((ext_vector_type(8)));
typedef short s16x4 __attribute__((ext_vector_type(4)));
typedef float f32x4 __attribute__((ext_vector_type(4)));
typedef float f32x2 __attribute__((ext_vector_type(2)));
typedef unsigned u32x4 __attribute__((ext_vector_type(4)));
typedef unsigned u32x2 __attribute__((ext_vector_type(2)));

constexpr int DM = 1024, NB = 8, SEQ = 2048, DEPTH = 4, NS = 128;
constexpr int TP = NB * SEQ;
constexpr int TT = TP + NS;
constexpr int DLRU = 512, DIN = 4104, NPROJ = 4096, DMIX = 1536, DFF = 2816, DGU = 5632;
constexpr int NCH = 32;
constexpr float EPS = 1e-6f;
constexpr int PC_LX = 0, PC_LG = 512, PC_Q = 1024, PC_K = 1280, PC_V = 1536, PC_RG = 2048, PC_Z = 2560, PC_XBC = 3072;

constexpr size_t O_Y = 0;
constexpr size_t O_LCP = (size_t)TT * DM;
constexpr size_t O_LCS = O_LCP + (size_t)DEPTH * NB * 3 * 512;
constexpr size_t O_LHP = O_LCS + (size_t)DEPTH * NS * 3 * 512;
constexpr size_t O_LHS = O_LHP + (size_t)DEPTH * NB * 512;
constexpr size_t O_RP = O_LHS + (size_t)DEPTH * NS * 512;
constexpr size_t O_RS = O_RP + (size_t)DEPTH * NB * 4 * 64 * 128;
constexpr size_t O_SCP = O_RS + (size_t)DEPTH * NS * 4 * 64 * 128;
constexpr size_t O_SCS = O_SCP + (size_t)DEPTH * NB * 3 * 1024;
constexpr size_t O_SP = O_SCS + (size_t)DEPTH * NS * 3 * 1024;
constexpr size_t O_SS = O_SP + (size_t)DEPTH * NB * 8 * 64 * 128;
constexpr size_t O_FCP = O_SS + (size_t)DEPTH * NS * 8 * 64 * 128;
constexpr size_t O_FCS = O_FCP + (size_t)DEPTH * NB * 2 * DFF;

constexpr size_t W_WIN = 0;
constexpr size_t W_WOUT = W_WIN + (size_t)DEPTH * NPROJ * DM * 2;
constexpr size_t W_WUP = W_WOUT + (size_t)DEPTH * DM * DMIX * 2;
constexpr size_t W_WDOWN = W_WUP + (size_t)DEPTH * DGU * DM * 2;
constexpr size_t W_LRUW = W_WDOWN + (size_t)DEPTH * DM * DFF * 2;
constexpr size_t W_ROPE = W_LRUW + (size_t)2 * DEPTH * 8 * 64 * 64 * 2;
constexpr size_t W_DT = W_ROPE + 524800;
constexpr size_t W_LRUAB = W_DT + (size_t)TT * 8 * 4;
constexpr size_t W_LRUHIN = W_LRUAB + (size_t)NB * NCH * 512 * 2 * 4;
constexpr size_t W_DEC = W_LRUHIN + (size_t)NB * NCH * 512 * 4;
constexpr size_t W_RSS = W_DEC + 8192;
constexpr size_t W_WDT = W_RSS + (size_t)9 * TT * 8;
constexpr size_t W_HB = W_WDT + (size_t)DEPTH * 16 * DM * 2;
constexpr size_t W_XB = W_HB + (size_t)TT * DMIX * 2;
constexpr size_t W_PROJ = W_XB + (size_t)TT * DM * 2;
constexpr size_t W_SPR = W_PROJ + (size_t)TT * NPROJ * 2;
constexpr size_t W_SPS = W_SPR + (size_t)NB * 4 * NCH * 8192 * 2;
static_assert(W_SPS + (size_t)NB * 8 * NCH * 8192 * 2 <= W_PROJ + (size_t)TT * DGU * 2, "Sp does not fit behind proj");
constexpr size_t W_DS = W_PROJ + (size_t)TT * DGU * 2;
constexpr size_t W_DSSSD = W_DS + (size_t)NB * 4 * NCH * 8192 * 4;
constexpr size_t W_BAR = W_DSSSD + (size_t)NB * 8 * NCH * 8192 * 4;
constexpr size_t W_GS01 = W_BAR + 16384;
constexpr size_t W_US01 = W_GS01 + (size_t)256 * 2 * DFF * 2;
constexpr size_t W_GS23 = W_US01 + (size_t)256 * 2 * DFF * 2;
constexpr size_t W_END = W_GS23 + (size_t)256 * 2 * DFF * 2;
static_assert(W_END <= (size_t)512 * 1024 * 1024, "workspace budget");
constexpr int LDS_BYTES = 131072;

struct Params { const float* in[31]; float* out; unsigned char* ws; };

typedef unsigned long long u64;
__device__ __forceinline__ u64 ss_fix(float ss) { return (u64)(ss * 1048576.f + 0.5f); }
__device__ __forceinline__ float rstd_fix(u64 v) { return rsqrtf((float)v * (1.f / (1048576.f * 1024.f)) + 1e-6f); }
__device__ __forceinline__ int opaque_tid() { int t = threadIdx.x; asm volatile("" : "+v"(t)); return t; }
#define TIDX opaque_tid()
__device__ __forceinline__ float bf2f(bf16_t v) { return __uint_as_float(((unsigned)v) << 16); }
__device__ __forceinline__ unsigned pk2(float lo, float hi) { unsigned r; asm volatile("v_cvt_pk_bf16_f32 %0, %1, %2" : "=v"(r) : "v"(lo), "v"(hi)); return r; }
__device__ __forceinline__ bf16_t f2bf(float f) { return (bf16_t)(pk2(f, 0.f) & 0xffffu); }
__device__ __forceinline__ void unpack8(u32x4 w, float* f) {
    f[0] = __uint_as_float(w.x << 16); f[1] = __uint_as_float(w.x & 0xffff0000u);
    f[2] = __uint_as_float(w.y << 16); f[3] = __uint_as_float(w.y & 0xffff0000u);
    f[4] = __uint_as_float(w.z << 16); f[5] = __uint_as_float(w.z & 0xffff0000u);
    f[6] = __uint_as_float(w.w << 16); f[7] = __uint_as_float(w.w & 0xffff0000u);
}
__device__ __forceinline__ void unpack4(u32x2 w, float* f) {
    f[0] = __uint_as_float(w.x << 16); f[1] = __uint_as_float(w.x & 0xffff0000u);
    f[2] = __uint_as_float(w.y << 16); f[3] = __uint_as_float(w.y & 0xffff0000u);
}
__device__ __forceinline__ u32x4 pack8(const float* f) { u32x4 w; w.x = pk2(f[0], f[1]); w.y = pk2(f[2], f[3]); w.z = pk2(f[4], f[5]); w.w = pk2(f[6], f[7]); return w; }
__device__ __forceinline__ float fexp_(float x) { return __builtin_amdgcn_exp2f(x * 1.44269504089f); }
__device__ __forceinline__ float sigmoidf_(float x) { return __builtin_amdgcn_rcpf(1.f + fexp_(-x)); }
__device__ __forceinline__ float siluf_(float x) { return x * __builtin_amdgcn_rcpf(1.f + fexp_(-x)); }
__device__ __forceinline__ float geluf_(float x) { const float z = x * __builtin_fmaf(x * x, 0.1029432397f, 2.302208198f); const float r = __builtin_amdgcn_rcpf(1.f + __builtin_amdgcn_exp2f(z)); return __builtin_fmaf(-x, r, x); }
__device__ __forceinline__ float softplusf_(float x) { return x > 20.f ? x : log1pf(fexp_(x)); }
__device__ __forceinline__ float shfl_idx(float v, int src) { return __int_as_float(__builtin_amdgcn_ds_bpermute(src << 2, __float_as_int(v))); }
__device__ __forceinline__ float shfl_xor_(float v, int o, int lane) { return shfl_idx(v, lane ^ o); }
__device__ __forceinline__ float shfl_up_(float v, int o, int lane) { return shfl_idx(v, (lane - o) & 63); }
__device__ __forceinline__ float wave_sum(float v, int lane) {
#pragma unroll
    for (int o = 32; o >= 1; o >>= 1) v += shfl_xor_(v, o, lane);
    return v;
}
template <int N> __device__ __forceinline__ float dpp_shr(float old, float src) { return __int_as_float(__builtin_amdgcn_update_dpp(__float_as_int(old), __float_as_int(src), 0x110 + N, 0xf, 0xf, false)); }
template <int N> __device__ __forceinline__ float dpp_ror(float src) { return __int_as_float(__builtin_amdgcn_update_dpp(0, __float_as_int(src), 0x120 + N, 0xf, 0xf, false)); }
__device__ __forceinline__ bf16x8 frag_row(const LAS bf16_t* t, int ld, int r0, int k0, int fr, int fq) {
    return *(const LAS bf16x8*)(t + (r0 + fr) * ld + k0 + 8 * fq);
}
__device__ __forceinline__ bf16x8 frag_tr(const LAS bf16_t* t, int ld, int k0, int c0, int fr, int fq) {
    const LAS bf16_t* p = t + (k0 + 8 * fq + (fr >> 2)) * ld + c0 + 4 * (fr & 3);
    s16x4 lo = __builtin_bit_cast(s16x4, __builtin_amdgcn_ds_read_tr16_b64_v4i16((LAS s16x4*)p));
    s16x4 hi = __builtin_bit_cast(s16x4, __builtin_amdgcn_ds_read_tr16_b64_v4i16((LAS s16x4*)(p + 4 * ld)));
    bf16x8 r; r[0] = lo[0]; r[1] = lo[1]; r[2] = lo[2]; r[3] = lo[3]; r[4] = hi[0]; r[5] = hi[1]; r[6] = hi[2]; r[7] = hi[3]; return r;
}
#define MFMA(X, Y, C) __builtin_amdgcn_mfma_f32_16x16x32_bf16((X), (Y), (C), 0, 0, 0)

namespace pg8 {
constexpr int BM = 256, BK = 64, HALF = 128, HTB = HALF * BK * 2, NXCD = 8, WGM = 8;
__device__ __forceinline__ int lds_byte(int r, int c) { const int st = (r >> 4) * 2 + (c >> 5), rr = r & 15, cc = c & 31, ob = rr * 64 + cc * 2; return st * 1024 + (ob ^ (((ob >> 9) & 1) << 5)); }
__device__ __forceinline__ void stage_rc(int b, int& R, int& C) { const int st = b / 1024, sb = b % 1024, swz = sb ^ (((sb >> 9) & 1) << 5); R = (st >> 1) * 16 + swz / 64; C = (st & 1) * 32 + (swz % 64) / 2; }
__device__ __forceinline__ int perm32(int rho) { const int n = rho >> 4, i = rho & 15; return 8 * (i >> 2) + 4 * n + (i & 3); }
struct Unit { int pm, pn; };
struct Gemm { const bf16_t* A; const bf16_t* Bt; int M, N, K; };
struct StaticOrder {
    int nM, nN, nwg, G, c;
    __device__ void init(int M, int N, int G_, int c_) { nM = M / BM; nN = N / BM; nwg = nM * nN; G = G_; c = c_; }
    __device__ bool next(int i, Unit& u) const {
        const long L = (long)i * G + c; if (L >= nwg) return false;
        int wgid = (int)L; { const int q = nwg / NXCD, r = nwg % NXCD, xcd = wgid % NXCD, off = wgid / NXCD; wgid = (xcd < r ? xcd * (q + 1) : r * (q + 1) + (xcd - r) * q) + off; }
        const int nig = WGM * nN, gid = wgid / nig, fm = gid * WGM, gsz = (nM - fm) < WGM ? (nM - fm) : WGM;
        u.pm = fm + ((wgid % nig) % gsz); u.pn = (wgid % nig) / gsz; return true;
    }
};
template <class Epi>
__device__ __forceinline__ void gemm_phase(LAS unsigned char* lds, const Gemm g, const StaticOrder& S, const Epi& E) {
    const int tid = TIDX, wid = __builtin_amdgcn_readfirstlane(tid >> 6), lane = tid & 63, wr = wid >> 2, wc = wid & 3, fr = lane & 15, fq = lane >> 4;
    const int K = g.K, nt = K / BK;
    unsigned voffA[2], voffB[2];
#pragma unroll
    for (int i = 0; i < 2; ++i) { int R, C; stage_rc(tid * 16 + i * 8192, R, C); const int Rb = Epi::PERM ? ((R & ~31) + perm32(R & 31)) : R;
        voffA[i] = (unsigned)(R * K + C) * 2u; voffB[i] = (unsigned)(Rb * K + C) * 2u; }
    const size_t kstep = (size_t)(BK * 2);
    const size_t hstep = (size_t)HALF * K * 2;
    const size_t tstep = 2 * hstep;
    const unsigned ldsw = (unsigned)wid * 1024u;
    const int aoff = lds_byte(wr * 64 + fr, fq * 8), boff = lds_byte(wc * 32 + fr, fq * 8);
#define PG8_SA(b, h) (((b) * 2 + (h)) * HTB)
#define PG8_SB(b, h) ((4 + (b) * 2 + (h)) * HTB)
#define PG8_STAGE(bufoff, gbase, voff) do { _Pragma("unroll") for (int _i = 0; _i < 2; ++_i) \
        __builtin_amdgcn_global_load_lds((const unsigned*)((const char*)(gbase) + (voff)[_i]), (LAS unsigned*)(lds + (bufoff) + ldsw + _i * 8192), 16, 0, 0); } while (0)
#define PG8_LDA(dst, b, h) do { _Pragma("unroll") for (int m = 0; m < 4; ++m) _Pragma("unroll") for (int k = 0; k < 2; ++k) dst[m][k] = *(const LAS bf16x8*)(lds + PG8_SA(b, h) + aoff + m * 2048 + k * 1024); } while (0)
#define PG8_LDB(dst, b, h) do { _Pragma("unroll") for (int n = 0; n < 2; ++n) _Pragma("unroll") for (int k = 0; k < 2; ++k) dst[n][k] = *(const LAS bf16x8*)(lds + PG8_SB(b, h) + boff + n * 2048 + k * 1024); } while (0)
#define PG8_MMA(ai, bj, At, Bt) do { __builtin_amdgcn_s_setprio(1); _Pragma("unroll") for (int m = 0; m < 4; ++m) _Pragma("unroll") for (int n = 0; n < 2; ++n) _Pragma("unroll") for (int k = 0; k < 2; ++k) \
        acc[ai][bj][m][n] = __builtin_amdgcn_mfma_f32_16x16x32_bf16(Bt[n][k], At[m][k], acc[ai][bj][m][n], 0, 0, 0); __builtin_amdgcn_s_setprio(0); } while (0)
#define PG8_WAIT_V(n) asm volatile("s_waitcnt vmcnt(" #n ")" ::: "memory")
#define PG8_WAIT_L(n) asm volatile("s_waitcnt lgkmcnt(" #n ")" ::: "memory")
#define PG8_BAR __builtin_amdgcn_s_barrier()
#define PG8_SCHED __builtin_amdgcn_sched_barrier(0)
    Unit cur, nxt; int ui = 0;
    if (!S.next(0, cur)) return;
    f32x4 acc[2][2][4][2];
#pragma unroll
    for (int a = 0; a < 2; ++a)
#pragma unroll
        for (int b = 0; b < 2; ++b)
#pragma unroll
            for (int m = 0; m < 4; ++m)
#pragma unroll
                for (int n = 0; n < 2; ++n) acc[a][b][m][n] = (f32x4){0.f, 0.f, 0.f, 0.f};
    bf16x8 At[4][2], B0[2][2], B1[2][2];
    const char* cA = (const char*)g.A + (size_t)cur.pm * tstep; const char* cB = (const char*)g.Bt + (size_t)cur.pn * tstep;
    PG8_STAGE(PG8_SB(0, 0), cB, voffB); PG8_STAGE(PG8_SA(0, 0), cA, voffA); PG8_STAGE(PG8_SB(0, 1), cB + hstep, voffB); PG8_STAGE(PG8_SA(0, 1), cA + hstep, voffA);
    if (wr == 1) PG8_BAR;
    PG8_WAIT_V(4); PG8_BAR;
    PG8_STAGE(PG8_SB(1, 0), cB + kstep, voffB); PG8_STAGE(PG8_SA(1, 0), cA + kstep, voffA); PG8_STAGE(PG8_SB(1, 1), cB + hstep + kstep, voffB);
    PG8_WAIT_V(6); PG8_BAR;
    for (;;) {
        const bool has_next = S.next(ui + 1, nxt);
        const char* nA = has_next ? (const char*)g.A + (size_t)nxt.pm * tstep : cA; const char* nB = has_next ? (const char*)g.Bt + (size_t)nxt.pn * tstep : cB;
        for (int t = 0; t < nt; t += 2) {
            const bool last = (t == nt - 2);
            const char* a1 = cA + (size_t)(t + 1) * kstep;
            const char* a2 = last ? nA : cA + (size_t)(t + 2) * kstep; const char* b2 = last ? nB : cB + (size_t)(t + 2) * kstep;
            const char* a3 = a2 + kstep; const char* b3 = b2 + kstep;
            PG8_LDB(B0, 0, 0); PG8_SCHED; PG8_LDA(At, 0, 0); PG8_STAGE(PG8_SA(1, 1), a1 + hstep, voffA);
            PG8_WAIT_L(8); PG8_BAR; PG8_WAIT_L(0); PG8_MMA(0, 0, At, B0); PG8_BAR; PG8_SCHED;
            PG8_LDB(B1, 0, 1); PG8_STAGE(PG8_SB(0, 0), b2, voffB);
            PG8_BAR; PG8_WAIT_L(0); PG8_MMA(0, 1, At, B1); PG8_BAR;
            PG8_LDA(At, 0, 1); PG8_STAGE(PG8_SA(0, 0), a2, voffA);
            PG8_BAR; PG8_WAIT_L(0); PG8_MMA(1, 0, At, B0); PG8_BAR; PG8_SCHED;
            PG8_STAGE(PG8_SB(0, 1), b2 + hstep, voffB);
            PG8_WAIT_V(6); PG8_BAR; PG8_MMA(1, 1, At, B1); PG8_BAR;
            PG8_LDB(B0, 1, 0); PG8_SCHED; PG8_LDA(At, 1, 0); PG8_STAGE(PG8_SA(0, 1), a2 + hstep, voffA);
            PG8_WAIT_L(8); PG8_BAR; PG8_WAIT_L(0); PG8_MMA(0, 0, At, B0); PG8_BAR; PG8_SCHED;
            PG8_LDB(B1, 1, 1); PG8_STAGE(PG8_SB(1, 0), b3, voffB);
            PG8_BAR; PG8_WAIT_L(0); PG8_MMA(0, 1, At, B1); PG8_BAR;
            PG8_LDA(At, 1, 1); PG8_STAGE(PG8_SA(1, 0), a3, voffA);
            PG8_BAR; PG8_WAIT_L(0); PG8_MMA(1, 0, At, B0); PG8_BAR; PG8_SCHED;
            PG8_STAGE(PG8_SB(1, 1), b3 + hstep, voffB);
            PG8_WAIT_V(6); PG8_BAR; PG8_MMA(1, 1, At, B1); PG8_BAR;
        }
        if constexpr (Epi::AFTER_DRAIN) { if (has_next) E(acc, cur, wr, wc, fr, fq); } else E(acc, cur, wr, wc, fr, fq);
        if (!has_next) break;
#pragma unroll
        for (int a = 0; a < 2; ++a)
#pragma unroll
            for (int b = 0; b < 2; ++b)
#pragma unroll
                for (int m = 0; m < 4; ++m)
#pragma unroll
                    for (int n = 0; n < 2; ++n) acc[a][b][m][n] = (f32x4){0.f, 0.f, 0.f, 0.f};
        cur = nxt; cA = nA; cB = nB; ++ui;
    }
    PG8_WAIT_V(0);
    if (wr == 0) PG8_BAR;
    PG8_BAR;
    if constexpr (Epi::AFTER_DRAIN) E.fused(acc, cur, wr, wc, fr, fq, lds, wid, lane);
#undef PG8_SA
#undef PG8_SB
#undef PG8_STAGE
#undef PG8_LDA
#undef PG8_LDB
#undef PG8_MMA
#undef PG8_WAIT_V
#undef PG8_WAIT_L
#undef PG8_BAR
#undef PG8_SCHED
}
struct EpiBf16 {
    static constexpr bool PERM = true, AFTER_DRAIN = false;
    bf16_t* O; int ldc; const u64* rss;
    __device__ __forceinline__ void operator()(const f32x4 (&acc)[2][2][4][2], const Unit& u, int wr, int wc, int fr, int fq) const {
        const int row0 = u.pm * BM + wr * 64 + fr, col0 = u.pn * BM + wc * 32 + 8 * fq;
        u64 rv[2][4];
#pragma unroll
        for (int ai = 0; ai < 2; ++ai)
#pragma unroll
            for (int m = 0; m < 4; ++m) rv[ai][m] = rss[row0 + ai * HALF + m * 16];
#pragma unroll
        for (int ai = 0; ai < 2; ++ai)
#pragma unroll
            for (int m = 0; m < 4; ++m) { const int row = row0 + ai * HALF + m * 16; bf16_t* rowp = O + (size_t)row * ldc + col0;
                const float rs = rstd_fix(rv[ai][m]);
#pragma unroll
                for (int bj = 0; bj < 2; ++bj) { const f32x4 v0 = acc[ai][bj][m][0] * rs, v1 = acc[ai][bj][m][1] * rs;
                    u32x4 w; w.x = pk2(v0[0], v0[1]); w.y = pk2(v0[2], v0[3]); w.z = pk2(v1[0], v1[1]); w.w = pk2(v1[2], v1[3]);
                    *(u32x4*)(rowp + bj * HALF) = w; } }
    }
};
struct EpiResid {
    static constexpr bool PERM = false, AFTER_DRAIN = true;
    int ldc; bf16_t* xb; u64* rss;
    __device__ __forceinline__ void operator()(const f32x4 (&acc)[2][2][4][2], const Unit& u, int wr, int wc, int fr, int fq) const {
        const int row0 = u.pm * BM + wr * 64 + fr, col0 = u.pn * BM + wc * 32 + 4 * fq, lane = fr | (fq << 4);
#pragma unroll
        for (int ai = 0; ai < 2; ++ai)
#pragma unroll
            for (int m = 0; m < 4; ++m) { const int row = row0 + ai * HALF + m * 16; bf16_t* xbp = xb + (size_t)row * ldc + col0;
                float ss = 0.f;
#pragma unroll
                for (int bj = 0; bj < 2; ++bj)
#pragma unroll
                    for (int n = 0; n < 2; ++n) { u32x2* pp = (u32x2*)(xbp + bj * HALF + n * 16); float o[4]; unpack4(*pp, o);
                        u32x2 w; w.x = pk2(o[0] + acc[ai][bj][m][n][0], o[1] + acc[ai][bj][m][n][1]); w.y = pk2(o[2] + acc[ai][bj][m][n][2], o[3] + acc[ai][bj][m][n][3]); *pp = w;
                        unpack4(w, o); ss += o[0] * o[0] + o[1] * o[1] + o[2] * o[2] + o[3] * o[3]; }
                ss += shfl_xor_(ss, 16, lane); ss += shfl_xor_(ss, 32, lane);
                if (fq == 0) atomicAdd(rss + row, ss_fix(ss)); }
    }
    __device__ __forceinline__ void fused(const f32x4 (&acc)[2][2][4][2], const Unit& u, int wr, int wc, int fr, int fq, LAS unsigned char* lds, int wid, int lane) const {
        LAS f32x4* t = (LAS f32x4*)lds;
#pragma unroll
        for (int ai = 0; ai < 2; ++ai) {
            const int rbase = u.pm * BM + ai * HALF + wid * 16, col = u.pn * BM + lane * 4;
            u32x2 xv[16];
#pragma unroll
            for (int i = 0; i < 16; ++i) xv[i] = *(const u32x2*)(xb + (size_t)(rbase + i) * ldc + col);
#pragma unroll
            for (int m = 0; m < 4; ++m)
#pragma unroll
                for (int bj = 0; bj < 2; ++bj)
#pragma unroll
                    for (int n = 0; n < 2; ++n) { const int r = 64 * wr + 16 * m + fr, chunk = 32 * bj + 8 * wc + 4 * n + fq; t[r * 64 + (chunk ^ (r & 15))] = acc[ai][bj][m][n]; }
            __syncthreads();
            float myss = 0.f;
#pragma unroll
            for (int i = 0; i < 16; ++i) { const int r = wid * 16 + i;
                const f32x4 a = t[r * 64 + (lane ^ (r & 15))]; float o[4]; unpack4(xv[i], o);
                u32x2 w; w.x = pk2(o[0] + a[0], o[1] + a[1]); w.y = pk2(o[2] + a[2], o[3] + a[3]); *(u32x2*)(xb + (size_t)(rbase + i) * ldc + col) = w;
                unpack4(w, o);
                const float ss = wave_sum(o[0] * o[0] + o[1] * o[1] + o[2] * o[2] + o[3] * o[3], lane);
                if (lane == i) myss = ss; }
            if (lane < 16) atomicAdd(rss + rbase + lane, ss_fix(myss));
            __syncthreads();
        }
    }
};
struct EpiAct {
    static constexpr bool PERM = true, AFTER_DRAIN = false;
    bf16_t* act; const u64* rss; const float* cw; const float* cb; bf16_t* gs01; bf16_t* us01; bf16_t* gs23; float* fcp;
    __device__ __forceinline__ void operator()(const f32x4 (&acc)[2][2][4][2], const Unit& u, int wr, int wc, int fr, int fq) const {
        const int row0 = u.pm * BM + wr * 64 + fr, f0 = u.pn * HALF + wc * 32 + 8 * fq;
        float w0[8], w1[8], w2[8], bb[8];
        *(f32x4*)w0 = *(const f32x4*)(cw + f0); *(f32x4*)(w0 + 4) = *(const f32x4*)(cw + f0 + 4);
        *(f32x4*)w1 = *(const f32x4*)(cw + DFF + f0); *(f32x4*)(w1 + 4) = *(const f32x4*)(cw + DFF + f0 + 4);
        *(f32x4*)w2 = *(const f32x4*)(cw + 2 * DFF + f0); *(f32x4*)(w2 + 4) = *(const f32x4*)(cw + 2 * DFF + f0 + 4);
        *(f32x4*)bb = *(const f32x4*)(cb + f0); *(f32x4*)(bb + 4) = *(const f32x4*)(cb + f0 + 4);
        u64 rv[2][4];
#pragma unroll
        for (int ai = 0; ai < 2; ++ai)
#pragma unroll
            for (int m = 0; m < 4; ++m) rv[ai][m] = rss[row0 + ai * HALF + m * 16];
#pragma unroll
        for (int ai = 0; ai < 2; ++ai) {
            float gp[8];
#pragma unroll
            for (int e = 0; e < 8; ++e) gp[e] = 0.f;
#pragma unroll
            for (int m = 0; m < 4; ++m) {
                const int row = row0 + ai * HALF + m * 16;
                const float rs = rstd_fix(rv[ai][m]);
                float g[8], up[8], o[8];
                { const f32x4 g0 = acc[ai][0][m][0] * rs, g1 = acc[ai][0][m][1] * rs, u0 = acc[ai][1][m][0] * rs, u1 = acc[ai][1][m][1] * rs;
#pragma unroll
                  for (int i = 0; i < 4; ++i) { g[i] = g0[i]; g[4 + i] = g1[i]; up[i] = u0[i]; up[4 + i] = u1[i]; } }
#pragma unroll
                for (int e2 = 0; e2 < 4; ++e2) {
                    const int e = 2 * e2;
                    const f32x2 gv = {g[e], g[e + 1]};
                    const f32x2 g1v = {dpp_shr<1>(dpp_ror<1>(gp[e]), g[e]), dpp_shr<1>(dpp_ror<1>(gp[e + 1]), g[e + 1])};
                    const f32x2 g2v = {dpp_shr<2>(dpp_ror<2>(gp[e]), g[e]), dpp_shr<2>(dpp_ror<2>(gp[e + 1]), g[e + 1])};
                    const f32x2 w0v = {w0[e], w0[e + 1]}, w1v = {w1[e], w1[e + 1]}, w2v = {w2[e], w2[e + 1]}, bbv = {bb[e], bb[e + 1]}, upv = {up[e], up[e + 1]};
                    const f32x2 y = __builtin_elementwise_fma(w0v, g2v, __builtin_elementwise_fma(w1v, g1v, __builtin_elementwise_fma(w2v, gv, bbv)));
                    const f32x2 z = y * __builtin_elementwise_fma(y * y, (f32x2){0.1029432397f, 0.1029432397f}, (f32x2){2.302208198f, 2.302208198f});
                    f32x2 d; d.x = __builtin_amdgcn_exp2f(z.x); d.y = __builtin_amdgcn_exp2f(z.y);
                    d = d + 1.0f;
                    f32x2 r; r.x = __builtin_amdgcn_rcpf(d.x); r.y = __builtin_amdgcn_rcpf(d.y);
                    const f32x2 ov = __builtin_elementwise_fma(-y, r, y) * upv;
                    o[e] = ov.x; o[e + 1] = ov.y;
                }
                if (m == 0 && fr < 2) {
                    const size_t so = ((size_t)(row >> 6) * 2 + fr) * DFF + f0;
                    *(u32x4*)(gs01 + so) = pack8(g); *(u32x4*)(us01 + so) = pack8(up);
                } else *(u32x4*)(act + (size_t)row * DFF + f0) = pack8(o);
                if (m == 3 && fr >= 14) *(u32x4*)(gs23 + ((size_t)(row >> 6) * 2 + (fr - 14)) * DFF + f0) = pack8(g);
                const int ts = row & (SEQ - 1);
                if (ts >= SEQ - 2) { float* fo = fcp + ((size_t)(row >> 11) * 2 + (ts - (SEQ - 2))) * DFF + f0;
                    *(f32x4*)fo = (f32x4){g[0], g[1], g[2], g[3]}; *(f32x4*)(fo + 4) = (f32x4){g[4], g[5], g[6], g[7]}; }
#pragma unroll
                for (int e = 0; e < 8; ++e) gp[e] = g[e];
            }
        }
    }
};
struct EpiDry {
    static constexpr bool PERM = false, AFTER_DRAIN = false;
    float* C;
    __device__ __forceinline__ void operator()(const f32x4 (&acc)[2][2][4][2], const Unit& u, int wr, int wc, int fr, int fq) const {
        float s = 0.f;
#pragma unroll
        for (int ai = 0; ai < 2; ++ai)
#pragma unroll
            for (int bj = 0; bj < 2; ++bj)
#pragma unroll
                for (int m = 0; m < 4; ++m)
#pragma unroll
                    for (int n = 0; n < 2; ++n) s += acc[ai][bj][m][n][0] + acc[ai][bj][m][n][1] + acc[ai][bj][m][n][2] + acc[ai][bj][m][n][3];
        if (s != s) C[0] = s;
    }
};
}

template <int K, int MODE  >
__device__ __forceinline__ void thin_gemm(LAS unsigned char* lds, const bf16_t* A, const bf16_t* Bt, int N, void* out, int ldc, bf16_t* xb, u64* rss) {
    const int tid = TIDX, wid = tid >> 6, lane = tid & 63, fr = lane & 15, fq = lane >> 4;
    constexpr int KW = K / 8, STEPS = KW / 32;
    const int ntask = (N / 16) * 8;
    LAS f32x4* red = (LAS f32x4*)lds;
    const int per = (ntask + (int)gridDim.x - 1) / (int)gridDim.x, t0 = blockIdx.x * per, t1 = min(ntask, t0 + per);
    for (int base = t0; base < t1; base += 8) {
        const int nr = min(8, t1 - base);
#pragma unroll (STEPS <= 4 ? 4 : 2)
        for (int i = 0; i < nr; ++i) {
            const int t = base + i, ct = t >> 3, rt = t & 7;
            const bf16_t* ap = A + (size_t)(rt * 16 + fr) * K + wid * KW + 8 * fq;
            const bf16_t* bp = Bt + (size_t)(ct * 16 + fr) * K + wid * KW + 8 * fq;
            bf16x8 a[STEPS], b[STEPS];
#pragma unroll
            for (int s = 0; s < STEPS; ++s) { a[s] = *(const bf16x8*)(ap + 32 * s); b[s] = *(const bf16x8*)(bp + 32 * s); }
            f32x4 acc = {0.f, 0.f, 0.f, 0.f};
#pragma unroll
            for (int s = 0; s < STEPS; ++s) acc = MFMA(b[s], a[s], acc);
            red[(i * 8 + wid) * 64 + lane] = acc;
        }
        __syncthreads();
        if (wid < nr) {
            const int t = base + wid, ct = t >> 3, rt = t & 7;
            f32x4 s = red[(wid * 8) * 64 + lane];
#pragma unroll
            for (int w = 1; w < 8; ++w) s = s + red[(wid * 8 + w) * 64 + lane];
            const int row = rt * 16 + fr, col = ct * 16 + 4 * fq;
            if (MODE == 0) { const float rs = rstd_fix(rss[row]);
                u32x2 w2; w2.x = pk2(s[0] * rs, s[1] * rs); w2.y = pk2(s[2] * rs, s[3] * rs); *(u32x2*)((bf16_t*)out + (size_t)row * ldc + col) = w2; }
            else { u32x2* pp = (u32x2*)(xb + (size_t)row * ldc + col); float o[4]; unpack4(*pp, o);
                u32x2 w2; w2.x = pk2(o[0] + s[0], o[1] + s[1]); w2.y = pk2(o[2] + s[2], o[3] + s[3]); *pp = w2;
                unpack4(w2, o);
                float ss = o[0] * o[0] + o[1] * o[1] + o[2] * o[2] + o[3] * o[3];
                ss += shfl_xor_(ss, 16, lane); ss += shfl_xor_(ss, 32, lane);
                if (fq == 0) atomicAdd(rss + row, ss_fix(ss)); }
        }
        __syncthreads();
    }
}

__device__ __forceinline__ void thin_gemm_act(LAS unsigned char* lds, const bf16_t* A, const bf16_t* Bt, const u64* rss, const float* cw, const float* cb, const float* st, float* fo, bf16_t* act) {
    const int tid = TIDX, wid = tid >> 6, lane = tid & 63, fr = lane & 15, fq = lane >> 4;
    constexpr int K = DM, KW = K / 8, STEPS = KW / 32;
    const int ntask = (DFF / 16) * 8;
    LAS f32x4* red = (LAS f32x4*)lds;
    const int per = (ntask + (int)gridDim.x - 1) / (int)gridDim.x, t0 = blockIdx.x * per, t1 = min(ntask, t0 + per);
    for (int base = t0; base < t1; base += 8) {
        const int nr = min(8, t1 - base);
#pragma unroll 2
        for (int i = 0; i < nr; ++i) {
            const int t = base + i, ft = t >> 3, rt = t & 7;
            const int f = ft * 16 + fr, wrow = 256 * (f >> 7) + (f & 127);
            const bf16_t* ap = A + (size_t)(rt * 16 + fr) * K + wid * KW + 8 * fq;
            const bf16_t* bg = Bt + (size_t)wrow * K + wid * KW + 8 * fq;
            const bf16_t* bu = bg + (size_t)128 * K;
            bf16x8 a[STEPS], b1[STEPS], b2[STEPS];
#pragma unroll
            for (int s = 0; s < STEPS; ++s) { a[s] = *(const bf16x8*)(ap + 32 * s); b1[s] = *(const bf16x8*)(bg + 32 * s); b2[s] = *(const bf16x8*)(bu + 32 * s); }
            f32x4 ag = {0.f, 0.f, 0.f, 0.f}, au = {0.f, 0.f, 0.f, 0.f};
#pragma unroll
            for (int s = 0; s < STEPS; ++s) { ag = MFMA(b1[s], a[s], ag); au = MFMA(b2[s], a[s], au); }
            red[(i * 8 + wid) * 64 + lane] = ag; red[4096 + (i * 8 + wid) * 64 + lane] = au;
        }
        __syncthreads();
        if (wid < nr) {
            const int t = base + wid, ft = t >> 3, rt = t & 7;
            f32x4 g = red[(wid * 8) * 64 + lane], up = red[4096 + (wid * 8) * 64 + lane];
#pragma unroll
            for (int w = 1; w < 8; ++w) { g = g + red[(wid * 8 + w) * 64 + lane]; up = up + red[4096 + (wid * 8 + w) * 64 + lane]; }
            const int s = rt * 16 + fr, f = ft * 16 + 4 * fq;
            const float rs = rstd_fix(rss[s]);
            g = g * rs; up = up * rs;
            const f32x4 p0 = *(const f32x4*)(st + ((size_t)s * 2 + 0) * DFF + f), p1 = *(const f32x4*)(st + ((size_t)s * 2 + 1) * DFF + f);
            const f32x4 c0 = *(const f32x4*)(cw + f), c1 = *(const f32x4*)(cw + DFF + f), c2 = *(const f32x4*)(cw + 2 * DFF + f), cbv = *(const f32x4*)(cb + f);
            float o[4];
#pragma unroll
            for (int e = 0; e < 4; ++e) o[e] = geluf_(cbv[e] + c0[e] * p0[e] + c1[e] * p1[e] + c2[e] * g[e]) * up[e];
            u32x2 w2; w2.x = pk2(o[0], o[1]); w2.y = pk2(o[2], o[3]); *(u32x2*)(act + (size_t)s * DFF + f) = w2;
            *(f32x4*)(fo + ((size_t)s * 2 + 0) * DFF + f) = p1; *(f32x4*)(fo + ((size_t)s * 2 + 1) * DFF + f) = g;
        }
        __syncthreads();
    }
}
__device__ __forceinline__ void act_fixup(const Params& p, int l, int pm) {
    const bf16_t* gs01 = (const bf16_t*)(p.ws + W_GS01); const bf16_t* us01 = (const bf16_t*)(p.ws + W_US01); const bf16_t* gs23 = (const bf16_t*)(p.ws + W_GS23);
    bf16_t* act = (bf16_t*)(p.ws + W_DS);
    const float* cw = p.in[27] + (size_t)l * 3 * DFF; const float* cb = p.in[28] + (size_t)l * DFF;
    const int tid = TIDX;
    constexpr int NU = 8 * (DFF / 8), NK = (NU + 511) / 512;
    u32x4 rg[NK], ru[NK], r1[NK], r2[NK];
#pragma unroll
    for (int k = 0; k < NK; ++k) {
        const int idx = tid + 512 * k;
        rg[k] = ru[k] = r1[k] = r2[k] = (u32x4){0u, 0u, 0u, 0u};
        if (idx < NU) {
            const int rsel = idx / (DFF / 8), c0 = (idx % (DFF / 8)) * 8, blk = pm * 4 + (rsel >> 1), rr = rsel & 1;
            const bool seq0 = (blk & 31) == 0;
            rg[k] = *(const u32x4*)(gs01 + ((size_t)blk * 2 + rr) * DFF + c0);
            ru[k] = *(const u32x4*)(us01 + ((size_t)blk * 2 + rr) * DFF + c0);
            if (rr == 0) { if (!seq0) { r1[k] = *(const u32x4*)(gs23 + ((size_t)(blk - 1) * 2 + 1) * DFF + c0); r2[k] = *(const u32x4*)(gs23 + ((size_t)(blk - 1) * 2 + 0) * DFF + c0); } }
            else { r1[k] = *(const u32x4*)(gs01 + ((size_t)blk * 2 + 0) * DFF + c0); if (!seq0) r2[k] = *(const u32x4*)(gs23 + ((size_t)(blk - 1) * 2 + 1) * DFF + c0); }
        }
    }
#pragma unroll
    for (int k = 0; k < NK; ++k) {
        const int idx = tid + 512 * k;
        if (idx < NU) {
            const int rsel = idx / (DFF / 8), c0 = (idx % (DFF / 8)) * 8, blk = pm * 4 + (rsel >> 1), rr = rsel & 1;
            float g[8], up[8], g1[8], g2[8], o[8];
            unpack8(rg[k], g); unpack8(ru[k], up); unpack8(r1[k], g1); unpack8(r2[k], g2);
#pragma unroll
            for (int e = 0; e < 8; ++e) o[e] = geluf_(cb[c0 + e] + cw[c0 + e] * g2[e] + cw[DFF + c0 + e] * g1[e] + cw[2 * DFF + c0 + e] * g[e]) * up[e];
            *(u32x4*)(act + ((size_t)blk * 64 + rr) * DFF + c0) = pack8(o);
        }
    }
}

__device__ void phase_prep(const Params& p, LAS unsigned char* lds) {
    const int tid = TIDX;
    LAS float* tl = (LAS float*)lds;
    for (int grp = blockIdx.x; grp < DEPTH * 3520 / 4; grp += gridDim.x) {
        const float* src[4]; bf16_t* dst[4]; int Ks[4], ldns[4]; const float* gs[4];
        f32x4 v[4][2];
#pragma unroll
        for (int q = 0; q < 4; ++q) {
            const int idx = grp * 4 + q;
            const int l = idx / 3520; int r = idx % 3520;
            int kt, nt;
            if (r < 1024) { gs[q] = p.in[8] + l * DM; src[q] = p.in[9] + (size_t)l * DM * DIN; ldns[q] = DIN; Ks[q] = DM; dst[q] = (bf16_t*)(p.ws + W_WIN) + (size_t)l * NPROJ * DM; nt = r % 64; kt = r / 64; }
            else if (r < 1408) { r -= 1024; gs[q] = nullptr; src[q] = p.in[24] + (size_t)l * DMIX * DM; ldns[q] = DM; Ks[q] = DMIX; dst[q] = (bf16_t*)(p.ws + W_WOUT) + (size_t)l * DM * DMIX; nt = r % 16; kt = r / 16; }
            else if (r < 2816) { r -= 1408; gs[q] = p.in[25] + l * DM; src[q] = p.in[26] + (size_t)l * DM * DGU; ldns[q] = DGU; Ks[q] = DM; dst[q] = (bf16_t*)(p.ws + W_WUP) + (size_t)l * DGU * DM; nt = r % 88; kt = r / 88; }
            else { r -= 2816; gs[q] = nullptr; src[q] = p.in[29] + (size_t)l * DFF * DM; ldns[q] = DM; Ks[q] = DFF; dst[q] = (bf16_t*)(p.ws + W_WDOWN) + (size_t)l * DM * DFF; nt = r % 16; kt = r / 16; }
            int drow = nt * 64;
            if (ldns[q] == DGU) { const int f = drow < DFF ? drow : drow - DFF; drow = 256 * (f >> 7) + (f & 127) + (drow < DFF ? 0 : 128); }
            src[q] += (size_t)(kt * 64) * ldns[q] + nt * 64; dst[q] += (size_t)drow * Ks[q] + kt * 64;
#pragma unroll
            for (int ps = 0; ps < 2; ++ps) { v[q][ps] = __builtin_nontemporal_load((const f32x4*)(src[q] + (size_t)((tid >> 4) + ps * 32) * ldns[q] + (tid & 15) * 4)); if (gs[q]) v[q][ps] = v[q][ps] * gs[q][kt * 64 + (tid >> 4) + ps * 32]; }
        }
#pragma unroll
        for (int q = 0; q < 4; ++q)
#pragma unroll
            for (int ps = 0; ps < 2; ++ps) { LAS float* t = tl + q * 4160 + ((tid >> 4) + ps * 32) * 65 + (tid & 15) * 4; t[0] = v[q][ps][0]; t[1] = v[q][ps][1]; t[2] = v[q][ps][2]; t[3] = v[q][ps][3]; }
        __syncthreads();
#pragma unroll
        for (int q = 0; q < 4; ++q) {
            const int n = tid >> 3, kq = tid & 7;
            float f[8];
#pragma unroll
            for (int e = 0; e < 8; ++e) f[e] = tl[q * 4160 + (8 * kq + e) * 65 + n];
            *(u32x4*)(dst[q] + (size_t)n * Ks[q] + 8 * kq) = pack8(f);
        }
        __syncthreads();
    }
    const int gt = blockIdx.x * 512 + tid, gn = gridDim.x * 512;
    {
        bf16_t* wrT = (bf16_t*)(p.ws + W_LRUW); bf16_t* wiT = wrT + DEPTH * 8 * 64 * 64;
        for (int i = gt; i < DEPTH * 8 * 64 * 64; i += gn) {
            const int lh = i >> 12, j = (i >> 6) & 63, ii = i & 63;
            wrT[i] = f2bf(p.in[12][(size_t)lh * 4096 + ii * 64 + j]);
            wiT[i] = f2bf(p.in[14][(size_t)lh * 4096 + ii * 64 + j]);
        }
    }
    {
        float* rc = (float*)(p.ws + W_ROPE); float* rs = rc + 2049 * 32;
        for (int i = gt; i < 2049 * 32; i += gn) {
            const int pos = (i >> 5) < 2048 ? (i >> 5) : 16384; const int d = i & 31;
            const float freq = powf(10000.f, -(float)d / 32.f);
            const float ang = (float)pos * freq;
            rc[i] = cosf(ang); rs[i] = sinf(ang);
        }
    }
    {
        bf16_t* wdt = (bf16_t*)(p.ws + W_WDT);
        for (int i = gt; i < DEPTH * 16 * DM; i += gn) {
            const int l = i >> 14, j = (i >> 10) & 15, k = i & 1023;
            wdt[i] = j < 8 ? f2bf(p.in[8][l * DM + k] * p.in[9][((size_t)l * DM + k) * DIN + NPROJ + j]) : (bf16_t)0;
        }
    }
    {
        u64* rss = (u64*)(p.ws + W_RSS);
        for (int i = gt; i < 8 * TT; i += gn) rss[TT + i] = 0ull;
    }
    {
        const int wid = tid >> 6, lane = tid & 63;
        bf16_t* xb = (bf16_t*)(p.ws + W_XB); u64* rss = (u64*)(p.ws + W_RSS);
        const int nw = gridDim.x * 8;
        for (int row0 = blockIdx.x * 8 + wid; row0 < TT; row0 += 4 * nw) {
            f32x4 v[4][4];
#pragma unroll
            for (int r = 0; r < 4; ++r) { const int row = row0 + r * nw; const float* src = row < TP ? p.in[0] + (size_t)row * DM : p.in[1] + (size_t)(row - TP) * DM;
#pragma unroll
                for (int i = 0; i < 4; ++i) v[r][i] = row < TT ? __builtin_nontemporal_load((const f32x4*)(src + i * 256 + lane * 4)) : (f32x4){0.f, 0.f, 0.f, 0.f}; }
#pragma unroll
            for (int r = 0; r < 4; ++r) { const int row = row0 + r * nw; float ss = 0.f;
                if (row < TT) {
#pragma unroll
                    for (int i = 0; i < 4; ++i) { u32x2 w; w.x = pk2(v[r][i][0], v[r][i][1]); w.y = pk2(v[r][i][2], v[r][i][3]); *(u32x2*)(xb + (size_t)row * DM + i * 256 + lane * 4) = w;
                        float o[4]; unpack4(w, o); ss += o[0] * o[0] + o[1] * o[1] + o[2] * o[2] + o[3] * o[3]; }
                }
                ss = wave_sum(ss, lane);
                if (lane == 0 && row < TT) rss[row] = ss_fix(ss);
            }
        }
    }
}

__device__ void phase_dt(const Params& p, int l) {
    const int tid = TIDX, wid = tid >> 6, lane = tid & 63, fr = lane & 15, fq = lane >> 4;
    const bf16_t* xb = (const bf16_t*)(p.ws + W_XB); const bf16_t* wdt = (const bf16_t*)(p.ws + W_WDT) + (size_t)l * 16 * DM;
    const u64* rss = (const u64*)(p.ws + W_RSS) + (size_t)(2 * l) * TT; float* dtraw = (float*)(p.ws + W_DT);
    for (int tile = blockIdx.x * 8 + wid; tile < TT / 16; tile += gridDim.x * 8) {
        const bf16_t* ap = xb + (size_t)(tile * 16 + fr) * DM + 8 * fq; const bf16_t* bp = wdt + (size_t)fr * DM + 8 * fq;
        f32x4 acc = {0.f, 0.f, 0.f, 0.f};
#pragma unroll 16
        for (int s = 0; s < 32; ++s) acc = MFMA(*(const bf16x8*)(bp + 32 * s), *(const bf16x8*)(ap + 32 * s), acc);
        const int row = tile * 16 + fr;
        if (fq < 2) { const float rs = rstd_fix(rss[row]); *(f32x4*)(dtraw + (size_t)row * 8 + 4 * fq) = acc * rs; }
    }
}

__device__ void phase_final(const Params& p) {
    const int tid = TIDX, wid = tid >> 6, lane = tid & 63;
    const bf16_t* xb = (const bf16_t*)(p.ws + W_XB);
    const float* g = p.in[30];
    f32x4 g4[4];
#pragma unroll
    for (int i = 0; i < 4; ++i) g4[i] = *(const f32x4*)(g + i * 256 + lane * 4);
    const int nw = gridDim.x * 8;
    for (int row0 = blockIdx.x * 8 + wid; row0 < TT; row0 += 4 * nw) {
        u32x2 raw[4][4];
#pragma unroll
        for (int r = 0; r < 4; ++r) { const int row = row0 + r * nw;
#pragma unroll
            for (int i = 0; i < 4; ++i) raw[r][i] = row < TT ? *(const u32x2*)(xb + (size_t)row * DM + i * 256 + lane * 4) : (u32x2){0u, 0u}; }
#pragma unroll
        for (int r = 0; r < 4; ++r) { const int row = row0 + r * nw;
            f32x4 v[4]; float ss = 0.f;
#pragma unroll
            for (int i = 0; i < 4; ++i) { float o[4]; unpack4(raw[r][i], o); v[i] = (f32x4){o[0], o[1], o[2], o[3]}; ss += o[0] * o[0] + o[1] * o[1] + o[2] * o[2] + o[3] * o[3]; }
            ss = wave_sum(ss, lane);
            const float rstd = rsqrtf(ss * (1.f / DM) + EPS);
            if (row < TT) {
#pragma unroll
                for (int i = 0; i < 4; ++i) __builtin_nontemporal_store(v[i] * rstd * g4[i], (f32x4*)(p.out + (size_t)row * DM + i * 256 + lane * 4));
            }
        }
    }
}


__device__ __forceinline__ float ret_logg(int h) { return log1pf(-exp2f(-5.f - (float)h)); }

template <class CM, class F>
__device__ __forceinline__ void conv64(const bf16_t* proj, int row0, int tseq0, int pc0, const float* cw, const float* cb, int C, int nchunks, CM&& chmap, F&& emit) {
    for (int u = TIDX; u < nchunks * 8; u += 512) {
        const int q = u % nchunks, seg = u / nchunks, c = chmap(q), j0 = seg * 8;
        const bf16_t* src = proj + (size_t)(row0 + j0) * NPROJ + pc0 + c;
        u32x4 raw[11];
        if (tseq0 + j0 == 0) { raw[0] = (u32x4){0u, 0u, 0u, 0u}; raw[1] = raw[0]; raw[2] = raw[0]; }
        else { raw[0] = *(const u32x4*)(src - 3 * NPROJ); raw[1] = *(const u32x4*)(src - 2 * NPROJ); raw[2] = *(const u32x4*)(src - NPROJ); }
#pragma unroll
        for (int j = 0; j < 8; ++j) raw[3 + j] = *(const u32x4*)(src + (size_t)j * NPROJ);
        float w0[8], w1[8], w2[8], w3[8], bb[8];
#pragma unroll
        for (int e = 0; e < 8; ++e) { w0[e] = cw[c + e]; w1[e] = cw[C + c + e]; w2[e] = cw[2 * C + c + e]; w3[e] = cw[3 * C + c + e]; bb[e] = cb[c + e]; }
        float h3[8], h2[8], h1[8];
        unpack8(raw[0], h3); unpack8(raw[1], h2); unpack8(raw[2], h1);
#pragma unroll
        for (int j = 0; j < 8; ++j) {
            float cur[8], y[8];
            unpack8(raw[3 + j], cur);
#pragma unroll
            for (int e = 0; e < 8; ++e) y[e] = bb[e] + w0[e] * h3[e] + w1[e] * h2[e] + w2[e] * h1[e] + w3[e] * cur[e];
            emit(j0 + j, q, c, y);
#pragma unroll
            for (int e = 0; e < 8; ++e) { h3[e] = h2[e]; h2[e] = h1[e]; h1[e] = cur[e]; }
        }
    }
}

__device__ __forceinline__ void rot16(const bf16_t* src, const float* rc, const float* rs, float scale, LAS bf16_t* dst) {
    float x1[16], x2[16], o1[16], o2[16];
    unpack8(*(const u32x4*)src, x1); unpack8(*(const u32x4*)(src + 8), x1 + 8);
    unpack8(*(const u32x4*)(src + 32), x2); unpack8(*(const u32x4*)(src + 40), x2 + 8);
#pragma unroll
    for (int e = 0; e < 16; ++e) { const float c = rc[e], s = rs[e]; o1[e] = (x1[e] * c - x2[e] * s) * scale; o2[e] = (x1[e] * s + x2[e] * c) * scale; }
    *(LAS u32x4*)dst = pack8(o1); *(LAS u32x4*)(dst + 8) = pack8(o1 + 8);
    *(LAS u32x4*)(dst + 32) = pack8(o2); *(LAS u32x4*)(dst + 40) = pack8(o2 + 8);
}

__device__ void ret_m1(const Params& p, LAS unsigned char* lds, int b, int c) {
    const int tid = TIDX, wid = tid >> 6, lane = tid & 63, fr = lane & 15, fq = lane >> 4;
    const bf16_t* proj = (const bf16_t*)(p.ws + W_PROJ);
    const float* rc = (const float*)(p.ws + W_ROPE); const float* rs = rc + 2049 * 32;
    float* dS = (float*)(p.ws + W_DS);
    LAS bf16_t* Kt = (LAS bf16_t*)lds;
    LAS bf16_t* Vt = (LAS bf16_t*)(lds + 33792);
    const int row0 = b * SEQ + c * 64, pos0 = c * 64;
    {
        const int j = tid >> 3, sub = tid & 7, h = sub >> 1, d0 = (sub & 1) * 16;
        const float scale = 0.125f * fexp_((float)(63 - j) * ret_logg(h));
        rot16(proj + (size_t)(row0 + j) * NPROJ + PC_K + h * 64 + d0, rc + (pos0 + j) * 32 + d0, rs + (pos0 + j) * 32 + d0, scale, Kt + j * 264 + h * 64 + d0);
#pragma unroll
        for (int i = 0; i < 8; ++i) { const int id = tid + 512 * i, jj = id >> 6, cc = id & 63;
            *(LAS u32x4*)(Vt + jj * 520 + cc * 8) = *(const u32x4*)(proj + (size_t)(row0 + jj) * NPROJ + PC_V + cc * 8); }
    }
    __syncthreads();
    {
        const int h = wid >> 1, vh = wid & 1;
        bf16x8 X[4][2];
#pragma unroll
        for (int kt = 0; kt < 4; ++kt)
#pragma unroll
            for (int kk = 0; kk < 2; ++kk) X[kt][kk] = frag_tr(Kt, 264, kk * 32, h * 64 + kt * 16, fr, fq);
        float* out = dS + ((size_t)((b * 4 + h) * NCH + c)) * 8192;
#pragma unroll
        for (int vt = 0; vt < 4; ++vt) {
            bf16x8 Y[2];
#pragma unroll
            for (int kk = 0; kk < 2; ++kk) Y[kk] = frag_tr(Vt, 520, kk * 32, h * 128 + vh * 64 + vt * 16, fr, fq);
#pragma unroll
            for (int kt = 0; kt < 4; ++kt) {
                f32x4 a = {0.f, 0.f, 0.f, 0.f};
                a = MFMA(X[kt][0], Y[0], a); a = MFMA(X[kt][1], Y[1], a);
                *(f32x4*)(out + (vh * 64 + vt * 16 + fr) * 64 + kt * 16 + 4 * fq) = a;
            }
        }
    }
    __syncthreads();
}

template <int NH>
__device__ __forceinline__ void ssd_dt_cum(const Params& p, int l, int row0, int h0, LAS float* dtv, LAS float* cum) {
    const int tid = TIDX, hl = tid >> 6, j = tid & 63;
    const float* dtraw = (const float*)(p.ws + W_DT);
    if (hl < NH) {
        const int h = h0 + hl;
        const float dt = softplusf_(dtraw[(size_t)(row0 + j) * 8 + h] + p.in[20][l * 8 + h]);
        float v = -dt * fexp_(p.in[21][l * 8 + h]);
#pragma unroll
        for (int o = 1; o < 64; o <<= 1) { const float t = shfl_up_(v, o, j); if (j >= o) v += t; }
        dtv[hl * 64 + j] = dt; cum[hl * 64 + j] = v;
    }
    __syncthreads();
}

__device__ void ssd_m1(const Params& p, LAS unsigned char* lds, int l, int b, int c) {
    const int tid = TIDX, wid = tid >> 6, lane = tid & 63, fr = lane & 15, fq = lane >> 4;
    const bf16_t* proj = (const bf16_t*)(p.ws + W_PROJ);
    float* dS = (float*)(p.ws + W_DSSSD); float* dec = (float*)(p.ws + W_DEC);
    LAS bf16_t* Xs = (LAS bf16_t*)lds;
    LAS bf16_t* Bm = (LAS bf16_t*)(lds + 66560);
    LAS float* dtv = (LAS float*)(lds + 100352);
    LAS float* cum = dtv + 512;
    LAS float* wl = cum + 512;
    const int row0 = b * SEQ + c * 64;
    ssd_dt_cum<8>(p, l, row0, 0, dtv, cum);
    { const int h = tid >> 6, j = tid & 63; wl[tid] = fexp_(cum[h * 64 + 63] - cum[tid]) * dtv[tid]; if (j == 63) dec[(b * 8 + h) * NCH + c] = fexp_(cum[h * 64 + 63]); }
    __syncthreads();
    conv64(proj, row0, c * 64, PC_XBC, p.in[18] + (size_t)l * 4 * 1024, p.in[19] + l * 1024, 1024, 96, [](int q) { return q * 8; },
           [&](int j, int q, int ch, float* y) {
               float s[8];
               if (ch < 512) { const float w = wl[(ch >> 6) * 64 + j];
#pragma unroll
                   for (int e = 0; e < 8; ++e) s[e] = siluf_(y[e]) * w;
                   *(LAS u32x4*)(Xs + j * 520 + ch) = pack8(s);
               } else {
#pragma unroll
                   for (int e = 0; e < 8; ++e) s[e] = siluf_(y[e]);
                   *(LAS u32x4*)(Bm + j * 264 + ch - 512) = pack8(s);
               }
           });
    __syncthreads();
    {
        const int h = wid, g = h >> 2;
        bf16x8 Y[4][2];
#pragma unroll
        for (int pt = 0; pt < 4; ++pt)
#pragma unroll
            for (int kk = 0; kk < 2; ++kk) Y[pt][kk] = frag_tr(Xs, 520, kk * 32, h * 64 + pt * 16, fr, fq);
        float* out = dS + ((size_t)((b * 8 + h) * NCH + c)) * 8192;
#pragma unroll
        for (int nt = 0; nt < 8; ++nt) {
            bf16x8 X[2];
#pragma unroll
            for (int kk = 0; kk < 2; ++kk) X[kk] = frag_tr(Bm, 264, kk * 32, g * 128 + nt * 16, fr, fq);
#pragma unroll
            for (int pt = 0; pt < 4; ++pt) {
                f32x4 a = {0.f, 0.f, 0.f, 0.f};
                a = MFMA(X[0], Y[pt][0], a); a = MFMA(X[1], Y[pt][1], a);
                *(f32x4*)(out + (pt * 16 + fr) * 128 + nt * 16 + 4 * fq) = a;
            }
        }
    }
    __syncthreads();
}

template <int PASS>
__device__ void lru_item(const Params& p, LAS unsigned char* lds, int l, int b, int c) {
    const int tid = TIDX, wid = tid >> 6, lane = tid & 63, fr = lane & 15, fq = lane >> 4;
    const bf16_t* proj = (const bf16_t*)(p.ws + W_PROJ);
    LAS bf16_t* xc = (LAS bf16_t*)lds;
    const int row0 = b * SEQ + c * 64;
    const int h = wid;
    const bf16_t* wrT = (const bf16_t*)(p.ws + W_LRUW) + (size_t)(l * 8 + h) * 4096;
    const bf16_t* wiT = wrT + DEPTH * 8 * 4096;
    bf16x8 BrA[4][2], BiA[4][2]; float brA[4], biA[4], lamA[4], hinA[4];
#pragma unroll
    for (int n = 0; n < 4; ++n) {
#pragma unroll
        for (int kk = 0; kk < 2; ++kk) { BrA[n][kk] = *(const bf16x8*)(wrT + (n * 16 + fr) * 64 + kk * 32 + 8 * fq); BiA[n][kk] = *(const bf16x8*)(wiT + (n * 16 + fr) * 64 + kk * 32 + 8 * fq); }
        const int ch = h * 64 + n * 16 + fr;
        brA[n] = p.in[13][l * 512 + ch]; biA[n] = p.in[15][l * 512 + ch]; lamA[n] = p.in[16][l * 512 + ch];
        hinA[n] = PASS == 2 ? ((const float*)(p.ws + W_LRUHIN))[(size_t)(b * NCH + c) * 512 + ch] : 0.f;
    }
    conv64(proj, row0, c * 64, PC_LX, p.in[10] + (size_t)l * 4 * 512, p.in[11] + l * 512, 512, 64, [](int q) { return q * 8; },
           [&](int j, int q, int ch, float* y) { *(LAS u32x4*)(xc + j * 520 + ch) = pack8(y); });
    __syncthreads();
    bf16x8 Af[4][2];
#pragma unroll
    for (int m = 0; m < 4; ++m)
#pragma unroll
        for (int kk = 0; kk < 2; ++kk) Af[m][kk] = frag_row(xc, 520, m * 16, h * 64 + kk * 32, fr, fq);
    float* lruAB = (float*)(p.ws + W_LRUAB); const float* hin = (const float*)(p.ws + W_LRUHIN);
    bf16_t* mix = (bf16_t*)(p.ws + W_HB);
#pragma unroll
    for (int n = 0; n < 4; ++n) {
        f32x4 ar[4], ai[4];
        {
            bf16x8 Br[2], Bi[2];
#pragma unroll
            for (int kk = 0; kk < 2; ++kk) { Br[kk] = BrA[n][kk]; Bi[kk] = BiA[n][kk]; }
#pragma unroll
            for (int m = 0; m < 4; ++m) {
                f32x4 a = {0.f, 0.f, 0.f, 0.f}, bq = {0.f, 0.f, 0.f, 0.f};
                a = MFMA(Af[m][0], Br[0], a); a = MFMA(Af[m][1], Br[1], a);
                bq = MFMA(Af[m][0], Bi[0], bq); bq = MFMA(Af[m][1], Bi[1], bq);
                ar[m] = a; ai[m] = bq;
            }
        }
        const int ch = h * 64 + n * 16 + fr;
        const float br = brA[n], bi = biA[n];
        const float sp = log1pf(fexp_(-lamA[n]));
#pragma unroll
        for (int m = 0; m < 4; ++m)
#pragma unroll
            for (int i = 0; i < 4; ++i) {
                const int t = m * 16 + 4 * fq + i;
                const float xv = bf2f(xc[t * 520 + ch]);
                const float r = sigmoidf_(ar[m][i] + br), ig = sigmoidf_(ai[m][i] + bi);
                const float la = -8.f * r * sp;
                const float av = fexp_(la);
                ar[m][i] = av;
                ai[m][i] = __builtin_amdgcn_sqrtf(fmaxf(1.f - av * av, 0.f)) * ig * xv;
            }
        float carry = 0.f, Atot = 1.f;
        if (PASS == 2) carry = hinA[n];
#pragma unroll
        for (int m = 0; m < 4; ++m) {
            const float a0 = ar[m][0], a1 = ar[m][1], a2 = ar[m][2], a3 = ar[m][3];
            const float b0 = ai[m][0], b1 = ai[m][1], b2 = ai[m][2], b3 = ai[m][3];
            float Al = a0 * a1 * a2 * a3, Bl = ((b0 * a1 + b1) * a2 + b2) * a3 + b3;
            float Ap = shfl_up_(Al, 16, lane), Bp = shfl_up_(Bl, 16, lane);
            if (fq >= 1) { Bl = Bp * Al + Bl; Al = Ap * Al; }
            Ap = shfl_up_(Al, 32, lane); Bp = shfl_up_(Bl, 32, lane);
            if (fq >= 2) { Bl = Bp * Al + Bl; Al = Ap * Al; }
            float Aex = shfl_up_(Al, 16, lane), Bex = shfl_up_(Bl, 16, lane);
            if (fq == 0) { Aex = 1.f; Bex = 0.f; }
            const float At = shfl_idx(Al, fr + 48), Bt = shfl_idx(Bl, fr + 48);
            if (PASS == 2) {
                float hh = Aex * carry + Bex;
                hh = a0 * hh + b0; ai[m][0] = hh;
                hh = a1 * hh + b1; ai[m][1] = hh;
                hh = a2 * hh + b2; ai[m][2] = hh;
                hh = a3 * hh + b3; ai[m][3] = hh;
            }
            carry = At * carry + Bt; Atot *= At;
        }
        if (PASS == 1) {
            if (fq == 0) { f32x2 v = {Atot, carry}; *(f32x2*)(lruAB + ((size_t)(b * NCH + c) * 512 + ch) * 2) = v; }
        } else {
            bf16_t gv[4][4];
#pragma unroll
            for (int m = 0; m < 4; ++m)
#pragma unroll
                for (int i = 0; i < 4; ++i) gv[m][i] = proj[(size_t)(row0 + m * 16 + 4 * fq + i) * NPROJ + PC_LG + ch];
#pragma unroll
            for (int m = 0; m < 4; ++m)
#pragma unroll
                for (int i = 0; i < 4; ++i) {
                    const size_t t = row0 + m * 16 + 4 * fq + i;
                    mix[t * DMIX + ch] = f2bf(ai[m][i] * geluf_(bf2f(gv[m][i])));
                }
        }
    }
    __syncthreads();
}

__device__ void phase_m15(const Params& p, int l) {
    const int gt = blockIdx.x * 512 + TIDX, gn = gridDim.x * 512;
    const float* dSr = (const float*)(p.ws + W_DS); const float* dSs = (const float*)(p.ws + W_DSSSD); const float* dec = (const float*)(p.ws + W_DEC);
    bf16_t* spr = (bf16_t*)(p.ws + W_SPR); bf16_t* sps = (bf16_t*)(p.ws + W_SPS);
    for (int u = gt; u < (32 + 64) * 4096; u += gn) {
        float zz = 0.f; asm volatile("" : "+v"(zz));
        f32x2 S = {zz, zz};
        f32x2 tv[NCH];
        if (u < 32 * 4096) {
            const int bh = u >> 12, e2 = u & 4095, h = bh & 3;
            const float* ptr = dSr + (size_t)bh * NCH * 8192 + e2 * 2; bf16_t* sp = spr + (size_t)bh * NCH * 8192 + e2 * 2;
            const float d = fexp_(64.f * ret_logg(h));
#pragma unroll
            for (int c = 0; c < NCH; ++c) tv[c] = *(const f32x2*)(ptr + (size_t)c * 8192);
#pragma unroll
            for (int c = 0; c < NCH; ++c) { *(unsigned*)(sp + (size_t)c * 8192) = pk2(S[0], S[1]); S = S * d + tv[c]; }
            float* o = p.out + O_RP + ((size_t)(l * NB * 4 + bh)) * 8192;
#pragma unroll
            for (int i = 0; i < 2; ++i) { const int e = e2 * 2 + i, v = e >> 6, k = e & 63; o[k * 128 + v] = S[i]; }
        } else {
            const int uu = u - 32 * 4096, bh = uu >> 12, e2 = uu & 4095;
            const float* ptr = dSs + (size_t)bh * NCH * 8192 + e2 * 2; bf16_t* sp = sps + (size_t)bh * NCH * 8192 + e2 * 2;
            float dc[NCH];
#pragma unroll
            for (int c = 0; c < NCH; ++c) { tv[c] = *(const f32x2*)(ptr + (size_t)c * 8192); dc[c] = dec[bh * NCH + c]; }
#pragma unroll
            for (int c = 0; c < NCH; ++c) { *(unsigned*)(sp + (size_t)c * 8192) = pk2(S[0], S[1]); S = S * dc[c] + tv[c]; }
            *(f32x2*)(p.out + O_SP + ((size_t)(l * NB * 8 + bh)) * 8192 + e2 * 2) = S;
        }
    }
    const float* lruAB = (const float*)(p.ws + W_LRUAB); float* hin = (float*)(p.ws + W_LRUHIN);
    for (int u = gt; u < NB * 512; u += gn) {
        const int b = u >> 9, ch = u & 511; float h = 0.f;
        f32x2 ab[NCH];
#pragma unroll
        for (int c = 0; c < NCH; ++c) ab[c] = *(const f32x2*)(lruAB + ((size_t)(b * NCH + c) * 512 + ch) * 2);
#pragma unroll
        for (int c = 0; c < NCH; ++c) { hin[(size_t)(b * NCH + c) * 512 + ch] = h; h = ab[c][0] * h + ab[c][1]; }
        p.out[O_LHP + (size_t)(l * NB + b) * 512 + ch] = h;
    }
}

__device__ void ret_m2(const Params& p, LAS unsigned char* lds, int l, int b, int c, int hp) {
    const int tid = TIDX, wid = tid >> 6, lane = tid & 63, fr = lane & 15, fq = lane >> 4;
    const bf16_t* proj = (const bf16_t*)(p.ws + W_PROJ);
    const float* rc = (const float*)(p.ws + W_ROPE); const float* rs = rc + 2049 * 32;
    const bf16_t* sp = (const bf16_t*)(p.ws + W_SPR);
    bf16_t* mix = (bf16_t*)(p.ws + W_HB);
    const int row0 = b * SEQ + c * 64, pos0 = c * 64;
    constexpr int HB = 63488;
    {
        const int j = tid >> 3, sub = tid & 7, hh = sub >> 2, which = (sub >> 1) & 1, d0 = (sub & 1) * 16, h = 2 * hp + hh;
        LAS bf16_t* dst = (LAS bf16_t*)(lds + hh * HB + which * 9216) + j * 72 + d0;
        rot16(proj + (size_t)(row0 + j) * NPROJ + (which ? PC_K : PC_Q) + h * 64 + d0, rc + (pos0 + j) * 32 + d0, rs + (pos0 + j) * 32 + d0, which ? 0.125f : 1.f, dst);
#pragma unroll
        for (int i = 0; i < 4; ++i) { const int id = tid + 512 * i, h2 = id >> 10, jj = (id >> 4) & 63, cc = id & 15;
            *(LAS u32x4*)((LAS bf16_t*)(lds + h2 * HB + 18432) + jj * 136 + cc * 8) = *(const u32x4*)(proj + (size_t)(row0 + jj) * NPROJ + PC_V + (2 * hp + h2) * 128 + cc * 8); }
#pragma unroll
        for (int i = 0; i < 4; ++i) { const int id = tid + 512 * i, h2 = id >> 10, v = (id >> 3) & 127, kc = id & 7;
            *(LAS u32x4*)((LAS bf16_t*)(lds + h2 * HB + 35840) + v * 72 + kc * 8) = *(const u32x4*)(sp + ((size_t)((b * 4 + 2 * hp + h2) * NCH + c)) * 8192 + v * 64 + kc * 8); }
    }
    __syncthreads();
    const int hh = wid >> 2, it = wid & 3, i0 = it * 16, h = 2 * hp + hh;
    const float lg = ret_logg(h);
    LAS bf16_t* Q = (LAS bf16_t*)(lds + hh * HB); LAS bf16_t* Kk = Q + 64 * 72; LAS bf16_t* V = (LAS bf16_t*)(lds + hh * HB + 18432);
    LAS bf16_t* S = (LAS bf16_t*)(lds + hh * HB + 35840); LAS bf16_t* P = (LAS bf16_t*)(lds + hh * HB + 54272);
    bf16x8 Yq[2];
#pragma unroll
    for (int kk = 0; kk < 2; ++kk) Yq[kk] = frag_row(Q, 72, i0, kk * 32, fr, fq);
    const int irow = i0 + fr;
#pragma unroll
    for (int jt = 0; jt < 4; ++jt) {
        f32x4 sc = {0.f, 0.f, 0.f, 0.f};
#pragma unroll
        for (int kk = 0; kk < 2; ++kk) sc = MFMA(frag_row(Kk, 72, jt * 16, kk * 32, fr, fq), Yq[kk], sc);
        float v[4];
#pragma unroll
        for (int i = 0; i < 4; ++i) { const int j = jt * 16 + 4 * fq + i; v[i] = j <= irow ? sc[i] * fexp_((float)(irow - j) * lg) : 0.f; }
        u32x2 w; w.x = pk2(v[0], v[1]); w.y = pk2(v[2], v[3]);
        *(LAS u32x2*)(P + irow * 72 + jt * 16 + 4 * fq) = w;
    }
    __syncthreads();
    const size_t t = row0 + irow;
    u32x2 rgv[8]; f32x4 ngv[8];
#pragma unroll
    for (int vt = 0; vt < 8; ++vt) { rgv[vt] = *(const u32x2*)(proj + t * NPROJ + PC_RG + h * 128 + vt * 16 + 4 * fq); ngv[vt] = *(const f32x4*)(p.in[17] + l * 512 + h * 128 + vt * 16 + 4 * fq); }
    bf16x8 Yp[2];
#pragma unroll
    for (int kk = 0; kk < 2; ++kk) Yp[kk] = frag_row(P, 72, i0, kk * 32, fr, fq);
    const float qdec = fexp_((float)(irow + 1) * lg);
    f32x4 o[8]; float ssq = 0.f;
#pragma unroll
    for (int vt = 0; vt < 8; ++vt) {
        f32x4 a1 = {0.f, 0.f, 0.f, 0.f}, a2 = {0.f, 0.f, 0.f, 0.f};
#pragma unroll
        for (int kk = 0; kk < 2; ++kk) { a1 = MFMA(frag_tr(V, 136, kk * 32, vt * 16, fr, fq), Yp[kk], a1); a2 = MFMA(frag_row(S, 72, vt * 16, kk * 32, fr, fq), Yq[kk], a2); }
        o[vt] = a1 + a2 * qdec;
        ssq += o[vt][0] * o[vt][0] + o[vt][1] * o[vt][1] + o[vt][2] * o[vt][2] + o[vt][3] * o[vt][3];
    }
    ssq += shfl_xor_(ssq, 16, lane); ssq += shfl_xor_(ssq, 32, lane);
    const float rstd = rsqrtf(ssq * (1.f / 128.f) + EPS);
#pragma unroll
    for (int vt = 0; vt < 8; ++vt) {
        const int v = vt * 16 + 4 * fq;
        float gt[4]; unpack4(rgv[vt], gt);
        const f32x4 ng = ngv[vt];
        float y[4];
#pragma unroll
        for (int i = 0; i < 4; ++i) y[i] = siluf_(gt[i]) * (o[vt][i] * rstd * ng[i]);
        u32x2 w; w.x = pk2(y[0], y[1]); w.y = pk2(y[2], y[3]);
        *(u32x2*)(mix + t * DMIX + 512 + h * 128 + v) = w;
    }
    __syncthreads();
}

__device__ void ssd_m2(const Params& p, LAS unsigned char* lds, int l, int b, int c, int g) {
    const int tid = TIDX, wid = tid >> 6, lane = tid & 63, fr = lane & 15, fq = lane >> 4;
    const bf16_t* proj = (const bf16_t*)(p.ws + W_PROJ);
    const bf16_t* sp = (const bf16_t*)(p.ws + W_SPS);
    bf16_t* mix = (bf16_t*)(p.ws + W_HB);
    const int row0 = b * SEQ + c * 64;
    LAS bf16_t* Cm = (LAS bf16_t*)lds;
    LAS bf16_t* Bm = (LAS bf16_t*)(lds + 17408);
    constexpr int PB = 34816, HB = 35840;
    LAS float* dtv = (LAS float*)(lds + 106496);
    LAS float* cum = dtv + 256;
    LAS float* ssqb = cum + 256;
    ssd_dt_cum<4>(p, l, row0, 4 * g, dtv, cum);
    const float* cw = p.in[18] + (size_t)l * 4 * 1024; const float* cb = p.in[19] + l * 1024;
    conv64(proj, row0, c * 64, PC_XBC, cw, cb, 1024, 32, [g](int q) { return (q < 16 ? 512 : 768 - 128) + g * 128 + q * 8; },
           [&](int j, int q, int ch, float* y) {
               float s[8];
#pragma unroll
               for (int e = 0; e < 8; ++e) s[e] = siluf_(y[e]);
               if (q < 16) *(LAS u32x4*)(Bm + j * 136 + q * 8) = pack8(s); else *(LAS u32x4*)(Cm + j * 136 + (q - 16) * 8) = pack8(s);
           });
    const int hh = wid >> 2, it = wid & 3, i0 = it * 16, irow = i0 + fr;
    const size_t t = row0 + irow;
    f32x4 gy[2][4]; float ssq = 0.f;
#pragma unroll
    for (int pr = 0; pr < 2; ++pr) {
        const int hbase = 4 * g + 2 * pr;
        conv64(proj, row0, c * 64, PC_XBC, cw, cb, 1024, 16, [hbase](int q) { return hbase * 64 + q * 8; },
               [&](int j, int q, int ch, float* y) {
                   float s[8];
#pragma unroll
                   for (int e = 0; e < 8; ++e) s[e] = siluf_(y[e]);
                   *(LAS u32x4*)((LAS bf16_t*)(lds + PB + (q >> 3) * HB + 9216) + j * 72 + (q & 7) * 8) = pack8(s);
               });
#pragma unroll
        for (int i = 0; i < 4; ++i) { const int id = tid + 512 * i, h2 = id >> 10, pp = (id >> 4) & 63, nc = id & 15;
            *(LAS u32x4*)((LAS bf16_t*)(lds + PB + h2 * HB + 18432) + pp * 136 + nc * 8) = *(const u32x4*)(sp + ((size_t)((b * 8 + hbase + h2) * NCH + c)) * 8192 + pp * 128 + nc * 8); }
        __syncthreads();
        const int h = hbase + hh, hl = 2 * pr + hh;
        LAS bf16_t* P = (LAS bf16_t*)(lds + PB + hh * HB); LAS bf16_t* X = P + 64 * 72; LAS bf16_t* S = (LAS bf16_t*)(lds + PB + hh * HB + 18432);
        bf16x8 Yc[4];
#pragma unroll
        for (int kk = 0; kk < 4; ++kk) Yc[kk] = frag_row(Cm, 136, i0, kk * 32, fr, fq);
        const float cumi = cum[hl * 64 + irow];
#pragma unroll
        for (int jh = 0; jh < 2; ++jh) {
            bf16x8 Xb[2][4]; f32x4 cj[2], dj[2];
#pragma unroll
            for (int q = 0; q < 2; ++q) {
#pragma unroll
                for (int kk = 0; kk < 4; ++kk) Xb[q][kk] = frag_row(Bm, 136, (2 * jh + q) * 16, kk * 32, fr, fq);
                cj[q] = *(const LAS f32x4*)(cum + hl * 64 + (2 * jh + q) * 16 + 4 * fq); dj[q] = *(const LAS f32x4*)(dtv + hl * 64 + (2 * jh + q) * 16 + 4 * fq);
            }
#pragma unroll
            for (int q = 0; q < 2; ++q) {
                const int jt = 2 * jh + q;
                f32x4 sc = {0.f, 0.f, 0.f, 0.f};
#pragma unroll
                for (int kk = 0; kk < 4; ++kk) sc = MFMA(Xb[q][kk], Yc[kk], sc);
                float v[4];
#pragma unroll
                for (int i = 0; i < 4; ++i) { const int j = jt * 16 + 4 * fq + i; v[i] = j <= irow ? sc[i] * fexp_(cumi - cj[q][i]) * dj[q][i] : 0.f; }
                u32x2 w; w.x = pk2(v[0], v[1]); w.y = pk2(v[2], v[3]);
                *(LAS u32x2*)(P + irow * 72 + jt * 16 + 4 * fq) = w;
            }
        }
        __syncthreads();
        u32x2 zraw[4];
#pragma unroll
        for (int pt = 0; pt < 4; ++pt) zraw[pt] = *(const u32x2*)(proj + t * NPROJ + PC_Z + h * 64 + pt * 16 + 4 * fq);
        bf16x8 Yp[2];
#pragma unroll
        for (int kk = 0; kk < 2; ++kk) Yp[kk] = frag_row(P, 72, i0, kk * 32, fr, fq);
        const float ecum = fexp_(cumi), Dh = p.in[22][l * 8 + h];
#pragma unroll
        for (int pt = 0; pt < 4; ++pt) {
            f32x4 a1 = {0.f, 0.f, 0.f, 0.f}, a2 = {0.f, 0.f, 0.f, 0.f};
#pragma unroll
            for (int kk = 0; kk < 2; ++kk) a1 = MFMA(frag_tr(X, 72, kk * 32, pt * 16, fr, fq), Yp[kk], a1);
#pragma unroll
            for (int kk = 0; kk < 4; ++kk) a2 = MFMA(frag_row(S, 136, pt * 16, kk * 32, fr, fq), Yc[kk], a2);
            const int pp = pt * 16 + 4 * fq;
            float xv[4], zv[4]; unpack4(*(const LAS u32x2*)(X + irow * 72 + pp), xv);
            unpack4(zraw[pt], zv);
            f32x4 r;
#pragma unroll
            for (int i = 0; i < 4; ++i) { const float y = a1[i] + ecum * a2[i] + Dh * xv[i]; r[i] = y * siluf_(zv[i]); ssq += r[i] * r[i]; }
            gy[pr][pt] = r;
        }
        __syncthreads();
    }
    f32x4 ngv[2][4];
#pragma unroll
    for (int pr = 0; pr < 2; ++pr)
#pragma unroll
        for (int pt = 0; pt < 4; ++pt) ngv[pr][pt] = *(const f32x4*)(p.in[23] + l * 512 + g * 256 + (2 * pr + hh) * 64 + pt * 16 + 4 * fq);
    ssq += shfl_xor_(ssq, 16, lane); ssq += shfl_xor_(ssq, 32, lane);
    if (fq == 0) ssqb[irow * 2 + hh] = ssq;
    __syncthreads();
    const float rstd = rsqrtf((ssqb[irow * 2] + ssqb[irow * 2 + 1]) * (1.f / 256.f) + EPS);
#pragma unroll
    for (int pr = 0; pr < 2; ++pr)
#pragma unroll
        for (int pt = 0; pt < 4; ++pt) {
            const int chn = g * 256 + (2 * pr + hh) * 64 + pt * 16 + 4 * fq;
            const f32x4 ng = ngv[pr][pt];
            u32x2 w; w.x = pk2(gy[pr][pt][0] * rstd * ng[0], gy[pr][pt][1] * rstd * ng[1]); w.y = pk2(gy[pr][pt][2] * rstd * ng[2], gy[pr][pt][3] * rstd * ng[3]);
            *(u32x2*)(mix + t * DMIX + 1024 + chn) = w;
        }
    __syncthreads();
}

__device__ void sample_item(const Params& p, LAS unsigned char* lds, int l, int s, int g) {
    const int tid = TIDX, wid = tid >> 6, lane = tid & 63;
    const bf16_t* proj = (const bf16_t*)(p.ws + W_PROJ);
    bf16_t* mix = (bf16_t*)(p.ws + W_HB);
    const size_t t = TP + s;
    const bf16_t* prow = proj + t * NPROJ;
    LAS float* sv = (LAS float*)lds;
    LAS float* sdt = sv + 512;
    LAS float* gy = sv + 520;
    LAS float* sq = sv + 776;
    LAS float* ro = sv + 1032;
    LAS float* sxc = sv + 2304;
    f32x4 ssd0[4][4], ret0[2][4];
    {
        const int n4 = (tid & 31) * 4, pr = tid >> 5;
#pragma unroll
        for (int hl = 0; hl < 4; ++hl)
#pragma unroll
            for (int ps = 0; ps < 4; ++ps) ssd0[hl][ps] = __builtin_nontemporal_load((const f32x4*)(p.in[6] + ((size_t)(l * NS + s) * 8 + 4 * g + hl) * 8192 + (ps * 16 + pr) * 128 + n4));
#pragma unroll
        for (int hh = 0; hh < 2; ++hh)
#pragma unroll
            for (int ps = 0; ps < 4; ++ps) ret0[hh][ps] = __builtin_nontemporal_load((const f32x4*)(p.in[4] + ((size_t)(l * NS + s) * 4 + 2 * g + hh) * 8192 + (ps * 16 + pr) * 128 + n4));
    }
    {
        const int ch = tid < 256 ? g * 256 + tid : (tid < 384 ? 512 + g * 128 + (tid - 256) : 768 + g * 128 + (tid - 384));
        const float* cw = p.in[18] + (size_t)l * 4 * 1024; const float* st = p.in[5] + (size_t)(l * NS + s) * 3 * 1024;
        const float cur = bf2f(prow[PC_XBC + ch]);
        const float s0 = st[ch], s1 = st[1024 + ch], s2 = st[2048 + ch];
        const float y = p.in[19][l * 1024 + ch] + cw[ch] * s0 + cw[1024 + ch] * s1 + cw[2048 + ch] * s2 + cw[3072 + ch] * cur;
        sv[tid] = siluf_(y);
        float* so = p.out + O_SCS + (size_t)(l * NS + s) * 3 * 1024;
        so[ch] = s1; so[1024 + ch] = s2; so[2048 + ch] = cur;
        if (tid < 4) {
            const int h = 4 * g + tid;
            const float dt = softplusf_(((const float*)(p.ws + W_DT))[t * 8 + h] + p.in[20][l * 8 + h]);
            sdt[tid] = dt; sdt[4 + tid] = fexp_(-dt * fexp_(p.in[21][l * 8 + h]));
        }
    }
    __syncthreads();
    {
        const int n4 = (tid & 31) * 4, pr = tid >> 5;
        const f32x4 bv = *(const LAS f32x4*)(sv + 256 + n4), cv = *(const LAS f32x4*)(sv + 384 + n4);
        float part[4][4]; bf16_t zr[4][4];
#pragma unroll
        for (int hl = 0; hl < 4; ++hl)
#pragma unroll
            for (int ps = 0; ps < 4; ++ps) zr[hl][ps] = prow[PC_Z + (4 * g + hl) * 64 + ps * 16 + pr];
#pragma unroll
        for (int hl = 0; hl < 4; ++hl) {
            const int h = 4 * g + hl;
            const float dt = sdt[hl], eda = sdt[4 + hl];
            float* S1 = p.out + O_SS + ((size_t)(l * NS + s) * 8 + h) * 8192;
#pragma unroll
            for (int ps = 0; ps < 4; ++ps) {
                const int pp = ps * 16 + pr;
                const float xp = sv[hl * 64 + pp];
                const f32x4 sn = ssd0[hl][ps] * eda + bv * (dt * xp);
                __builtin_nontemporal_store(sn, (f32x4*)(S1 + pp * 128 + n4));
                part[hl][ps] = cv[0] * sn[0] + cv[1] * sn[1] + cv[2] * sn[2] + cv[3] * sn[3];
            }
        }
#pragma unroll
        for (int o = 16; o >= 1; o >>= 1)
#pragma unroll
            for (int hl = 0; hl < 4; ++hl)
#pragma unroll
                for (int ps = 0; ps < 4; ++ps) part[hl][ps] += shfl_xor_(part[hl][ps], o, lane);
        if ((tid & 31) == 0) {
#pragma unroll
            for (int hl = 0; hl < 4; ++hl)
#pragma unroll
                for (int ps = 0; ps < 4; ++ps) { const int pp = ps * 16 + pr; const float y = part[hl][ps] + p.in[22][l * 8 + 4 * g + hl] * sv[hl * 64 + pp]; gy[hl * 64 + pp] = y * siluf_(bf2f(zr[hl][ps])); }
        }
    }
    __syncthreads();
    {
        const f32x4 v = *(const LAS f32x4*)(gy + lane * 4);
        const float ssq = wave_sum(v[0] * v[0] + v[1] * v[1] + v[2] * v[2] + v[3] * v[3], lane);
        const float rstd = rsqrtf(ssq * (1.f / 256.f) + EPS);
        if (tid < 256) mix[t * DMIX + 1024 + g * 256 + tid] = f2bf(gy[tid] * rstd * p.in[23][l * 512 + g * 256 + tid]);
    }
    if (tid < 128) {
        const int hh = tid >> 6, w = (tid >> 5) & 1, d = tid & 31, h = 2 * g + hh;
        const int col = (w ? PC_K : PC_Q) + h * 64;
        const float x1 = bf2f(prow[col + d]), x2 = bf2f(prow[col + 32 + d]);
        const float* rc = (const float*)(p.ws + W_ROPE); const float* rs = rc + 2049 * 32;
        const float cs = rc[2048 * 32 + d], sn = rs[2048 * 32 + d], sc = w ? 0.125f : 1.f;
        sq[w * 128 + hh * 64 + d] = (x1 * cs - x2 * sn) * sc; sq[w * 128 + hh * 64 + 32 + d] = (x1 * sn + x2 * cs) * sc;
    }
    __syncthreads();
#pragma unroll
    for (int hh = 0; hh < 2; ++hh) {
        const int h = 2 * g + hh;
        const float gh = 1.f - exp2f(-5.f - (float)h);
        const int v4 = (tid & 31) * 4, kr = tid >> 5;
        float vv[4]; unpack4(*(const u32x2*)(prow + PC_V + h * 128 + v4), vv);
        const float* S0 = p.in[4] + ((size_t)(l * NS + s) * 4 + h) * 8192; float* S1 = p.out + O_RS + ((size_t)(l * NS + s) * 4 + h) * 8192;
        f32x4 part = {0.f, 0.f, 0.f, 0.f};
#pragma unroll
        for (int ps = 0; ps < 4; ++ps) {
            const int k = ps * 16 + kr;
            const float kk = sq[128 + hh * 64 + k], qq = sq[hh * 64 + k];
            const f32x4 s0 = ret0[hh][ps];
            f32x4 sn; sn[0] = gh * s0[0] + kk * vv[0]; sn[1] = gh * s0[1] + kk * vv[1]; sn[2] = gh * s0[2] + kk * vv[2]; sn[3] = gh * s0[3] + kk * vv[3];
            __builtin_nontemporal_store(sn, (f32x4*)(S1 + k * 128 + v4));
            part = part + sn * qq;
        }
#pragma unroll
        for (int i = 0; i < 4; ++i) part[i] += shfl_xor_(part[i], 32, lane);
        if (lane < 32) *(LAS f32x4*)(ro + wid * 128 + v4) = part;
        __syncthreads();
        if (tid < 128) {
            float o = 0.f;
#pragma unroll
            for (int w = 0; w < 8; ++w) o += ro[w * 128 + tid];
            float ssq = wave_sum(o * o, lane);
            ro[1024 + tid] = o; if (lane == 0) ro[1152 + wid] = ssq;
        }
        __syncthreads();
        if (tid < 128) {
            const float rstd = rsqrtf((ro[1152] + ro[1153]) * (1.f / 128.f) + EPS);
            const float o = ro[1024 + tid];
            mix[t * DMIX + 512 + h * 128 + tid] = f2bf(siluf_(bf2f(prow[PC_RG + h * 128 + tid])) * (o * rstd * p.in[17][l * 512 + h * 128 + tid]));
        }
        __syncthreads();
    }
    if (tid < 256) {
        const int ch = 256 * g + tid;
        const float* cw = p.in[10] + (size_t)l * 4 * 512; const float* st = p.in[2] + (size_t)(l * NS + s) * 3 * 512;
        const float cur = bf2f(prow[PC_LX + ch]);
        const float s0 = st[ch], s1 = st[512 + ch], s2 = st[1024 + ch];
        sxc[tid] = p.in[11][l * 512 + ch] + cw[ch] * s0 + cw[512 + ch] * s1 + cw[1024 + ch] * s2 + cw[1536 + ch] * cur;
        float* so = p.out + O_LCS + (size_t)(l * NS + s) * 3 * 512;
        so[ch] = s1; so[512 + ch] = s2; so[1024 + ch] = cur;
    }
    __syncthreads();
    if (tid < 256) {
        const int j = tid & 63, hl = tid >> 6, h = 4 * g + hl, ch = h * 64 + j;
        const float* wr = p.in[12] + (size_t)(l * 8 + h) * 4096; const float* wi = p.in[14] + (size_t)(l * 8 + h) * 4096;
        float r = 0.f, ig = 0.f;
        for (int i = 0; i < 64; ++i) { const float xv = sxc[hl * 64 + i]; r += xv * wr[i * 64 + j]; ig += xv * wi[i * 64 + j]; }
        r = sigmoidf_(r + p.in[13][l * 512 + ch]); ig = sigmoidf_(ig + p.in[15][l * 512 + ch]);
        const float sp = log1pf(fexp_(-p.in[16][l * 512 + ch]));
        const float la = -8.f * r * sp, a = fexp_(la);
        const float hn = a * p.in[3][(size_t)(l * NS + s) * 512 + ch] + __builtin_amdgcn_sqrtf(fmaxf(-expm1f(2.f * la), 0.f)) * ig * sxc[tid];
        p.out[O_LHS + (size_t)(l * NS + s) * 512 + ch] = hn;
        mix[t * DMIX + ch] = f2bf(hn * geluf_(bf2f(prow[PC_LG + ch])));
    }
    __syncthreads();
}

#ifndef ITMASK
#define ITMASK 0xFF
#endif
#define IT_EN(x) (((ITMASK) >> (x)) & 1)
#ifndef REP_ITEM
#define REP_ITEM 0
#endif
__device__ void phase_m1(const Params& p, LAS unsigned char* lds, int l) {
    for (int rr = 0; rr < 1 + ((REP_ITEM >> 0) & 1); ++rr) { if (IT_EN(0)) for (int it = blockIdx.x; it < 256; it += gridDim.x) ret_m1(p, lds, it >> 5, it & 31); }
    for (int rr = 0; rr < 1 + ((REP_ITEM >> 1) & 1); ++rr) { if (IT_EN(1)) for (int it = blockIdx.x; it < 256; it += gridDim.x) ssd_m1(p, lds, l, it >> 5, it & 31); }
    for (int rr = 0; rr < 1 + ((REP_ITEM >> 2) & 1); ++rr) { if (IT_EN(2)) for (int it = blockIdx.x; it < 256; it += gridDim.x) lru_item<1>(p, lds, l, it >> 5, it & 31); }
    for (int rr = 0; rr < 1 + ((REP_ITEM >> 3) & 1); ++rr) { if (IT_EN(3)) for (int it = blockIdx.x; it < 256; it += gridDim.x) sample_item(p, lds, l, it >> 1, it & 1); }
    const bf16_t* proj = (const bf16_t*)(p.ws + W_PROJ);
    const int gt = blockIdx.x * 512 + TIDX, gn = gridDim.x * 512;
    for (int u = gt; u < NB * 3 * 1536; u += gn) {
        const int b = u / (3 * 1536), r = u % (3 * 1536), k = r / 1536, cc = r % 1536;
        const size_t row = (size_t)b * SEQ + SEQ - 3 + k;
        if (cc < 512) p.out[O_LCP + ((size_t)(l * NB + b) * 3 + k) * 512 + cc] = bf2f(proj[row * NPROJ + PC_LX + cc]);
        else p.out[O_SCP + ((size_t)(l * NB + b) * 3 + k) * 1024 + cc - 512] = bf2f(proj[row * NPROJ + PC_XBC + cc - 512]);
    }
}
__device__ void phase_m2(const Params& p, LAS unsigned char* lds, int l) {
    for (int rr = 0; rr < 1 + ((REP_ITEM >> 4) & 1); ++rr) { if (IT_EN(4)) for (int it = blockIdx.x; it < 512; it += gridDim.x) ret_m2(p, lds, l, it >> 6, (it >> 1) & 31, it & 1); }
    for (int rr = 0; rr < 1 + ((REP_ITEM >> 5) & 1); ++rr) { if (IT_EN(5)) for (int it = blockIdx.x; it < 512; it += gridDim.x) ssd_m2(p, lds, l, it >> 6, (it >> 1) & 31, it & 1); }
    for (int rr = 0; rr < 1 + ((REP_ITEM >> 6) & 1); ++rr) { if (IT_EN(6)) for (int it = blockIdx.x; it < 256; it += gridDim.x) lru_item<2>(p, lds, l, it >> 5, it & 31); }
}


#define XB_TMO      128
#define XB_XCNT(j)  (256  + 64 * (j))
#define XB_XSUB(j)  (1280 + 64 * (j))
#define XB_XGEN(j)  (2304 + 64 * (j))
#define XB_TOP      3328
#define XB_TOPGEN   3392
#define XCD_BAR_WORDS 3456
#define XB_SPIN_CAP (1u << 22)
__device__ __forceinline__ unsigned xb_ld(unsigned* p)              { return __hip_atomic_load(p, __ATOMIC_RELAXED, __HIP_MEMORY_SCOPE_AGENT); }
__device__ __forceinline__ unsigned xb_add(unsigned* p, unsigned v) { return __hip_atomic_fetch_add(p, v, __ATOMIC_RELAXED, __HIP_MEMORY_SCOPE_AGENT); }
__device__ __forceinline__ unsigned xb_xcc_id() { return (unsigned)__builtin_amdgcn_s_getreg((3 << 11) | 20) & 0xFu; }
#define XB_SPIN(cond, bar) do { unsigned _sp = 0; while (cond) { __builtin_amdgcn_s_sleep(1); \
    if ((++_sp & 255u) == 0u) { if (xb_ld(&(bar)[XB_TMO])) break; if (_sp > XB_SPIN_CAP) { atomicAdd(&(bar)[XB_TMO], 1u); break; } } } } while (0)
struct XcdBarrier { unsigned* bar; unsigned x; volatile LAS unsigned* st; };
__device__ __forceinline__ XcdBarrier xcd_barrier_post(unsigned* bar, volatile LAS unsigned* st) {
    XcdBarrier b; b.bar = bar; b.x = xb_xcc_id(); b.st = st;
    if (threadIdx.x == 0) (void)xb_add(&bar[XB_XCNT(b.x)], 1u);
    return b;
}
__device__ __forceinline__ void xcd_barrier_complete(unsigned* bar, unsigned x, unsigned& nloc, unsigned& nx) {
    const unsigned G = gridDim.x * gridDim.y * gridDim.z;
    unsigned sum, cnt, mine, sp = 0u;
    for (;;) {
        sum = 0u; cnt = 0u; mine = 0u;
#pragma unroll
        for (unsigned j = 0; j < 16; ++j) { const unsigned c = xb_ld(&bar[XB_XCNT(j)]); sum += c; cnt += (c > 0u) ? 1u : 0u; mine = (j == x) ? c : mine; }
        if (sum == G) break;
        __builtin_amdgcn_s_sleep(1);
        if ((++sp & 255u) == 0u) { if (xb_ld(&bar[XB_TMO])) break; if (sp > XB_SPIN_CAP) { atomicAdd(&bar[XB_TMO], 1u); break; } }
    }
    nloc = mine > 0u ? mine : 1u; nx = cnt > 0u ? cnt : 1u;
}
__device__ __forceinline__ void xcd_barrier(const XcdBarrier& b) {
    asm volatile("s_waitcnt vmcnt(0)" ::: "memory");
    __syncthreads();
    if (threadIdx.x == 0) {
        unsigned* bar = b.bar;
        __builtin_amdgcn_s_waitcnt(0);
        unsigned nloc = b.st[0], nx = b.st[1];
        if (nloc == 0u) { xcd_barrier_complete(bar, b.x, nloc, nx); b.st[0] = nloc; b.st[1] = nx; }
        const unsigned old = xb_add(&bar[XB_XSUB(b.x)], 1u);
        const unsigned gen = old / nloc;
        if (old + 1u == (gen + 1u) * nloc) {
            __builtin_amdgcn_fence(__ATOMIC_RELEASE, "agent");
            asm volatile("s_waitcnt vmcnt(0)" ::: "memory");
            const unsigned og = xb_add(&bar[XB_TOP], 1u);
            const unsigned tg = og / nx;
            if (og + 1u == (tg + 1u) * nx) xb_add(&bar[XB_TOPGEN], 1u);
            else XB_SPIN(xb_ld(&bar[XB_TOPGEN]) == tg, bar);
            __builtin_amdgcn_fence(__ATOMIC_ACQUIRE, "agent");
            xb_add(&bar[XB_XGEN(b.x)], 1u);
            asm volatile("s_waitcnt vmcnt(0)" ::: "memory");
        } else {
            XB_SPIN(xb_ld(&bar[XB_XGEN(b.x)]) == gen, bar);
            __builtin_amdgcn_fence(__ATOMIC_ACQUIRE, "agent");
            asm volatile("s_waitcnt vmcnt(0)" ::: "memory");
        }
    }
    __syncthreads();
}

constexpr int NPHASE = 2 + 7 * DEPTH;
#ifndef PHMASK
#define PHMASK 0xFFF
#endif
#define PH_EN(x) (((PHMASK) >> (x)) & 1)
__device__ __forceinline__ void run_phase(const Params& p, LAS unsigned char* lds, int ph) {
    if (ph == 0) { if (PH_EN(10)) phase_prep(p, lds); return; }
    if (ph == NPHASE - 1) { if (PH_EN(11)) phase_final(p); return; }
    const int l = (ph - 1) / 7, s = (ph - 1) % 7;
    bf16_t* mix = (bf16_t*)(p.ws + W_HB); bf16_t* xb = (bf16_t*)(p.ws + W_XB); bf16_t* big = (bf16_t*)(p.ws + W_PROJ); bf16_t* act = (bf16_t*)(p.ws + W_DS);
    u64* rss = (u64*)(p.ws + W_RSS);
    pg8::StaticOrder S;
    switch (s) {
    case 0: if (PH_EN(1)) {
        const bf16_t* W = (const bf16_t*)(p.ws + W_WIN) + (size_t)l * NPROJ * DM;
        const u64* r = rss + (size_t)(2 * l) * TT;
        S.init(TP, NPROJ, gridDim.x, blockIdx.x);
        pg8::gemm_phase(lds, pg8::Gemm{xb, W, TP, NPROJ, DM}, S, pg8::EpiBf16{big, NPROJ, r});
        phase_dt(p, l);
        thin_gemm<DM, 0>(lds, xb + (size_t)TP * DM, W, NPROJ, big + (size_t)TP * NPROJ, NPROJ, nullptr, (u64*)r + TP);
    } break;
    case 1: if (PH_EN(2)) phase_m1(p, lds, l); break;
    case 2: if (PH_EN(3)) phase_m15(p, l); break;
    case 3: if (PH_EN(4)) phase_m2(p, lds, l); break;
    case 4: if (PH_EN(5)) {
        const bf16_t* W = (const bf16_t*)(p.ws + W_WOUT) + (size_t)l * DM * DMIX;
        u64* r = rss + (size_t)(2 * l + 1) * TT;
        S.init(TP, DM, gridDim.x, blockIdx.x);
        pg8::gemm_phase(lds, pg8::Gemm{mix, W, TP, DM, DMIX}, S, pg8::EpiResid{DM, xb, r});
        thin_gemm<DMIX, 1>(lds, mix + (size_t)TP * DMIX, W, DM, nullptr, DM, xb + (size_t)TP * DM, r + TP);
    } break;
    case 5: if (PH_EN(7)) {
        const bf16_t* W = (const bf16_t*)(p.ws + W_WUP) + (size_t)l * DGU * DM;
        const u64* r = rss + (size_t)(2 * l + 1) * TT;
        const float* cw = p.in[27] + (size_t)l * 3 * DFF; const float* cb = p.in[28] + (size_t)l * DFF;
        S.init(TP, DGU, gridDim.x, blockIdx.x);
        pg8::gemm_phase(lds, pg8::Gemm{xb, W, TP, DGU, DM}, S, pg8::EpiAct{act, r, cw, cb, (bf16_t*)(p.ws + W_GS01), (bf16_t*)(p.ws + W_US01), (bf16_t*)(p.ws + W_GS23), p.out + O_FCP + (size_t)l * NB * 2 * DFF});
        thin_gemm_act(lds, xb + (size_t)TP * DM, W, r + TP, cw, cb, p.in[7] + (size_t)l * NS * 2 * DFF, p.out + O_FCS + (size_t)l * NS * 2 * DFF, act + (size_t)TP * DFF);
    } break;
    case 6: if (PH_EN(9)) {
        const bf16_t* W = (const bf16_t*)(p.ws + W_WDOWN) + (size_t)l * DM * DFF;
        u64* r = rss + (size_t)(2 * l + 2) * TT;
        S.init(TP, DM, gridDim.x, blockIdx.x);
        { pg8::Unit uu; for (int i = 0; S.next(i, uu); ++i) act_fixup(p, l, uu.pm); __threadfence(); __syncthreads(); }
        pg8::gemm_phase(lds, pg8::Gemm{act, W, TP, DM, DFF}, S, pg8::EpiResid{DM, xb, r});
        thin_gemm<DFF, 1>(lds, act + (size_t)TP * DFF, W, DM, nullptr, DM, xb + (size_t)TP * DM, r + TP);
    } break;
    }
}

__global__ void __launch_bounds__(512, 2) mega(Params p, int ph0, int ph1, int coop) {
    extern __shared__ __attribute__((aligned(16))) unsigned char shm[];
    LAS unsigned char* lds = (LAS unsigned char*)shm;
    cg::grid_group grid = cg::this_grid();
    volatile LAS unsigned* st = (volatile LAS unsigned*)(lds + LDS_BYTES);
    if (threadIdx.x < 4) st[threadIdx.x] = 0u;
    __syncthreads();
    XcdBarrier xb = xcd_barrier_post((unsigned*)(p.ws + W_BAR), st);
    for (int ph = ph0; ph < ph1; ++ph) {
        int reps = 1;
#ifdef REP_MASK
        { const int s = (ph == 0) ? 10 : (ph == NPHASE - 1 ? 11 : (ph - 1) % 7); if ((REP_MASK >> s) & 1) reps = 2; }
#endif
        for (int r = 0; r < reps; ++r) { run_phase(p, lds, ph); if (reps > 1) __syncthreads(); }
        if (coop && ph + 1 < ph1) {
            if (coop == 2) grid.sync();
            xcd_barrier(xb);
#ifdef REP_SYNC
            xcd_barrier(xb);
#endif
        }
    }
}

extern "C" void kernel_launch(void* const* d_in, const int* in_sizes, int n_in, void* d_out, int out_size, void* d_ws, size_t ws_size, hipStream_t stream) {
    static int grid_blocks = 0;
    if (!grid_blocks) {
        int dev = 0, cus = 0, per_cu = 0;
        hipGetDevice(&dev);
        hipDeviceGetAttribute(&cus, hipDeviceAttributeMultiprocessorCount, dev);
        hipFuncSetAttribute((const void*)mega, hipFuncAttributeMaxDynamicSharedMemorySize, LDS_BYTES + 16);
        hipOccupancyMaxActiveBlocksPerMultiprocessor(&per_cu, (const void*)mega, 512, LDS_BYTES + 16);
        if (per_cu < 1) per_cu = 1;
        grid_blocks = cus * per_cu;
        if (grid_blocks > 256) grid_blocks = 256;
        if (ws_size < W_END) fprintf(stderr, "kernel_launch: workspace too small: %zu < %zu\n", ws_size, (size_t)W_END);
    }
    Params p{};
    for (int i = 0; i < 31; ++i) p.in[i] = (const float*)d_in[i];
    p.out = (float*)d_out; p.ws = (unsigned char*)d_ws;
    hipMemsetAsync((unsigned char*)d_ws + W_BAR, 0, XCD_BAR_WORDS * 4, stream);
    int ph0 = 0, ph1 = NPHASE, coop = 1;
    void* args[] = {&p, &ph0, &ph1, &coop};
    hipError_t e = hipLaunchCooperativeKernel((const void*)mega, dim3(grid_blocks), dim3(512), args, LDS_BYTES + 16, stream);
    if (e != hipSuccess) fprintf(stderr, "cooperative launch failed: %s (grid %d)\n", hipGetErrorString(e), grid_blocks);
}
```

```cpp
#include <hip/hip_runtime.h>
#include <hip/hip_cooperative_groups.h>
#include <cstdio>
namespace cg = cooperative_groups;

#define LAS __attribute__((address_space(3)))
typedef unsigned short bf16_t;
typedef short bf16x8 __attribute__((ext_vector_type(8)));
typedef short s16x4 __attribute__((ext_vector_type(4)));
typedef float f32x4 __attribute__((ext_vector_type(4)));
typedef float f32x2 __attribute__((ext_vector_type(2)));
typedef unsigned u32x4 __attribute__((ext_vector_type(4)));
typedef unsigned u32x2 __attribute__((ext_vector_type(2)));

constexpr int DM = 1024, NB = 8, SEQ = 2048, DEPTH = 4, NS = 128;
constexpr int TP = NB * SEQ;
constexpr int TT = TP + NS;
constexpr int DLRU = 512, DIN = 4104, NPROJ = 4096, DMIX = 1536, DFF = 2816, DGU = 5632;
constexpr int NCH = 32;
constexpr float EPS = 1e-6f;
constexpr int PC_LX = 0, PC_LG = 512, PC_Q = 1024, PC_K = 1280, PC_V = 1536, PC_RG = 2048, PC_Z = 2560, PC_XBC = 3072;

constexpr size_t O_Y = 0;
constexpr size_t O_LCP = (size_t)TT * DM;
constexpr size_t O_LCS = O_LCP + (size_t)DEPTH * NB * 3 * 512;
constexpr size_t O_LHP = O_LCS + (size_t)DEPTH * NS * 3 * 512;
constexpr size_t O_LHS = O_LHP + (size_t)DEPTH * NB * 512;
constexpr size_t O_RP = O_LHS + (size_t)DEPTH * NS * 512;
constexpr size_t O_RS = O_RP + (size_t)DEPTH * NB * 4 * 64 * 128;
constexpr size_t O_SCP = O_RS + (size_t)DEPTH * NS * 4 * 64 * 128;
constexpr size_t O_SCS = O_SCP + (size_t)DEPTH * NB * 3 * 1024;
constexpr size_t O_SP = O_SCS + (size_t)DEPTH * NS * 3 * 1024;
constexpr size_t O_SS = O_SP + (size_t)DEPTH * NB * 8 * 64 * 128;
constexpr size_t O_FCP = O_SS + (size_t)DEPTH * NS * 8 * 64 * 128;
constexpr size_t O_FCS = O_FCP + (size_t)DEPTH * NB * 2 * DFF;

constexpr size_t W_WIN = 0;
constexpr size_t W_WOUT = W_WIN + (size_t)DEPTH * NPROJ * DM * 2;
constexpr size_t W_WUP = W_WOUT + (size_t)DEPTH * DM * DMIX * 2;
constexpr size_t W_WDOWN = W_WUP + (size_t)DEPTH * DGU * DM * 2;
constexpr size_t W_LRUW = W_WDOWN + (size_t)DEPTH * DM * DFF * 2;
constexpr size_t W_ROPE = W_LRUW + (size_t)2 * DEPTH * 8 * 64 * 64 * 2;
constexpr size_t W_DT = W_ROPE + 524800;
constexpr size_t W_LRUAB = W_DT + (size_t)TT * 8 * 4;
constexpr size_t W_LRUHIN = W_LRUAB + (size_t)NB * NCH * 512 * 2 * 4;
constexpr size_t W_DEC = W_LRUHIN + (size_t)NB * NCH * 512 * 4;
constexpr size_t W_RSS = W_DEC + 8192;
constexpr size_t W_WDT = W_RSS + (size_t)9 * TT * 8;
constexpr size_t W_HB = W_WDT + (size_t)DEPTH * 16 * DM * 2;
constexpr size_t W_XB = W_HB + (size_t)TT * DMIX * 2;
constexpr size_t W_PROJ = W_XB + (size_t)TT * DM * 2;
constexpr size_t W_SPR = W_PROJ + (size_t)TT * NPROJ * 2;
constexpr size_t W_SPS = W_SPR + (size_t)NB * 4 * NCH * 8192 * 2;
static_assert(W_SPS + (size_t)NB * 8 * NCH * 8192 * 2 <= W_PROJ + (size_t)TT * DGU * 2, "Sp does not fit behind proj");
constexpr size_t W_DS = W_PROJ + (size_t)TT * DGU * 2;
constexpr size_t W_DSSSD = W_DS + (size_t)NB * 4 * NCH * 8192 * 4;
constexpr size_t W_BAR = W_DSSSD + (size_t)NB * 8 * NCH * 8192 * 4;
constexpr size_t W_GS01 = W_BAR + 16384;
constexpr size_t W_US01 = W_GS01 + (size_t)256 * 2 * DFF * 2;
constexpr size_t W_GS23 = W_US01 + (size_t)256 * 2 * DFF * 2;
constexpr size_t W_END = W_GS23 + (size_t)256 * 2 * DFF * 2;
static_assert(W_END <= (size_t)512 * 1024 * 1024, "workspace budget");
constexpr int LDS_BYTES = 131072;

struct Params { const float* in[31]; float* out; unsigned char* ws; };

typedef unsigned long long u64;
__device__ __forceinline__ u64 ss_fix(float ss) { return (u64)(ss * 1048576.f + 0.5f); }
__device__ __forceinline__ float rstd_fix(u64 v) { return rsqrtf((float)v * (1.f / (1048576.f * 1024.f)) + 1e-6f); }
__device__ __forceinline__ int opaque_tid() { int t = threadIdx.x; asm volatile("" : "+v"(t)); return t; }
#define TIDX opaque_tid()
__device__ __forceinline__ float bf2f(bf16_t v) { return __uint_as_float(((unsigned)v) << 16); }
__device__ __forceinline__ unsigned pk2(float lo, float hi) { unsigned r; asm volatile("v_cvt_pk_bf16_f32 %0, %1, %2" : "=v"(r) : "v"(lo), "v"(hi)); return r; }
__device__ __forceinline__ bf16_t f2bf(float f) { return (bf16_t)(pk2(f, 0.f) & 0xffffu); }
__device__ __forceinline__ void unpack8(u32x4 w, float* f) {
    f[0] = __uint_as_float(w.x << 16); f[1] = __uint_as_float(w.x & 0xffff0000u);
    f[2] = __uint_as_float(w.y << 16); f[3] = __uint_as_float(w.y & 0xffff0000u);
    f[4] = __uint_as_float(w.z << 16); f[5] = __uint_as_float(w.z & 0xffff0000u);
    f[6] = __uint_as_float(w.w << 16); f[7] = __uint_as_float(w.w & 0xffff0000u);
}
__device__ __forceinline__ void unpack4(u32x2 w, float* f) {
    f[0] = __uint_as_float(w.x << 16); f[1] = __uint_as_float(w.x & 0xffff0000u);
    f[2] = __uint_as_float(w.y << 16); f[3] = __uint_as_float(w.y & 0xffff0000u);
}
__device__ __forceinline__ u32x4 pack8(const float* f) { u32x4 w; w.x = pk2(f[0], f[1]); w.y = pk2(f[2], f[3]); w.z = pk2(f[4], f[5]); w.w = pk2(f[6], f[7]); return w; }
__device__ __forceinline__ float fexp_(float x) { return __builtin_amdgcn_exp2f(x * 1.44269504089f); }
__device__ __forceinline__ float sigmoidf_(float x) { return __builtin_amdgcn_rcpf(1.f + fexp_(-x)); }
__device__ __forceinline__ float siluf_(float x) { return x * __builtin_amdgcn_rcpf(1.f + fexp_(-x)); }
__device__ __forceinline__ float geluf_(float x) { const float z = x * __builtin_fmaf(x * x, 0.1029432397f, 2.302208198f); const float r = __builtin_amdgcn_rcpf(1.f + __builtin_amdgcn_exp2f(z)); return __builtin_fmaf(-x, r, x); }
__device__ __forceinline__ float softplusf_(float x) { return x > 20.f ? x : log1pf(fexp_(x)); }
__device__ __forceinline__ float shfl_idx(float v, int src) { return __int_as_float(__builtin_amdgcn_ds_bpermute(src << 2, __float_as_int(v))); }
__device__ __forceinline__ float shfl_xor_(float v, int o, int lane) { return shfl_idx(v, lane ^ o); }
__device__ __forceinline__ float shfl_up_(float v, int o, int lane) { return shfl_idx(v, (lane - o) & 63); }
__device__ __forceinline__ float wave_sum(float v, int lane) {
#pragma unroll
    for (int o = 32; o >= 1; o >>= 1) v += shfl_xor_(v, o, lane);
    return v;
}
template <int N> __device__ __forceinline__ float dpp_shr(float old, float src) { return __int_as_float(__builtin_amdgcn_update_dpp(__float_as_int(old), __float_as_int(src), 0x110 + N, 0xf, 0xf, false)); }
template <int N> __device__ __forceinline__ float dpp_ror(float src) { return __int_as_float(__builtin_amdgcn_update_dpp(0, __float_as_int(src), 0x120 + N, 0xf, 0xf, false)); }
__device__ __forceinline__ bf16x8 frag_row(const LAS bf16_t* t, int ld, int r0, int k0, int fr, int fq) {
    return *(const LAS bf16x8*)(t + (r0 + fr) * ld + k0 + 8 * fq);
}
__device__ __forceinline__ bf16x8 frag_tr(const LAS bf16_t* t, int ld, int k0, int c0, int fr, int fq) {
    const LAS bf16_t* p = t + (k0 + 8 * fq + (fr >> 2)) * ld + c0 + 4 * (fr & 3);
    s16x4 lo = __builtin_bit_cast(s16x4, __builtin_amdgcn_ds_read_tr16_b64_v4i16((LAS s16x4*)p));
    s16x4 hi = __builtin_bit_cast(s16x4, __builtin_amdgcn_ds_read_tr16_b64_v4i16((LAS s16x4*)(p + 4 * ld)));
    bf16x8 r; r[0] = lo[0]; r[1] = lo[1]; r[2] = lo[2]; r[3] = lo[3]; r[4] = hi[0]; r[5] = hi[1]; r[6] = hi[2]; r[7] = hi[3]; return r;
}
#define MFMA(X, Y, C) __builtin_amdgcn_mfma_f32_16x16x32_bf16((X), (Y), (C), 0, 0, 0)

namespace pg8 {
constexpr int BM = 256, BK = 64, HALF = 128, HTB = HALF * BK * 2, NXCD = 8, WGM = 8;
__device__ __forceinline__ int lds_byte(int r, int c) { const int st = (r >> 4) * 2 + (c >> 5), rr = r & 15, cc = c & 31, ob = rr * 64 + cc * 2; return st * 1024 + (ob ^ (((ob >> 9) & 1) << 5)); }
__device__ __forceinline__ void stage_rc(int b, int& R, int& C) { const int st = b / 1024, sb = b % 1024, swz = sb ^ (((sb >> 9) & 1) << 5); R = (st >> 1) * 16 + swz / 64; C = (st & 1) * 32 + (swz % 64) / 2; }
__device__ __forceinline__ int perm32(int rho) { const int n = rho >> 4, i = rho & 15; return 8 * (i >> 2) + 4 * n + (i & 3); }
struct Unit { int pm, pn; };
struct Gemm { const bf16_t* A; const bf16_t* Bt; int M, N, K; };
struct StaticOrder {
    int nM, nN, nwg, G, c;
    __device__ void init(int M, int N, int G_, int c_) { nM = M / BM; nN = N / BM; nwg = nM * nN; G = G_; c = c_; }
    __device__ bool next(int i, Unit& u) const {
        const long L = (long)i * G + c; if (L >= nwg) return false;
        int wgid = (int)L; { const int q = nwg / NXCD, r = nwg % NXCD, xcd = wgid % NXCD, off = wgid / NXCD; wgid = (xcd < r ? xcd * (q + 1) : r * (q + 1) + (xcd - r) * q) + off; }
        const int nig = WGM * nN, gid = wgid / nig, fm = gid * WGM, gsz = (nM - fm) < WGM ? (nM - fm) : WGM;
        u.pm = fm + ((wgid % nig) % gsz); u.pn = (wgid % nig) / gsz; return true;
    }
};
template <class Epi>
__device__ __forceinline__ void gemm_phase(LAS unsigned char* lds, const Gemm g, const StaticOrder& S, const Epi& E) {
    const int tid = TIDX, wid = __builtin_amdgcn_readfirstlane(tid >> 6), lane = tid & 63, wr = wid >> 2, wc = wid & 3, fr = lane & 15, fq = lane >> 4;
    const int K = g.K, nt = K / BK;
    unsigned voffA[2], voffB[2];
#pragma unroll
    for (int i = 0; i < 2; ++i) { int R, C; stage_rc(tid * 16 + i * 8192, R, C); const int Rb = Epi::PERM ? ((R & ~31) + perm32(R & 31)) : R;
        voffA[i] = (unsigned)(R * K + C) * 2u; voffB[i] = (unsigned)(Rb * K + C) * 2u; }
    const size_t kstep = (size_t)(BK * 2);
    const size_t hstep = (size_t)HALF * K * 2;
    const size_t tstep = 2 * hstep;
    const unsigned ldsw = (unsigned)wid * 1024u;
    const int aoff = lds_byte(wr * 64 + fr, fq * 8), boff = lds_byte(wc * 32 + fr, fq * 8);
#define PG8_SA(b, h) (((b) * 2 + (h)) * HTB)
#define PG8_SB(b, h) ((4 + (b) * 2 + (h)) * HTB)
#define PG8_STAGE(bufoff, gbase, voff) do { _Pragma("unroll") for (int _i = 0; _i < 2; ++_i) \
        __builtin_amdgcn_global_load_lds((const unsigned*)((const char*)(gbase) + (voff)[_i]), (LAS unsigned*)(lds + (bufoff) + ldsw + _i * 8192), 16, 0, 0); } while (0)
#define PG8_LDA(dst, b, h) do { _Pragma("unroll") for (int m = 0; m < 4; ++m) _Pragma("unroll") for (int k = 0; k < 2; ++k) dst[m][k] = *(const LAS bf16x8*)(lds + PG8_SA(b, h) + aoff + m * 2048 + k * 1024); } while (0)
#define PG8_LDB(dst, b, h) do { _Pragma("unroll") for (int n = 0; n < 2; ++n) _Pragma("unroll") for (int k = 0; k < 2; ++k) dst[n][k] = *(const LAS bf16x8*)(lds + PG8_SB(b, h) + boff + n * 2048 + k * 1024); } while (0)
#define PG8_MMA(ai, bj, At, Bt) do { __builtin_amdgcn_s_setprio(1); _Pragma("unroll") for (int m = 0; m < 4; ++m) _Pragma("unroll") for (int n = 0; n < 2; ++n) _Pragma("unroll") for (int k = 0; k < 2; ++k) \
        acc[ai][bj][m][n] = __builtin_amdgcn_mfma_f32_16x16x32_bf16(Bt[n][k], At[m][k], acc[ai][bj][m][n], 0, 0, 0); __builtin_amdgcn_s_setprio(0); } while (0)
#define PG8_WAIT_V(n) asm volatile("s_waitcnt vmcnt(" #n ")" ::: "memory")
#define PG8_WAIT_L(n) asm volatile("s_waitcnt lgkmcnt(" #n ")" ::: "memory")
#define PG8_BAR __builtin_amdgcn_s_barrier()
#define PG8_SCHED __builtin_amdgcn_sched_barrier(0)
    Unit cur, nxt; int ui = 0;
    if (!S.next(0, cur)) return;
    f32x4 acc[2][2][4][2];
#pragma unroll
    for (int a = 0; a < 2; ++a)
#pragma unroll
        for (int b = 0; b < 2; ++b)
#pragma unroll
            for (int m = 0; m < 4; ++m)
#pragma unroll
                for (int n = 0; n < 2; ++n) acc[a][b][m][n] = (f32x4){0.f, 0.f, 0.f, 0.f};
    bf16x8 At[4][2], B0[2][2], B1[2][2];
    const char* cA = (const char*)g.A + (size_t)cur.pm * tstep; const char* cB = (const char*)g.Bt + (size_t)cur.pn * tstep;
    PG8_STAGE(PG8_SB(0, 0), cB, voffB); PG8_STAGE(PG8_SA(0, 0), cA, voffA); PG8_STAGE(PG8_SB(0, 1), cB + hstep, voffB); PG8_STAGE(PG8_SA(0, 1), cA + hstep, voffA);
    if (wr == 1) PG8_BAR;
    PG8_WAIT_V(4); PG8_BAR;
    PG8_STAGE(PG8_SB(1, 0), cB + kstep, voffB); PG8_STAGE(PG8_SA(1, 0), cA + kstep, voffA); PG8_STAGE(PG8_SB(1, 1), cB + hstep + kstep, voffB);
    PG8_WAIT_V(6); PG8_BAR;
    for (;;) {
        const bool has_next = S.next(ui + 1, nxt);
        const char* nA = has_next ? (const char*)g.A + (size_t)nxt.pm * tstep : cA; const char* nB = has_next ? (const char*)g.Bt + (size_t)nxt.pn * tstep : cB;
        for (int t = 0; t < nt; t += 2) {
            const bool last = (t == nt - 2);
            const char* a1 = cA + (size_t)(t + 1) * kstep;
            const char* a2 = last ? nA : cA + (size_t)(t + 2) * kstep; const char* b2 = last ? nB : cB + (size_t)(t + 2) * kstep;
            const char* a3 = a2 + kstep; const char* b3 = b2 + kstep;
            PG8_LDB(B0, 0, 0); PG8_SCHED; PG8_LDA(At, 0, 0); PG8_STAGE(PG8_SA(1, 1), a1 + hstep, voffA);
            PG8_WAIT_L(8); PG8_BAR; PG8_WAIT_L(0); PG8_MMA(0, 0, At, B0); PG8_BAR; PG8_SCHED;
            PG8_LDB(B1, 0, 1); PG8_STAGE(PG8_SB(0, 0), b2, voffB);
            PG8_BAR; PG8_WAIT_L(0); PG8_MMA(0, 1, At, B1); PG8_BAR;
            PG8_LDA(At, 0, 1); PG8_STAGE(PG8_SA(0, 0), a2, voffA);
            PG8_BAR; PG8_WAIT_L(0); PG8_MMA(1, 0, At, B0); PG8_BAR; PG8_SCHED;
            PG8_STAGE(PG8_SB(0, 1), b2 + hstep, voffB);
            PG8_WAIT_V(6); PG8_BAR; PG8_MMA(1, 1, At, B1); PG8_BAR;
            PG8_LDB(B0, 1, 0); PG8_SCHED; PG8_LDA(At, 1, 0); PG8_STAGE(PG8_SA(0, 1), a2 + hstep, voffA);
            PG8_WAIT_L(8); PG8_BAR; PG8_WAIT_L(0); PG8_MMA(0, 0, At, B0); PG8_BAR; PG8_SCHED;
            PG8_LDB(B1, 1, 1); PG8_STAGE(PG8_SB(1, 0), b3, voffB);
            PG8_BAR; PG8_WAIT_L(0); PG8_MMA(0, 1, At, B1); PG8_BAR;
            PG8_LDA(At, 1, 1); PG8_STAGE(PG8_SA(1, 0), a3, voffA);
            PG8_BAR; PG8_WAIT_L(0); PG8_MMA(1, 0, At, B0); PG8_BAR; PG8_SCHED;
            PG8_STAGE(PG8_SB(1, 1), b3 + hstep, voffB);
            PG8_WAIT_V(6); PG8_BAR; PG8_MMA(1, 1, At, B1); PG8_BAR;
        }
        if constexpr (Epi::AFTER_DRAIN) { if (has_next) E(acc, cur, wr, wc, fr, fq); } else E(acc, cur, wr, wc, fr, fq);
        if (!has_next) break;
#pragma unroll
        for (int a = 0; a < 2; ++a)
#pragma unroll
            for (int b = 0; b < 2; ++b)
#pragma unroll
                for (int m = 0; m < 4; ++m)
#pragma unroll
                    for (int n = 0; n < 2; ++n) acc[a][b][m][n] = (f32x4){0.f, 0.f, 0.f, 0.f};
        cur = nxt; cA = nA; cB = nB; ++ui;
    }
    PG8_WAIT_V(0);
    if (wr == 0) PG8_BAR;
    PG8_BAR;
    if constexpr (Epi::AFTER_DRAIN) E.fused(acc, cur, wr, wc, fr, fq, lds, wid, lane);
#undef PG8_SA
#undef PG8_SB
#undef PG8_STAGE
#undef PG8_LDA
#undef PG8_LDB
#undef PG8_MMA
#undef PG8_WAIT_V
#undef PG8_WAIT_L
#undef PG8_BAR
#undef PG8_SCHED
}
struct EpiBf16 {
    static constexpr bool PERM = true, AFTER_DRAIN = false;
    bf16_t* O; int ldc; const u64* rss;
    __device__ __forceinline__ void operator()(const f32x4 (&acc)[2][2][4][2], const Unit& u, int wr, int wc, int fr, int fq) const {
        const int row0 = u.pm * BM + wr * 64 + fr, col0 = u.pn * BM + wc * 32 + 8 * fq;
        u64 rv[2][4];
#pragma unroll
        for (int ai = 0; ai < 2; ++ai)
#pragma unroll
            for (int m = 0; m < 4; ++m) rv[ai][m] = rss[row0 + ai * HALF + m * 16];
#pragma unroll
        for (int ai = 0; ai < 2; ++ai)
#pragma unroll
            for (int m = 0; m < 4; ++m) { const int row = row0 + ai * HALF + m * 16; bf16_t* rowp = O + (size_t)row * ldc + col0;
                const float rs = rstd_fix(rv[ai][m]);
#pragma unroll
                for (int bj = 0; bj < 2; ++bj) { const f32x4 v0 = acc[ai][bj][m][0] * rs, v1 = acc[ai][bj][m][1] * rs;
                    u32x4 w; w.x = pk2(v0[0], v0[1]); w.y = pk2(v0[2], v0[3]); w.z = pk2(v1[0], v1[1]); w.w = pk2(v1[2], v1[3]);
                    *(u32x4*)(rowp + bj * HALF) = w; } }
    }
};
struct EpiResid {
    static constexpr bool PERM = false, AFTER_DRAIN = true;
    int ldc; bf16_t* xb; u64* rss;
    __device__ __forceinline__ void operator()(const f32x4 (&acc)[2][2][4][2], const Unit& u, int wr, int wc, int fr, int fq) const {
        const int row0 = u.pm * BM + wr * 64 + fr, col0 = u.pn * BM + wc * 32 + 4 * fq, lane = fr | (fq << 4);
#pragma unroll
        for (int ai = 0; ai < 2; ++ai)
#pragma unroll
            for (int m = 0; m < 4; ++m) { const int row = row0 + ai * HALF + m * 16; bf16_t* xbp = xb + (size_t)row * ldc + col0;
                float ss = 0.f;
#pragma unroll
                for (int bj = 0; bj < 2; ++bj)
#pragma unroll
                    for (int n = 0; n < 2; ++n) { u32x2* pp = (u32x2*)(xbp + bj * HALF + n * 16); float o[4]; unpack4(*pp, o);
                        u32x2 w; w.x = pk2(o[0] + acc[ai][bj][m][n][0], o[1] + acc[ai][bj][m][n][1]); w.y = pk2(o[2] + acc[ai][bj][m][n][2], o[3] + acc[ai][bj][m][n][3]); *pp = w;
                        unpack4(w, o); ss += o[0] * o[0] + o[1] * o[1] + o[2] * o[2] + o[3] * o[3]; }
                ss += shfl_xor_(ss, 16, lane); ss += shfl_xor_(ss, 32, lane);
                if (fq == 0) atomicAdd(rss + row, ss_fix(ss)); }
    }
    __device__ __forceinline__ void fused(const f32x4 (&acc)[2][2][4][2], const Unit& u, int wr, int wc, int fr, int fq, LAS unsigned char* lds, int wid, int lane) const {
        LAS f32x4* t = (LAS f32x4*)lds;
#pragma unroll
        for (int ai = 0; ai < 2; ++ai) {
            const int rbase = u.pm * BM + ai * HALF + wid * 16, col = u.pn * BM + lane * 4;
            u32x2 xv[16];
#pragma unroll
            for (int i = 0; i < 16; ++i) xv[i] = *(const u32x2*)(xb + (size_t)(rbase + i) * ldc + col);
#pragma unroll
            for (int m = 0; m < 4; ++m)
#pragma unroll
                for (int bj = 0; bj < 2; ++bj)
#pragma unroll
                    for (int n = 0; n < 2; ++n) { const int r = 64 * wr + 16 * m + fr, chunk = 32 * bj + 8 * wc + 4 * n + fq; t[r * 64 + (chunk ^ (r & 15))] = acc[ai][bj][m][n]; }
            __syncthreads();
            float myss = 0.f;
#pragma unroll
            for (int i = 0; i < 16; ++i) { const int r = wid * 16 + i;
                const f32x4 a = t[r * 64 + (lane ^ (r & 15))]; float o[4]; unpack4(xv[i], o);
                u32x2 w; w.x = pk2(o[0] + a[0], o[1] + a[1]); w.y = pk2(o[2] + a[2], o[3] + a[3]); *(u32x2*)(xb + (size_t)(rbase + i) * ldc + col) = w;
                unpack4(w, o);
                const float ss = wave_sum(o[0] * o[0] + o[1] * o[1] + o[2] * o[2] + o[3] * o[3], lane);
                if (lane == i) myss = ss; }
            if (lane < 16) atomicAdd(rss + rbase + lane, ss_fix(myss));
            __syncthreads();
        }
    }
};
struct EpiAct {
    static constexpr bool PERM = true, AFTER_DRAIN = false;
    bf16_t* act; const u64* rss; const float* cw; const float* cb; bf16_t* gs01; bf16_t* us01; bf16_t* gs23; float* fcp;
    __device__ __forceinline__ void operator()(const f32x4 (&acc)[2][2][4][2], const Unit& u, int wr, int wc, int fr, int fq) const {
        const int row0 = u.pm * BM + wr * 64 + fr, f0 = u.pn * HALF + wc * 32 + 8 * fq;
        float w0[8], w1[8], w2[8], bb[8];
        *(f32x4*)w0 = *(const f32x4*)(cw + f0); *(f32x4*)(w0 + 4) = *(const f32x4*)(cw + f0 + 4);
        *(f32x4*)w1 = *(const f32x4*)(cw + DFF + f0); *(f32x4*)(w1 + 4) = *(const f32x4*)(cw + DFF + f0 + 4);
        *(f32x4*)w2 = *(const f32x4*)(cw + 2 * DFF + f0); *(f32x4*)(w2 + 4) = *(const f32x4*)(cw + 2 * DFF + f0 + 4);
        *(f32x4*)bb = *(const f32x4*)(cb + f0); *(f32x4*)(bb + 4) = *(const f32x4*)(cb + f0 + 4);
        u64 rv[2][4];
#pragma unroll
        for (int ai = 0; ai < 2; ++ai)
#pragma unroll
            for (int m = 0; m < 4; ++m) rv[ai][m] = rss[row0 + ai * HALF + m * 16];
#pragma unroll
        for (int ai = 0; ai < 2; ++ai) {
            float gp[8];
#pragma unroll
            for (int e = 0; e < 8; ++e) gp[e] = 0.f;
#pragma unroll
            for (int m = 0; m < 4; ++m) {
                const int row = row0 + ai * HALF + m * 16;
                const float rs = rstd_fix(rv[ai][m]);
                float g[8], up[8], o[8];
                { const f32x4 g0 = acc[ai][0][m][0] * rs, g1 = acc[ai][0][m][1] * rs, u0 = acc[ai][1][m][0] * rs, u1 = acc[ai][1][m][1] * rs;
#pragma unroll
                  for (int i = 0; i < 4; ++i) { g[i] = g0[i]; g[4 + i] = g1[i]; up[i] = u0[i]; up[4 + i] = u1[i]; } }
#pragma unroll
                for (int e2 = 0; e2 < 4; ++e2) {
                    const int e = 2 * e2;
                    const f32x2 gv = {g[e], g[e + 1]};
                    const f32x2 g1v = {dpp_shr<1>(dpp_ror<1>(gp[e]), g[e]), dpp_shr<1>(dpp_ror<1>(gp[e + 1]), g[e + 1])};
                    const f32x2 g2v = {dpp_shr<2>(dpp_ror<2>(gp[e]), g[e]), dpp_shr<2>(dpp_ror<2>(gp[e + 1]), g[e + 1])};
                    const f32x2 w0v = {w0[e], w0[e + 1]}, w1v = {w1[e], w1[e + 1]}, w2v = {w2[e], w2[e + 1]}, bbv = {bb[e], bb[e + 1]}, upv = {up[e], up[e + 1]};
                    const f32x2 y = __builtin_elementwise_fma(w0v, g2v, __builtin_elementwise_fma(w1v, g1v, __builtin_elementwise_fma(w2v, gv, bbv)));
                    const f32x2 z = y * __builtin_elementwise_fma(y * y, (f32x2){0.1029432397f, 0.1029432397f}, (f32x2){2.302208198f, 2.302208198f});
                    f32x2 d; d.x = __builtin_amdgcn_exp2f(z.x); d.y = __builtin_amdgcn_exp2f(z.y);
                    d = d + 1.0f;
                    f32x2 r; r.x = __builtin_amdgcn_rcpf(d.x); r.y = __builtin_amdgcn_rcpf(d.y);
                    const f32x2 ov = __builtin_elementwise_fma(-y, r, y) * upv;
                    o[e] = ov.x; o[e + 1] = ov.y;
                }
                if (m == 0 && fr < 2) {
                    const size_t so = ((size_t)(row >> 6) * 2 + fr) * DFF + f0;
                    *(u32x4*)(gs01 + so) = pack8(g); *(u32x4*)(us01 + so) = pack8(up);
                } else *(u32x4*)(act + (size_t)row * DFF + f0) = pack8(o);
                if (m == 3 && fr >= 14) *(u32x4*)(gs23 + ((size_t)(row >> 6) * 2 + (fr - 14)) * DFF + f0) = pack8(g);
                const int ts = row & (SEQ - 1);
                if (ts >= SEQ - 2) { float* fo = fcp + ((size_t)(row >> 11) * 2 + (ts - (SEQ - 2))) * DFF + f0;
                    *(f32x4*)fo = (f32x4){g[0], g[1], g[2], g[3]}; *(f32x4*)(fo + 4) = (f32x4){g[4], g[5], g[6], g[7]}; }
#pragma unroll
                for (int e = 0; e < 8; ++e) gp[e] = g[e];
            }
        }
    }
};
struct EpiDry {
    static constexpr bool PERM = false, AFTER_DRAIN = false;
    float* C;
    __device__ __forceinline__ void operator()(const f32x4 (&acc)[2][2][4][2], const Unit& u, int wr, int wc, int fr, int fq) const {
        float s = 0.f;
#pragma unroll
        for (int ai = 0; ai < 2; ++ai)
#pragma unroll
            for (int bj = 0; bj < 2; ++bj)
#pragma unroll
                for (int m = 0; m < 4; ++m)
#pragma unroll
                    for (int n = 0; n < 2; ++n) s += acc[ai][bj][m][n][0] + acc[ai][bj][m][n][1] + acc[ai][bj][m][n][2] + acc[ai][bj][m][n][3];
        if (s != s) C[0] = s;
    }
};
}

template <int K, int MODE  >
__device__ __forceinline__ void thin_gemm(LAS unsigned char* lds, const bf16_t* A, const bf16_t* Bt, int N, void* out, int ldc, bf16_t* xb, u64* rss) {
    const int tid = TIDX, wid = tid >> 6, lane = tid & 63, fr = lane & 15, fq = lane >> 4;
    constexpr int KW = K / 8, STEPS = KW / 32;
    const int ntask = (N / 16) * 8;
    LAS f32x4* red = (LAS f32x4*)lds;
    const int per = (ntask + (int)gridDim.x - 1) / (int)gridDim.x, t0 = blockIdx.x * per, t1 = min(ntask, t0 + per);
    for (int base = t0; base < t1; base += 8) {
        const int nr = min(8, t1 - base);
#pragma unroll (STEPS <= 4 ? 4 : 2)
        for (int i = 0; i < nr; ++i) {
            const int t = base + i, ct = t >> 3, rt = t & 7;
            const bf16_t* ap = A + (size_t)(rt * 16 + fr) * K + wid * KW + 8 * fq;
            const bf16_t* bp = Bt + (size_t)(ct * 16 + fr) * K + wid * KW + 8 * fq;
            bf16x8 a[STEPS], b[STEPS];
#pragma unroll
            for (int s = 0; s < STEPS; ++s) { a[s] = *(const bf16x8*)(ap + 32 * s); b[s] = *(const bf16x8*)(bp + 32 * s); }
            f32x4 acc = {0.f, 0.f, 0.f, 0.f};
#pragma unroll
            for (int s = 0; s < STEPS; ++s) acc = MFMA(b[s], a[s], acc);
            red[(i * 8 + wid) * 64 + lane] = acc;
        }
        __syncthreads();
        if (wid < nr) {
            const int t = base + wid, ct = t >> 3, rt = t & 7;
            f32x4 s = red[(wid * 8) * 64 + lane];
#pragma unroll
            for (int w = 1; w < 8; ++w) s = s + red[(wid * 8 + w) * 64 + lane];
            const int row = rt * 16 + fr, col = ct * 16 + 4 * fq;
            if (MODE == 0) { const float rs = rstd_fix(rss[row]);
                u32x2 w2; w2.x = pk2(s[0] * rs, s[1] * rs); w2.y = pk2(s[2] * rs, s[3] * rs); *(u32x2*)((bf16_t*)out + (size_t)row * ldc + col) = w2; }
            else { u32x2* pp = (u32x2*)(xb + (size_t)row * ldc + col); float o[4]; unpack4(*pp, o);
                u32x2 w2; w2.x = pk2(o[0] + s[0], o[1] + s[1]); w2.y = pk2(o[2] + s[2], o[3] + s[3]); *pp = w2;
                unpack4(w2, o);
                float ss = o[0] * o[0] + o[1] * o[1] + o[2] * o[2] + o[3] * o[3];
                ss += shfl_xor_(ss, 16, lane); ss += shfl_xor_(ss, 32, lane);
                if (fq == 0) atomicAdd(rss + row, ss_fix(ss)); }
        }
        __syncthreads();
    }
}

__device__ __forceinline__ void thin_gemm_act(LAS unsigned char* lds, const bf16_t* A, const bf16_t* Bt, const u64* rss, const float* cw, const float* cb, const float* st, float* fo, bf16_t* act) {
    const int tid = TIDX, wid = tid >> 6, lane = tid & 63, fr = lane & 15, fq = lane >> 4;
    constexpr int K = DM, KW = K / 8, STEPS = KW / 32;
    const int ntask = (DFF / 16) * 8;
    LAS f32x4* red = (LAS f32x4*)lds;
    const int per = (ntask + (int)gridDim.x - 1) / (int)gridDim.x, t0 = blockIdx.x * per, t1 = min(ntask, t0 + per);
    for (int base = t0; base < t1; base += 8) {
        const int nr = min(8, t1 - base);
#pragma unroll 2
        for (int i = 0; i < nr; ++i) {
            const int t = base + i, ft = t >> 3, rt = t & 7;
            const int f = ft * 16 + fr, wrow = 256 * (f >> 7) + (f & 127);
            const bf16_t* ap = A + (size_t)(rt * 16 + fr) * K + wid * KW + 8 * fq;
            const bf16_t* bg = Bt + (size_t)wrow * K + wid * KW + 8 * fq;
            const bf16_t* bu = bg + (size_t)128 * K;
            bf16x8 a[STEPS], b1[STEPS], b2[STEPS];
#pragma unroll
            for (int s = 0; s < STEPS; ++s) { a[s] = *(const bf16x8*)(ap + 32 * s); b1[s] = *(const bf16x8*)(bg + 32 * s); b2[s] = *(const bf16x8*)(bu + 32 * s); }
            f32x4 ag = {0.f, 0.f, 0.f, 0.f}, au = {0.f, 0.f, 0.f, 0.f};
#pragma unroll
            for (int s = 0; s < STEPS; ++s) { ag = MFMA(b1[s], a[s], ag); au = MFMA(b2[s], a[s], au); }
            red[(i * 8 + wid) * 64 + lane] = ag; red[4096 + (i * 8 + wid) * 64 + lane] = au;
        }
        __syncthreads();
        if (wid < nr) {
            const int t = base + wid, ft = t >> 3, rt = t & 7;
            f32x4 g = red[(wid * 8) * 64 + lane], up = red[4096 + (wid * 8) * 64 + lane];
#pragma unroll
            for (int w = 1; w < 8; ++w) { g = g + red[(wid * 8 + w) * 64 + lane]; up = up + red[4096 + (wid * 8 + w) * 64 + lane]; }
            const int s = rt * 16 + fr, f = ft * 16 + 4 * fq;
            const float rs = rstd_fix(rss[s]);
            g = g * rs; up = up * rs;
            const f32x4 p0 = *(const f32x4*)(st + ((size_t)s * 2 + 0) * DFF + f), p1 = *(const f32x4*)(st + ((size_t)s * 2 + 1) * DFF + f);
            const f32x4 c0 = *(const f32x4*)(cw + f), c1 = *(const f32x4*)(cw + DFF + f), c2 = *(const f32x4*)(cw + 2 * DFF + f), cbv = *(const f32x4*)(cb + f);
            float o[4];
#pragma unroll
            for (int e = 0; e < 4; ++e) o[e] = geluf_(cbv[e] + c0[e] * p0[e] + c1[e] * p1[e] + c2[e] * g[e]) * up[e];
            u32x2 w2; w2.x = pk2(o[0], o[1]); w2.y = pk2(o[2], o[3]); *(u32x2*)(act + (size_t)s * DFF + f) = w2;
            *(f32x4*)(fo + ((size_t)s * 2 + 0) * DFF + f) = p1; *(f32x4*)(fo + ((size_t)s * 2 + 1) * DFF + f) = g;
        }
        __syncthreads();
    }
}
__device__ __forceinline__ void act_fixup(const Params& p, int l, int pm) {
    const bf16_t* gs01 = (const bf16_t*)(p.ws + W_GS01); const bf16_t* us01 = (const bf16_t*)(p.ws + W_US01); const bf16_t* gs23 = (const bf16_t*)(p.ws + W_GS23);
    bf16_t* act = (bf16_t*)(p.ws + W_DS);
    const float* cw = p.in[27] + (size_t)l * 3 * DFF; const float* cb = p.in[28] + (size_t)l * DFF;
    const int tid = TIDX;
    constexpr int NU = 8 * (DFF / 8), NK = (NU + 511) / 512;
    u32x4 rg[NK], ru[NK], r1[NK], r2[NK];
#pragma unroll
    for (int k = 0; k < NK; ++k) {
        const int idx = tid + 512 * k;
        rg[k] = ru[k] = r1[k] = r2[k] = (u32x4){0u, 0u, 0u, 0u};
        if (idx < NU) {
            const int rsel = idx / (DFF / 8), c0 = (idx % (DFF / 8)) * 8, blk = pm * 4 + (rsel >> 1), rr = rsel & 1;
            const bool seq0 = (blk & 31) == 0;
            rg[k] = *(const u32x4*)(gs01 + ((size_t)blk * 2 + rr) * DFF + c0);
            ru[k] = *(const u32x4*)(us01 + ((size_t)blk * 2 + rr) * DFF + c0);
            if (rr == 0) { if (!seq0) { r1[k] = *(const u32x4*)(gs23 + ((size_t)(blk - 1) * 2 + 1) * DFF + c0); r2[k] = *(const u32x4*)(gs23 + ((size_t)(blk - 1) * 2 + 0) * DFF + c0); } }
            else { r1[k] = *(const u32x4*)(gs01 + ((size_t)blk * 2 + 0) * DFF + c0); if (!seq0) r2[k] = *(const u32x4*)(gs23 + ((size_t)(blk - 1) * 2 + 1) * DFF + c0); }
        }
    }
#pragma unroll
    for (int k = 0; k < NK; ++k) {
        const int idx = tid + 512 * k;
        if (idx < NU) {
            const int rsel = idx / (DFF / 8), c0 = (idx % (DFF / 8)) * 8, blk = pm * 4 + (rsel >> 1), rr = rsel & 1;
            float g[8], up[8], g1[8], g2[8], o[8];
            unpack8(rg[k], g); unpack8(ru[k], up); unpack8(r1[k], g1); unpack8(r2[k], g2);
#pragma unroll
            for (int e = 0; e < 8; ++e) o[e] = geluf_(cb[c0 + e] + cw[c0 + e] * g2[e] + cw[DFF + c0 + e] * g1[e] + cw[2 * DFF + c0 + e] * g[e]) * up[e];
            *(u32x4*)(act + ((size_t)blk * 64 + rr) * DFF + c0) = pack8(o);
        }
    }
}

__device__ void phase_prep(const Params& p, LAS unsigned char* lds) {
    const int tid = TIDX;
    LAS float* tl = (LAS float*)lds;
    for (int grp = blockIdx.x; grp < DEPTH * 3520 / 4; grp += gridDim.x) {
        const float* src[4]; bf16_t* dst[4]; int Ks[4], ldns[4]; const float* gs[4];
        f32x4 v[4][2];
#pragma unroll
        for (int q = 0; q < 4; ++q) {
            const int idx = grp * 4 + q;
            const int l = idx / 3520; int r = idx % 3520;
            int kt, nt;
            if (r < 1024) { gs[q] = p.in[8] + l * DM; src[q] = p.in[9] + (size_t)l * DM * DIN; ldns[q] = DIN; Ks[q] = DM; dst[q] = (bf16_t*)(p.ws + W_WIN) + (size_t)l * NPROJ * DM; nt = r % 64; kt = r / 64; }
            else if (r < 1408) { r -= 1024; gs[q] = nullptr; src[q] = p.in[24] + (size_t)l * DMIX * DM; ldns[q] = DM; Ks[q] = DMIX; dst[q] = (bf16_t*)(p.ws + W_WOUT) + (size_t)l * DM * DMIX; nt = r % 16; kt = r / 16; }
            else if (r < 2816) { r -= 1408; gs[q] = p.in[25] + l * DM; src[q] = p.in[26] + (size_t)l * DM * DGU; ldns[q] = DGU; Ks[q] = DM; dst[q] = (bf16_t*)(p.ws + W_WUP) + (size_t)l * DGU * DM; nt = r % 88; kt = r / 88; }
            else { r -= 2816; gs[q] = nullptr; src[q] = p.in[29] + (size_t)l * DFF * DM; ldns[q] = DM; Ks[q] = DFF; dst[q] = (bf16_t*)(p.ws + W_WDOWN) + (size_t)l * DM * DFF; nt = r % 16; kt = r / 16; }
            int drow = nt * 64;
            if (ldns[q] == DGU) { const int f = drow < DFF ? drow : drow - DFF; drow = 256 * (f >> 7) + (f & 127) + (drow < DFF ? 0 : 128); }
            src[q] += (size_t)(kt * 64) * ldns[q] + nt * 64; dst[q] += (size_t)drow * Ks[q] + kt * 64;
#pragma unroll
            for (int ps = 0; ps < 2; ++ps) { v[q][ps] = __builtin_nontemporal_load((const f32x4*)(src[q] + (size_t)((tid >> 4) + ps * 32) * ldns[q] + (tid & 15) * 4)); if (gs[q]) v[q][ps] = v[q][ps] * gs[q][kt * 64 + (tid >> 4) + ps * 32]; }
        }
#pragma unroll
        for (int q = 0; q < 4; ++q)
#pragma unroll
            for (int ps = 0; ps < 2; ++ps) { LAS float* t = tl + q * 4160 + ((tid >> 4) + ps * 32) * 65 + (tid & 15) * 4; t[0] = v[q][ps][0]; t[1] = v[q][ps][1]; t[2] = v[q][ps][2]; t[3] = v[q][ps][3]; }
        __syncthreads();
#pragma unroll
        for (int q = 0; q < 4; ++q) {
            const int n = tid >> 3, kq = tid & 7;
            float f[8];
#pragma unroll
            for (int e = 0; e < 8; ++e) f[e] = tl[q * 4160 + (8 * kq + e) * 65 + n];
            *(u32x4*)(dst[q] + (size_t)n * Ks[q] + 8 * kq) = pack8(f);
        }
        __syncthreads();
    }
    const int gt = blockIdx.x * 512 + tid, gn = gridDim.x * 512;
    {
        bf16_t* wrT = (bf16_t*)(p.ws + W_LRUW); bf16_t* wiT = wrT + DEPTH * 8 * 64 * 64;
        for (int i = gt; i < DEPTH * 8 * 64 * 64; i += gn) {
            const int lh = i >> 12, j = (i >> 6) & 63, ii = i & 63;
            wrT[i] = f2bf(p.in[12][(size_t)lh * 4096 + ii * 64 + j]);
            wiT[i] = f2bf(p.in[14][(size_t)lh * 4096 + ii * 64 + j]);
        }
    }
    {
        float* rc = (float*)(p.ws + W_ROPE); float* rs = rc + 2049 * 32;
        for (int i = gt; i < 2049 * 32; i += gn) {
            const int pos = (i >> 5) < 2048 ? (i >> 5) : 16384; const int d = i & 31;
            const float freq = powf(10000.f, -(float)d / 32.f);
            const float ang = (float)pos * freq;
            rc[i] = cosf(ang); rs[i] = sinf(ang);
        }
    }
    {
        bf16_t* wdt = (bf16_t*)(p.ws + W_WDT);
        for (int i = gt; i < DEPTH * 16 * DM; i += gn) {
            const int l = i >> 14, j = (i >> 10) & 15, k = i & 1023;
            wdt[i] = j < 8 ? f2bf(p.in[8][l * DM + k] * p.in[9][((size_t)l * DM + k) * DIN + NPROJ + j]) : (bf16_t)0;
        }
    }
    {
        u64* rss = (u64*)(p.ws + W_RSS);
        for (int i = gt; i < 8 * TT; i += gn) rss[TT + i] = 0ull;
    }
    {
        const int wid = tid >> 6, lane = tid & 63;
        bf16_t* xb = (bf16_t*)(p.ws + W_XB); u64* rss = (u64*)(p.ws + W_RSS);
        const int nw = gridDim.x * 8;
        for (int row0 = blockIdx.x * 8 + wid; row0 < TT; row0 += 4 * nw) {
            f32x4 v[4][4];
#pragma unroll
            for (int r = 0; r < 4; ++r) { const int row = row0 + r * nw; const float* src = row < TP ? p.in[0] + (size_t)row * DM : p.in[1] + (size_t)(row - TP) * DM;
#pragma unroll
                for (int i = 0; i < 4; ++i) v[r][i] = row < TT ? __builtin_nontemporal_load((const f32x4*)(src + i * 256 + lane * 4)) : (f32x4){0.f, 0.f, 0.f, 0.f}; }
#pragma unroll
            for (int r = 0; r < 4; ++r) { const int row = row0 + r * nw; float ss = 0.f;
                if (row < TT) {
#pragma unroll
                    for (int i = 0; i < 4; ++i) { u32x2 w; w.x = pk2(v[r][i][0], v[r][i][1]); w.y = pk2(v[r][i][2], v[r][i][3]); *(u32x2*)(xb + (size_t)row * DM + i * 256 + lane * 4) = w;
                        float o[4]; unpack4(w, o); ss += o[0] * o[0] + o[1] * o[1] + o[2] * o[2] + o[3] * o[3]; }
                }
                ss = wave_sum(ss, lane);
                if (lane == 0 && row < TT) rss[row] = ss_fix(ss);
            }
        }
    }
}

__device__ void phase_dt(const Params& p, int l) {
    const int tid = TIDX, wid = tid >> 6, lane = tid & 63, fr = lane & 15, fq = lane >> 4;
    const bf16_t* xb = (const bf16_t*)(p.ws + W_XB); const bf16_t* wdt = (const bf16_t*)(p.ws + W_WDT) + (size_t)l * 16 * DM;
    const u64* rss = (const u64*)(p.ws + W_RSS) + (size_t)(2 * l) * TT; float* dtraw = (float*)(p.ws + W_DT);
    for (int tile = blockIdx.x * 8 + wid; tile < TT / 16; tile += gridDim.x * 8) {
        const bf16_t* ap = xb + (size_t)(tile * 16 + fr) * DM + 8 * fq; const bf16_t* bp = wdt + (size_t)fr * DM + 8 * fq;
        f32x4 acc = {0.f, 0.f, 0.f, 0.f};
#pragma unroll 16
        for (int s = 0; s < 32; ++s) acc = MFMA(*(const bf16x8*)(bp + 32 * s), *(const bf16x8*)(ap + 32 * s), acc);
        const int row = tile * 16 + fr;
        if (fq < 2) { const float rs = rstd_fix(rss[row]); *(f32x4*)(dtraw + (size_t)row * 8 + 4 * fq) = acc * rs; }
    }
}

__device__ void phase_final(const Params& p) {
    const int tid = TIDX, wid = tid >> 6, lane = tid & 63;
    const bf16_t* xb = (const bf16_t*)(p.ws + W_XB);
    const float* g = p.in[30];
    f32x4 g4[4];
#pragma unroll
    for (int i = 0; i < 4; ++i) g4[i] = *(const f32x4*)(g + i * 256 + lane * 4);
    const int nw = gridDim.x * 8;
    for (int row0 = blockIdx.x * 8 + wid; row0 < TT; row0 += 4 * nw) {
        u32x2 raw[4][4];
#pragma unroll
        for (int r = 0; r < 4; ++r) { const int row = row0 + r * nw;
#pragma unroll
            for (int i = 0; i < 4; ++i) raw[r][i] = row < TT ? *(const u32x2*)(xb + (size_t)row * DM + i * 256 + lane * 4) : (u32x2){0u, 0u}; }
#pragma unroll
        for (int r = 0; r < 4; ++r) { const int row = row0 + r * nw;
            f32x4 v[4]; float ss = 0.f;
#pragma unroll
            for (int i = 0; i < 4; ++i) { float o[4]; unpack4(raw[r][i], o); v[i] = (f32x4){o[0], o[1], o[2], o[3]}; ss += o[0] * o[0] + o[1] * o[1] + o[2] * o[2] + o[3] * o[3]; }
            ss = wave_sum(ss, lane);
            const float rstd = rsqrtf(ss * (1.f / DM) + EPS);
            if (row < TT) {
#pragma unroll
                for (int i = 0; i < 4; ++i) __builtin_nontemporal_store(v[i] * rstd * g4[i], (f32x4*)(p.out + (size_t)row * DM + i * 256 + lane * 4));
            }
        }
    }
}


__device__ __forceinline__ float ret_logg(int h) { return log1pf(-exp2f(-5.f - (float)h)); }

template <class CM, class F>
__device__ __forceinline__ void conv64(const bf16_t* proj, int row0, int tseq0, int pc0, const float* cw, const float* cb, int C, int nchunks, CM&& chmap, F&& emit) {
    for (int u = TIDX; u < nchunks * 8; u += 512) {
        const int q = u % nchunks, seg = u / nchunks, c = chmap(q), j0 = seg * 8;
        const bf16_t* src = proj + (size_t)(row0 + j0) * NPROJ + pc0 + c;
        u32x4 raw[11];
        if (tseq0 + j0 == 0) { raw[0] = (u32x4){0u, 0u, 0u, 0u}; raw[1] = raw[0]; raw[2] = raw[0]; }
        else { raw[0] = *(const u32x4*)(src - 3 * NPROJ); raw[1] = *(const u32x4*)(src - 2 * NPROJ); raw[2] = *(const u32x4*)(src - NPROJ); }
#pragma unroll
        for (int j = 0; j < 8; ++j) raw[3 + j] = *(const u32x4*)(src + (size_t)j * NPROJ);
        float w0[8], w1[8], w2[8], w3[8], bb[8];
#pragma unroll
        for (int e = 0; e < 8; ++e) { w0[e] = cw[c + e]; w1[e] = cw[C + c + e]; w2[e] = cw[2 * C + c + e]; w3[e] = cw[3 * C + c + e]; bb[e] = cb[c + e]; }
        float h3[8], h2[8], h1[8];
        unpack8(raw[0], h3); unpack8(raw[1], h2); unpack8(raw[2], h1);
#pragma unroll
        for (int j = 0; j < 8; ++j) {
            float cur[8], y[8];
            unpack8(raw[3 + j], cur);
#pragma unroll
            for (int e = 0; e < 8; ++e) y[e] = bb[e] + w0[e] * h3[e] + w1[e] * h2[e] + w2[e] * h1[e] + w3[e] * cur[e];
            emit(j0 + j, q, c, y);
#pragma unroll
            for (int e = 0; e < 8; ++e) { h3[e] = h2[e]; h2[e] = h1[e]; h1[e] = cur[e]; }
        }
    }
}

__device__ __forceinline__ void rot16(const bf16_t* src, const float* rc, const float* rs, float scale, LAS bf16_t* dst) {
    float x1[16], x2[16], o1[16], o2[16];
    unpack8(*(const u32x4*)src, x1); unpack8(*(const u32x4*)(src + 8), x1 + 8);
    unpack8(*(const u32x4*)(src + 32), x2); unpack8(*(const u32x4*)(src + 40), x2 + 8);
#pragma unroll
    for (int e = 0; e < 16; ++e) { const float c = rc[e], s = rs[e]; o1[e] = (x1[e] * c - x2[e] * s) * scale; o2[e] = (x1[e] * s + x2[e] * c) * scale; }
    *(LAS u32x4*)dst = pack8(o1); *(LAS u32x4*)(dst + 8) = pack8(o1 + 8);
    *(LAS u32x4*)(dst + 32) = pack8(o2); *(LAS u32x4*)(dst + 40) = pack8(o2 + 8);
}

__device__ void ret_m1(const Params& p, LAS unsigned char* lds, int b, int c) {
    const int tid = TIDX, wid = tid >> 6, lane = tid & 63, fr = lane & 15, fq = lane >> 4;
    const bf16_t* proj = (const bf16_t*)(p.ws + W_PROJ);
    const float* rc = (const float*)(p.ws + W_ROPE); const float* rs = rc + 2049 * 32;
    float* dS = (float*)(p.ws + W_DS);
    LAS bf16_t* Kt = (LAS bf16_t*)lds;
    LAS bf16_t* Vt = (LAS bf16_t*)(lds + 33792);
    const int row0 = b * SEQ + c * 64, pos0 = c * 64;
    {
        const int j = tid >> 3, sub = tid & 7, h = sub >> 1, d0 = (sub & 1) * 16;
        const float scale = 0.125f * fexp_((float)(63 - j) * ret_logg(h));
        rot16(proj + (size_t)(row0 + j) * NPROJ + PC_K + h * 64 + d0, rc + (pos0 + j) * 32 + d0, rs + (pos0 + j) * 32 + d0, scale, Kt + j * 264 + h * 64 + d0);
#pragma unroll
        for (int i = 0; i < 8; ++i) { const int id = tid + 512 * i, jj = id >> 6, cc = id & 63;
            *(LAS u32x4*)(Vt + jj * 520 + cc * 8) = *(const u32x4*)(proj + (size_t)(row0 + jj) * NPROJ + PC_V + cc * 8); }
    }
    __syncthreads();
    {
        const int h = wid >> 1, vh = wid & 1;
        bf16x8 X[4][2];
#pragma unroll
        for (int kt = 0; kt < 4; ++kt)
#pragma unroll
            for (int kk = 0; kk < 2; ++kk) X[kt][kk] = frag_tr(Kt, 264, kk * 32, h * 64 + kt * 16, fr, fq);
        float* out = dS + ((size_t)((b * 4 + h) * NCH + c)) * 8192;
#pragma unroll
        for (int vt = 0; vt < 4; ++vt) {
            bf16x8 Y[2];
#pragma unroll
            for (int kk = 0; kk < 2; ++kk) Y[kk] = frag_tr(Vt, 520, kk * 32, h * 128 + vh * 64 + vt * 16, fr, fq);
#pragma unroll
            for (int kt = 0; kt < 4; ++kt) {
                f32x4 a = {0.f, 0.f, 0.f, 0.f};
                a = MFMA(X[kt][0], Y[0], a); a = MFMA(X[kt][1], Y[1], a);
                *(f32x4*)(out + (vh * 64 + vt * 16 + fr) * 64 + kt * 16 + 4 * fq) = a;
            }
        }
    }
    __syncthreads();
}

template <int NH>
__device__ __forceinline__ void ssd_dt_cum(const Params& p, int l, int row0, int h0, LAS float* dtv, LAS float* cum) {
    const int tid = TIDX, hl = tid >> 6, j = tid & 63;
    const float* dtraw = (const float*)(p.ws + W_DT);
    if (hl < NH) {
        const int h = h0 + hl;
        const float dt = softplusf_(dtraw[(size_t)(row0 + j) * 8 + h] + p.in[20][l * 8 + h]);
        float v = -dt * fexp_(p.in[21][l * 8 + h]);
#pragma unroll
        for (int o = 1; o < 64; o <<= 1) { const float t = shfl_up_(v, o, j); if (j >= o) v += t; }
        dtv[hl * 64 + j] = dt; cum[hl * 64 + j] = v;
    }
    __syncthreads();
}

__device__ void ssd_m1(const Params& p, LAS unsigned char* lds, int l, int b, int c) {
    const int tid = TIDX, wid = tid >> 6, lane = tid & 63, fr = lane & 15, fq = lane >> 4;
    const bf16_t* proj = (const bf16_t*)(p.ws + W_PROJ);
    float* dS = (float*)(p.ws + W_DSSSD); float* dec = (float*)(p.ws + W_DEC);
    LAS bf16_t* Xs = (LAS bf16_t*)lds;
    LAS bf16_t* Bm = (LAS bf16_t*)(lds + 66560);
    LAS float* dtv = (LAS float*)(lds + 100352);
    LAS float* cum = dtv + 512;
    LAS float* wl = cum + 512;
    const int row0 = b * SEQ + c * 64;
    ssd_dt_cum<8>(p, l, row0, 0, dtv, cum);
    { const int h = tid >> 6, j = tid & 63; wl[tid] = fexp_(cum[h * 64 + 63] - cum[tid]) * dtv[tid]; if (j == 63) dec[(b * 8 + h) * NCH + c] = fexp_(cum[h * 64 + 63]); }
    __syncthreads();
    conv64(proj, row0, c * 64, PC_XBC, p.in[18] + (size_t)l * 4 * 1024, p.in[19] + l * 1024, 1024, 96, [](int q) { return q * 8; },
           [&](int j, int q, int ch, float* y) {
               float s[8];
               if (ch < 512) { const float w = wl[(ch >> 6) * 64 + j];
#pragma unroll
                   for (int e = 0; e < 8; ++e) s[e] = siluf_(y[e]) * w;
                   *(LAS u32x4*)(Xs + j * 520 + ch) = pack8(s);
               } else {
#pragma unroll
                   for (int e = 0; e < 8; ++e) s[e] = siluf_(y[e]);
                   *(LAS u32x4*)(Bm + j * 264 + ch - 512) = pack8(s);
               }
           });
    __syncthreads();
    {
        const int h = wid, g = h >> 2;
        bf16x8 Y[4][2];
#pragma unroll
        for (int pt = 0; pt < 4; ++pt)
#pragma unroll
            for (int kk = 0; kk < 2; ++kk) Y[pt][kk] = frag_tr(Xs, 520, kk * 32, h * 64 + pt * 16, fr, fq);
        float* out = dS + ((size_t)((b * 8 + h) * NCH + c)) * 8192;
#pragma unroll
        for (int nt = 0; nt < 8; ++nt) {
            bf16x8 X[2];
#pragma unroll
            for (int kk = 0; kk < 2; ++kk) X[kk] = frag_tr(Bm, 264, kk * 32, g * 128 + nt * 16, fr, fq);
#pragma unroll
            for (int pt = 0; pt < 4; ++pt) {
                f32x4 a = {0.f, 0.f, 0.f, 0.f};
                a = MFMA(X[0], Y[pt][0], a); a = MFMA(X[1], Y[pt][1], a);
                *(f32x4*)(out + (pt * 16 + fr) * 128 + nt * 16 + 4 * fq) = a;
            }
        }
    }
    __syncthreads();
}

template <int PASS>
__device__ void lru_item(const Params& p, LAS unsigned char* lds, int l, int b, int c) {
    const int tid = TIDX, wid = tid >> 6, lane = tid & 63, fr = lane & 15, fq = lane >> 4;
    const bf16_t* proj = (const bf16_t*)(p.ws + W_PROJ);
    LAS bf16_t* xc = (LAS bf16_t*)lds;
    const int row0 = b * SEQ + c * 64;
    const int h = wid;
    const bf16_t* wrT = (const bf16_t*)(p.ws + W_LRUW) + (size_t)(l * 8 + h) * 4096;
    const bf16_t* wiT = wrT + DEPTH * 8 * 4096;
    bf16x8 BrA[4][2], BiA[4][2]; float brA[4], biA[4], lamA[4], hinA[4];
#pragma unroll
    for (int n = 0; n < 4; ++n) {
#pragma unroll
        for (int kk = 0; kk < 2; ++kk) { BrA[n][kk] = *(const bf16x8*)(wrT + (n * 16 + fr) * 64 + kk * 32 + 8 * fq); BiA[n][kk] = *(const bf16x8*)(wiT + (n * 16 + fr) * 64 + kk * 32 + 8 * fq); }
        const int ch = h * 64 + n * 16 + fr;
        brA[n] = p.in[13][l * 512 + ch]; biA[n] = p.in[15][l * 512 + ch]; lamA[n] = p.in[16][l * 512 + ch];
        hinA[n] = PASS == 2 ? ((const float*)(p.ws + W_LRUHIN))[(size_t)(b * NCH + c) * 512 + ch] : 0.f;
    }
    conv64(proj, row0, c * 64, PC_LX, p.in[10] + (size_t)l * 4 * 512, p.in[11] + l * 512, 512, 64, [](int q) { return q * 8; },
           [&](int j, int q, int ch, float* y) { *(LAS u32x4*)(xc + j * 520 + ch) = pack8(y); });
    __syncthreads();
    float* lruAB = (float*)(p.ws + W_LRUAB); const float* hin = (const float*)(p.ws + W_LRUHIN);
    bf16_t* mix = (bf16_t*)(p.ws + W_HB);
#pragma unroll
    for (int n = 0; n < 4; ++n) {
        f32x4 ar[4], ai[4];
        {
            bf16x8 Af[4][2];
#pragma unroll
            for (int m = 0; m < 4; ++m)
#pragma unroll
                for (int kk = 0; kk < 2; ++kk) Af[m][kk] = frag_row(xc, 520, m * 16, h * 64 + kk * 32, fr, fq);
            bf16x8 Br[2], Bi[2];
#pragma unroll
            for (int kk = 0; kk < 2; ++kk) { Br[kk] = BrA[n][kk]; Bi[kk] = BiA[n][kk]; }
#pragma unroll
            for (int m = 0; m < 4; ++m) {
                f32x4 a = {0.f, 0.f, 0.f, 0.f}, bq = {0.f, 0.f, 0.f, 0.f};
                a = MFMA(Af[m][0], Br[0], a); a = MFMA(Af[m][1], Br[1], a);
                bq = MFMA(Af[m][0], Bi[0], bq); bq = MFMA(Af[m][1], Bi[1], bq);
                ar[m] = a; ai[m] = bq;
            }
        }
        const int ch = h * 64 + n * 16 + fr;
        const float br = brA[n], bi = biA[n];
        const float sp = log1pf(fexp_(-lamA[n]));
        const float nsp = -8.f * sp * 1.44269504089f;
#pragma unroll
        for (int m = 0; m < 4; ++m)
#pragma unroll
            for (int i = 0; i < 4; i += 2) {
                const int t = m * 16 + 4 * fq + i;
                const f32x2 xv = {bf2f(xc[t * 520 + ch]), bf2f(xc[(t + 1) * 520 + ch])};
                const f32x2 zr = ((f32x2){ar[m][i], ar[m][i + 1]} + br) * (-1.44269504089f), zi = ((f32x2){ai[m][i], ai[m][i + 1]} + bi) * (-1.44269504089f);
                f32x2 er, ei; er.x = __builtin_amdgcn_exp2f(zr.x); er.y = __builtin_amdgcn_exp2f(zr.y); ei.x = __builtin_amdgcn_exp2f(zi.x); ei.y = __builtin_amdgcn_exp2f(zi.y);
                er = er + 1.0f; ei = ei + 1.0f;
                f32x2 r, ig; r.x = __builtin_amdgcn_rcpf(er.x); r.y = __builtin_amdgcn_rcpf(er.y); ig.x = __builtin_amdgcn_rcpf(ei.x); ig.y = __builtin_amdgcn_rcpf(ei.y);
                const f32x2 l2 = r * nsp;
                f32x2 av; av.x = __builtin_amdgcn_exp2f(l2.x); av.y = __builtin_amdgcn_exp2f(l2.y);
                const f32x2 om = __builtin_elementwise_fma(-av, av, (f32x2){1.f, 1.f});
                f32x2 sq; sq.x = __builtin_amdgcn_sqrtf(fmaxf(om.x, 0.f)); sq.y = __builtin_amdgcn_sqrtf(fmaxf(om.y, 0.f));
                const f32x2 bv = sq * (ig * xv);
                ar[m][i] = av.x; ar[m][i + 1] = av.y; ai[m][i] = bv.x; ai[m][i + 1] = bv.y;
            }
        float carry = 0.f, Atot = 1.f;
        if (PASS == 2) carry = hinA[n];
#pragma unroll
        for (int m = 0; m < 4; ++m) {
            const float a0 = ar[m][0], a1 = ar[m][1], a2 = ar[m][2], a3 = ar[m][3];
            const float b0 = ai[m][0], b1 = ai[m][1], b2 = ai[m][2], b3 = ai[m][3];
            float Al = a0 * a1 * a2 * a3, Bl = ((b0 * a1 + b1) * a2 + b2) * a3 + b3;
            float Ap = shfl_up_(Al, 16, lane), Bp = shfl_up_(Bl, 16, lane);
            if (fq >= 1) { Bl = Bp * Al + Bl; Al = Ap * Al; }
            Ap = shfl_up_(Al, 32, lane); Bp = shfl_up_(Bl, 32, lane);
            if (fq >= 2) { Bl = Bp * Al + Bl; Al = Ap * Al; }
            float Aex = shfl_up_(Al, 16, lane), Bex = shfl_up_(Bl, 16, lane);
            if (fq == 0) { Aex = 1.f; Bex = 0.f; }
            const float At = shfl_idx(Al, fr + 48), Bt = shfl_idx(Bl, fr + 48);
            if (PASS == 2) {
                float hh = Aex * carry + Bex;
                hh = a0 * hh + b0; ai[m][0] = hh;
                hh = a1 * hh + b1; ai[m][1] = hh;
                hh = a2 * hh + b2; ai[m][2] = hh;
                hh = a3 * hh + b3; ai[m][3] = hh;
            }
            carry = At * carry + Bt; Atot *= At;
        }
        if (PASS == 1) {
            if (fq == 0) { f32x2 v = {Atot, carry}; *(f32x2*)(lruAB + ((size_t)(b * NCH + c) * 512 + ch) * 2) = v; }
        } else {
            bf16_t gv[4][4];
#pragma unroll
            for (int m = 0; m < 4; ++m)
#pragma unroll
                for (int i = 0; i < 4; ++i) gv[m][i] = proj[(size_t)(row0 + m * 16 + 4 * fq + i) * NPROJ + PC_LG + ch];
#pragma unroll
            for (int m = 0; m < 4; ++m)
#pragma unroll
                for (int i = 0; i < 4; ++i) {
                    const size_t t = row0 + m * 16 + 4 * fq + i;
                    mix[t * DMIX + ch] = f2bf(ai[m][i] * geluf_(bf2f(gv[m][i])));
                }
        }
    }
    __syncthreads();
}

__device__ void phase_m15(const Params& p, int l) {
    const int gt = blockIdx.x * 512 + TIDX, gn = gridDim.x * 512;
    const float* dSr = (const float*)(p.ws + W_DS); const float* dSs = (const float*)(p.ws + W_DSSSD); const float* dec = (const float*)(p.ws + W_DEC);
    bf16_t* spr = (bf16_t*)(p.ws + W_SPR); bf16_t* sps = (bf16_t*)(p.ws + W_SPS);
    for (int u = gt; u < (32 + 64) * 4096; u += gn) {
        float zz = 0.f; asm volatile("" : "+v"(zz));
        f32x2 S = {zz, zz};
        f32x2 tv[NCH];
        if (u < 32 * 4096) {
            const int bh = u >> 12, e2 = u & 4095, h = bh & 3;
            const float* ptr = dSr + (size_t)bh * NCH * 8192 + e2 * 2; bf16_t* sp = spr + (size_t)bh * NCH * 8192 + e2 * 2;
            const float d = fexp_(64.f * ret_logg(h));
#pragma unroll
            for (int c = 0; c < NCH; ++c) tv[c] = *(const f32x2*)(ptr + (size_t)c * 8192);
#pragma unroll
            for (int c = 0; c < NCH; ++c) { *(unsigned*)(sp + (size_t)c * 8192) = pk2(S[0], S[1]); S = S * d + tv[c]; }
            float* o = p.out + O_RP + ((size_t)(l * NB * 4 + bh)) * 8192;
#pragma unroll
            for (int i = 0; i < 2; ++i) { const int e = e2 * 2 + i, v = e >> 6, k = e & 63; o[k * 128 + v] = S[i]; }
        } else {
            const int uu = u - 32 * 4096, bh = uu >> 12, e2 = uu & 4095;
            const float* ptr = dSs + (size_t)bh * NCH * 8192 + e2 * 2; bf16_t* sp = sps + (size_t)bh * NCH * 8192 + e2 * 2;
            float dc[NCH];
#pragma unroll
            for (int c = 0; c < NCH; ++c) { tv[c] = *(const f32x2*)(ptr + (size_t)c * 8192); dc[c] = dec[bh * NCH + c]; }
#pragma unroll
            for (int c = 0; c < NCH; ++c) { *(unsigned*)(sp + (size_t)c * 8192) = pk2(S[0], S[1]); S = S * dc[c] + tv[c]; }
            *(f32x2*)(p.out + O_SP + ((size_t)(l * NB * 8 + bh)) * 8192 + e2 * 2) = S;
        }
    }
    const float* lruAB = (const float*)(p.ws + W_LRUAB); float* hin = (float*)(p.ws + W_LRUHIN);
    for (int u = gt; u < NB * 512; u += gn) {
        const int b = u >> 9, ch = u & 511; float h = 0.f;
        f32x2 ab[NCH];
#pragma unroll
        for (int c = 0; c < NCH; ++c) ab[c] = *(const f32x2*)(lruAB + ((size_t)(b * NCH + c) * 512 + ch) * 2);
#pragma unroll
        for (int c = 0; c < NCH; ++c) { hin[(size_t)(b * NCH + c) * 512 + ch] = h; h = ab[c][0] * h + ab[c][1]; }
        p.out[O_LHP + (size_t)(l * NB + b) * 512 + ch] = h;
    }
}

__device__ void ret_m2(const Params& p, LAS unsigned char* lds, int l, int b, int c, int hp) {
    const int tid = TIDX, wid = tid >> 6, lane = tid & 63, fr = lane & 15, fq = lane >> 4;
    const bf16_t* proj = (const bf16_t*)(p.ws + W_PROJ);
    const float* rc = (const float*)(p.ws + W_ROPE); const float* rs = rc + 2049 * 32;
    const bf16_t* sp = (const bf16_t*)(p.ws + W_SPR);
    bf16_t* mix = (bf16_t*)(p.ws + W_HB);
    const int row0 = b * SEQ + c * 64, pos0 = c * 64;
    constexpr int HB = 63488;
    {
        const int j = tid >> 3, sub = tid & 7, hh = sub >> 2, which = (sub >> 1) & 1, d0 = (sub & 1) * 16, h = 2 * hp + hh;
        LAS bf16_t* dst = (LAS bf16_t*)(lds + hh * HB + which * 9216) + j * 72 + d0;
        rot16(proj + (size_t)(row0 + j) * NPROJ + (which ? PC_K : PC_Q) + h * 64 + d0, rc + (pos0 + j) * 32 + d0, rs + (pos0 + j) * 32 + d0, which ? 0.125f : 1.f, dst);
#pragma unroll
        for (int i = 0; i < 4; ++i) { const int id = tid + 512 * i, h2 = id >> 10, jj = (id >> 4) & 63, cc = id & 15;
            *(LAS u32x4*)((LAS bf16_t*)(lds + h2 * HB + 18432) + jj * 136 + cc * 8) = *(const u32x4*)(proj + (size_t)(row0 + jj) * NPROJ + PC_V + (2 * hp + h2) * 128 + cc * 8); }
#pragma unroll
        for (int i = 0; i < 4; ++i) { const int id = tid + 512 * i, h2 = id >> 10, v = (id >> 3) & 127, kc = id & 7;
            *(LAS u32x4*)((LAS bf16_t*)(lds + h2 * HB + 35840) + v * 72 + kc * 8) = *(const u32x4*)(sp + ((size_t)((b * 4 + 2 * hp + h2) * NCH + c)) * 8192 + v * 64 + kc * 8); }
    }
    __syncthreads();
    const int hh = wid >> 2, it = wid & 3, i0 = it * 16, h = 2 * hp + hh;
    const float lg = ret_logg(h);
    LAS bf16_t* Q = (LAS bf16_t*)(lds + hh * HB); LAS bf16_t* Kk = Q + 64 * 72; LAS bf16_t* V = (LAS bf16_t*)(lds + hh * HB + 18432);
    LAS bf16_t* S = (LAS bf16_t*)(lds + hh * HB + 35840); LAS bf16_t* P = (LAS bf16_t*)(lds + hh * HB + 54272);
    bf16x8 Yq[2];
#pragma unroll
    for (int kk = 0; kk < 2; ++kk) Yq[kk] = frag_row(Q, 72, i0, kk * 32, fr, fq);
    const int irow = i0 + fr;
#pragma unroll
    for (int jt = 0; jt < 4; ++jt) {
        f32x4 sc = {0.f, 0.f, 0.f, 0.f};
#pragma unroll
        for (int kk = 0; kk < 2; ++kk) sc = MFMA(frag_row(Kk, 72, jt * 16, kk * 32, fr, fq), Yq[kk], sc);
        float v[4];
#pragma unroll
        for (int i = 0; i < 4; ++i) { const int j = jt * 16 + 4 * fq + i; v[i] = j <= irow ? sc[i] * fexp_((float)(irow - j) * lg) : 0.f; }
        u32x2 w; w.x = pk2(v[0], v[1]); w.y = pk2(v[2], v[3]);
        *(LAS u32x2*)(P + irow * 72 + jt * 16 + 4 * fq) = w;
    }
    __syncthreads();
    const size_t t = row0 + irow;
    u32x2 rgv[8]; f32x4 ngv[8];
#pragma unroll
    for (int vt = 0; vt < 8; ++vt) { rgv[vt] = *(const u32x2*)(proj + t * NPROJ + PC_RG + h * 128 + vt * 16 + 4 * fq); ngv[vt] = *(const f32x4*)(p.in[17] + l * 512 + h * 128 + vt * 16 + 4 * fq); }
    bf16x8 Yp[2];
#pragma unroll
    for (int kk = 0; kk < 2; ++kk) Yp[kk] = frag_row(P, 72, i0, kk * 32, fr, fq);
    const float qdec = fexp_((float)(irow + 1) * lg);
    f32x4 o[8]; float ssq = 0.f;
#pragma unroll
    for (int vt = 0; vt < 8; ++vt) {
        f32x4 a1 = {0.f, 0.f, 0.f, 0.f}, a2 = {0.f, 0.f, 0.f, 0.f};
#pragma unroll
        for (int kk = 0; kk < 2; ++kk) { a1 = MFMA(frag_tr(V, 136, kk * 32, vt * 16, fr, fq), Yp[kk], a1); a2 = MFMA(frag_row(S, 72, vt * 16, kk * 32, fr, fq), Yq[kk], a2); }
        o[vt] = a1 + a2 * qdec;
        ssq += o[vt][0] * o[vt][0] + o[vt][1] * o[vt][1] + o[vt][2] * o[vt][2] + o[vt][3] * o[vt][3];
    }
    ssq += shfl_xor_(ssq, 16, lane); ssq += shfl_xor_(ssq, 32, lane);
    const float rstd = rsqrtf(ssq * (1.f / 128.f) + EPS);
#pragma unroll
    for (int vt = 0; vt < 8; ++vt) {
        const int v = vt * 16 + 4 * fq;
        float gt[4]; unpack4(rgv[vt], gt);
        const f32x4 ng = ngv[vt];
        float y[4];
#pragma unroll
        for (int i = 0; i < 4; ++i) y[i] = siluf_(gt[i]) * (o[vt][i] * rstd * ng[i]);
        u32x2 w; w.x = pk2(y[0], y[1]); w.y = pk2(y[2], y[3]);
        *(u32x2*)(mix + t * DMIX + 512 + h * 128 + v) = w;
    }
    __syncthreads();
}

__device__ void ssd_m2(const Params& p, LAS unsigned char* lds, int l, int b, int c, int g) {
    const int tid = TIDX, wid = tid >> 6, lane = tid & 63, fr = lane & 15, fq = lane >> 4;
    const bf16_t* proj = (const bf16_t*)(p.ws + W_PROJ);
    const bf16_t* sp = (const bf16_t*)(p.ws + W_SPS);
    bf16_t* mix = (bf16_t*)(p.ws + W_HB);
    const int row0 = b * SEQ + c * 64;
    LAS bf16_t* Cm = (LAS bf16_t*)lds;
    LAS bf16_t* Bm = (LAS bf16_t*)(lds + 17408);
    constexpr int PB = 34816, HB = 35840;
    LAS float* dtv = (LAS float*)(lds + 106496);
    LAS float* cum = dtv + 256;
    LAS float* ssqb = cum + 256;
    ssd_dt_cum<4>(p, l, row0, 4 * g, dtv, cum);
    const float* cw = p.in[18] + (size_t)l * 4 * 1024; const float* cb = p.in[19] + l * 1024;
    conv64(proj, row0, c * 64, PC_XBC, cw, cb, 1024, 32, [g](int q) { return (q < 16 ? 512 : 768 - 128) + g * 128 + q * 8; },
           [&](int j, int q, int ch, float* y) {
               float s[8];
#pragma unroll
               for (int e = 0; e < 8; ++e) s[e] = siluf_(y[e]);
               if (q < 16) *(LAS u32x4*)(Bm + j * 136 + q * 8) = pack8(s); else *(LAS u32x4*)(Cm + j * 136 + (q - 16) * 8) = pack8(s);
           });
    const int hh = wid >> 2, it = wid & 3, i0 = it * 16, irow = i0 + fr;
    const size_t t = row0 + irow;
    f32x4 gy[2][4]; float ssq = 0.f;
#pragma unroll
    for (int pr = 0; pr < 2; ++pr) {
        const int hbase = 4 * g + 2 * pr;
        conv64(proj, row0, c * 64, PC_XBC, cw, cb, 1024, 16, [hbase](int q) { return hbase * 64 + q * 8; },
               [&](int j, int q, int ch, float* y) {
                   float s[8];
#pragma unroll
                   for (int e = 0; e < 8; ++e) s[e] = siluf_(y[e]);
                   *(LAS u32x4*)((LAS bf16_t*)(lds + PB + (q >> 3) * HB + 9216) + j * 72 + (q & 7) * 8) = pack8(s);
               });
#pragma unroll
        for (int i = 0; i < 4; ++i) { const int id = tid + 512 * i, h2 = id >> 10, pp = (id >> 4) & 63, nc = id & 15;
            *(LAS u32x4*)((LAS bf16_t*)(lds + PB + h2 * HB + 18432) + pp * 136 + nc * 8) = *(const u32x4*)(sp + ((size_t)((b * 8 + hbase + h2) * NCH + c)) * 8192 + pp * 128 + nc * 8); }
        __syncthreads();
        const int h = hbase + hh, hl = 2 * pr + hh;
        LAS bf16_t* P = (LAS bf16_t*)(lds + PB + hh * HB); LAS bf16_t* X = P + 64 * 72; LAS bf16_t* S = (LAS bf16_t*)(lds + PB + hh * HB + 18432);
        bf16x8 Yc[4];
#pragma unroll
        for (int kk = 0; kk < 4; ++kk) Yc[kk] = frag_row(Cm, 136, i0, kk * 32, fr, fq);
        const float cumi = cum[hl * 64 + irow];
#pragma unroll
        for (int jh = 0; jh < 2; ++jh) {
            bf16x8 Xb[2][4]; f32x4 cj[2], dj[2];
#pragma unroll
            for (int q = 0; q < 2; ++q) {
#pragma unroll
                for (int kk = 0; kk < 4; ++kk) Xb[q][kk] = frag_row(Bm, 136, (2 * jh + q) * 16, kk * 32, fr, fq);
                cj[q] = *(const LAS f32x4*)(cum + hl * 64 + (2 * jh + q) * 16 + 4 * fq); dj[q] = *(const LAS f32x4*)(dtv + hl * 64 + (2 * jh + q) * 16 + 4 * fq);
            }
#pragma unroll
            for (int q = 0; q < 2; ++q) {
                const int jt = 2 * jh + q;
                f32x4 sc = {0.f, 0.f, 0.f, 0.f};
#pragma unroll
                for (int kk = 0; kk < 4; ++kk) sc = MFMA(Xb[q][kk], Yc[kk], sc);
                float v[4];
#pragma unroll
                for (int i = 0; i < 4; ++i) { const int j = jt * 16 + 4 * fq + i; v[i] = j <= irow ? sc[i] * fexp_(cumi - cj[q][i]) * dj[q][i] : 0.f; }
                u32x2 w; w.x = pk2(v[0], v[1]); w.y = pk2(v[2], v[3]);
                *(LAS u32x2*)(P + irow * 72 + jt * 16 + 4 * fq) = w;
            }
        }
        __syncthreads();
        u32x2 zraw[4];
#pragma unroll
        for (int pt = 0; pt < 4; ++pt) zraw[pt] = *(const u32x2*)(proj + t * NPROJ + PC_Z + h * 64 + pt * 16 + 4 * fq);
        bf16x8 Yp[2];
#pragma unroll
        for (int kk = 0; kk < 2; ++kk) Yp[kk] = frag_row(P, 72, i0, kk * 32, fr, fq);
        const float ecum = fexp_(cumi), Dh = p.in[22][l * 8 + h];
#pragma unroll
        for (int pt = 0; pt < 4; ++pt) {
            f32x4 a1 = {0.f, 0.f, 0.f, 0.f}, a2 = {0.f, 0.f, 0.f, 0.f};
#pragma unroll
            for (int kk = 0; kk < 2; ++kk) a1 = MFMA(frag_tr(X, 72, kk * 32, pt * 16, fr, fq), Yp[kk], a1);
#pragma unroll
            for (int kk = 0; kk < 4; ++kk) a2 = MFMA(frag_row(S, 136, pt * 16, kk * 32, fr, fq), Yc[kk], a2);
            const int pp = pt * 16 + 4 * fq;
            float xv[4], zv[4]; unpack4(*(const LAS u32x2*)(X + irow * 72 + pp), xv);
            unpack4(zraw[pt], zv);
            f32x4 r;
#pragma unroll
            for (int i = 0; i < 4; ++i) { const float y = a1[i] + ecum * a2[i] + Dh * xv[i]; r[i] = y * siluf_(zv[i]); ssq += r[i] * r[i]; }
            gy[pr][pt] = r;
        }
        __syncthreads();
    }
    f32x4 ngv[2][4];
#pragma unroll
    for (int pr = 0; pr < 2; ++pr)
#pragma unroll
        for (int pt = 0; pt < 4; ++pt) ngv[pr][pt] = *(const f32x4*)(p.in[23] + l * 512 + g * 256 + (2 * pr + hh) * 64 + pt * 16 + 4 * fq);
    ssq += shfl_xor_(ssq, 16, lane); ssq += shfl_xor_(ssq, 32, lane);
    if (fq == 0) ssqb[irow * 2 + hh] = ssq;
    __syncthreads();
    const float rstd = rsqrtf((ssqb[irow * 2] + ssqb[irow * 2 + 1]) * (1.f / 256.f) + EPS);
#pragma unroll
    for (int pr = 0; pr < 2; ++pr)
#pragma unroll
        for (int pt = 0; pt < 4; ++pt) {
            const int chn = g * 256 + (2 * pr + hh) * 64 + pt * 16 + 4 * fq;
            const f32x4 ng = ngv[pr][pt];
            u32x2 w; w.x = pk2(gy[pr][pt][0] * rstd * ng[0], gy[pr][pt][1] * rstd * ng[1]); w.y = pk2(gy[pr][pt][2] * rstd * ng[2], gy[pr][pt][3] * rstd * ng[3]);
            *(u32x2*)(mix + t * DMIX + 1024 + chn) = w;
        }
    __syncthreads();
}

__device__ void sample_item(const Params& p, LAS unsigned char* lds, int l, int s, int g) {
    const int tid = TIDX, wid = tid >> 6, lane = tid & 63;
    const bf16_t* proj = (const bf16_t*)(p.ws + W_PROJ);
    bf16_t* mix = (bf16_t*)(p.ws + W_HB);
    const size_t t = TP + s;
    const bf16_t* prow = proj + t * NPROJ;
    LAS float* sv = (LAS float*)lds;
    LAS float* sdt = sv + 512;
    LAS float* gy = sv + 520;
    LAS float* sq = sv + 776;
    LAS float* ro = sv + 1032;
    LAS float* sxc = sv + 2304;
    f32x4 ssd0[4][4], ret0[2][4];
    {
        const int n4 = (tid & 31) * 4, pr = tid >> 5;
#pragma unroll
        for (int hl = 0; hl < 4; ++hl)
#pragma unroll
            for (int ps = 0; ps < 4; ++ps) ssd0[hl][ps] = __builtin_nontemporal_load((const f32x4*)(p.in[6] + ((size_t)(l * NS + s) * 8 + 4 * g + hl) * 8192 + (ps * 16 + pr) * 128 + n4));
#pragma unroll
        for (int hh = 0; hh < 2; ++hh)
#pragma unroll
            for (int ps = 0; ps < 4; ++ps) ret0[hh][ps] = __builtin_nontemporal_load((const f32x4*)(p.in[4] + ((size_t)(l * NS + s) * 4 + 2 * g + hh) * 8192 + (ps * 16 + pr) * 128 + n4));
    }
    {
        const int ch = tid < 256 ? g * 256 + tid : (tid < 384 ? 512 + g * 128 + (tid - 256) : 768 + g * 128 + (tid - 384));
        const float* cw = p.in[18] + (size_t)l * 4 * 1024; const float* st = p.in[5] + (size_t)(l * NS + s) * 3 * 1024;
        const float cur = bf2f(prow[PC_XBC + ch]);
        const float s0 = st[ch], s1 = st[1024 + ch], s2 = st[2048 + ch];
        const float y = p.in[19][l * 1024 + ch] + cw[ch] * s0 + cw[1024 + ch] * s1 + cw[2048 + ch] * s2 + cw[3072 + ch] * cur;
        sv[tid] = siluf_(y);
        float* so = p.out + O_SCS + (size_t)(l * NS + s) * 3 * 1024;
        so[ch] = s1; so[1024 + ch] = s2; so[2048 + ch] = cur;
        if (tid < 4) {
            const int h = 4 * g + tid;
            const float dt = softplusf_(((const float*)(p.ws + W_DT))[t * 8 + h] + p.in[20][l * 8 + h]);
            sdt[tid] = dt; sdt[4 + tid] = fexp_(-dt * fexp_(p.in[21][l * 8 + h]));
        }
    }
    __syncthreads();
    {
        const int n4 = (tid & 31) * 4, pr = tid >> 5;
        const f32x4 bv = *(const LAS f32x4*)(sv + 256 + n4), cv = *(const LAS f32x4*)(sv + 384 + n4);
        float part[4][4]; bf16_t zr[4][4];
#pragma unroll
        for (int hl = 0; hl < 4; ++hl)
#pragma unroll
            for (int ps = 0; ps < 4; ++ps) zr[hl][ps] = prow[PC_Z + (4 * g + hl) * 64 + ps * 16 + pr];
#pragma unroll
        for (int hl = 0; hl < 4; ++hl) {
            const int h = 4 * g + hl;
            const float dt = sdt[hl], eda = sdt[4 + hl];
            float* S1 = p.out + O_SS + ((size_t)(l * NS + s) * 8 + h) * 8192;
#pragma unroll
            for (int ps = 0; ps < 4; ++ps) {
                const int pp = ps * 16 + pr;
                const float xp = sv[hl * 64 + pp];
                const f32x4 sn = ssd0[hl][ps] * eda + bv * (dt * xp);
                __builtin_nontemporal_store(sn, (f32x4*)(S1 + pp * 128 + n4));
                part[hl][ps] = cv[0] * sn[0] + cv[1] * sn[1] + cv[2] * sn[2] + cv[3] * sn[3];
            }
        }
#pragma unroll
        for (int o = 16; o >= 1; o >>= 1)
#pragma unroll
            for (int hl = 0; hl < 4; ++hl)
#pragma unroll
                for (int ps = 0; ps < 4; ++ps) part[hl][ps] += shfl_xor_(part[hl][ps], o, lane);
        if ((tid & 31) == 0) {
#pragma unroll
            for (int hl = 0; hl < 4; ++hl)
#pragma unroll
                for (int ps = 0; ps < 4; ++ps) { const int pp = ps * 16 + pr; const float y = part[hl][ps] + p.in[22][l * 8 + 4 * g + hl] * sv[hl * 64 + pp]; gy[hl * 64 + pp] = y * siluf_(bf2f(zr[hl][ps])); }
        }
    }
    __syncthreads();
    {
        const f32x4 v = *(const LAS f32x4*)(gy + lane * 4);
        const float ssq = wave_sum(v[0] * v[0] + v[1] * v[1] + v[2] * v[2] + v[3] * v[3], lane);
        const float rstd = rsqrtf(ssq * (1.f / 256.f) + EPS);
        if (tid < 256) mix[t * DMIX + 1024 + g * 256 + tid] = f2bf(gy[tid] * rstd * p.in[23][l * 512 + g * 256 + tid]);
    }
    if (tid < 128) {
        const int hh = tid >> 6, w = (tid >> 5) & 1, d = tid & 31, h = 2 * g + hh;
        const int col = (w ? PC_K : PC_Q) + h * 64;
        const float x1 = bf2f(prow[col + d]), x2 = bf2f(prow[col + 32 + d]);
        const float* rc = (const float*)(p.ws + W_ROPE); const float* rs = rc + 2049 * 32;
        const float cs = rc[2048 * 32 + d], sn = rs[2048 * 32 + d], sc = w ? 0.125f : 1.f;
        sq[w * 128 + hh * 64 + d] = (x1 * cs - x2 * sn) * sc; sq[w * 128 + hh * 64 + 32 + d] = (x1 * sn + x2 * cs) * sc;
    }
    __syncthreads();
#pragma unroll
    for (int hh = 0; hh < 2; ++hh) {
        const int h = 2 * g + hh;
        const float gh = 1.f - exp2f(-5.f - (float)h);
        const int v4 = (tid & 31) * 4, kr = tid >> 5;
        float vv[4]; unpack4(*(const u32x2*)(prow + PC_V + h * 128 + v4), vv);
        const float* S0 = p.in[4] + ((size_t)(l * NS + s) * 4 + h) * 8192; float* S1 = p.out + O_RS + ((size_t)(l * NS + s) * 4 + h) * 8192;
        f32x4 part = {0.f, 0.f, 0.f, 0.f};
#pragma unroll
        for (int ps = 0; ps < 4; ++ps) {
            const int k = ps * 16 + kr;
            const float kk = sq[128 + hh * 64 + k], qq = sq[hh * 64 + k];
            const f32x4 s0 = ret0[hh][ps];
            f32x4 sn; sn[0] = gh * s0[0] + kk * vv[0]; sn[1] = gh * s0[1] + kk * vv[1]; sn[2] = gh * s0[2] + kk * vv[2]; sn[3] = gh * s0[3] + kk * vv[3];
            __builtin_nontemporal_store(sn, (f32x4*)(S1 + k * 128 + v4));
            part = part + sn * qq;
        }
#pragma unroll
        for (int i = 0; i < 4; ++i) part[i] += shfl_xor_(part[i], 32, lane);
        if (lane < 32) *(LAS f32x4*)(ro + wid * 128 + v4) = part;
        __syncthreads();
        if (tid < 128) {
            float o = 0.f;
#pragma unroll
            for (int w = 0; w < 8; ++w) o += ro[w * 128 + tid];
            float ssq = wave_sum(o * o, lane);
            ro[1024 + tid] = o; if (lane == 0) ro[1152 + wid] = ssq;
        }
        __syncthreads();
        if (tid < 128) {
            const float rstd = rsqrtf((ro[1152] + ro[1153]) * (1.f / 128.f) + EPS);
            const float o = ro[1024 + tid];
            mix[t * DMIX + 512 + h * 128 + tid] = f2bf(siluf_(bf2f(prow[PC_RG + h * 128 + tid])) * (o * rstd * p.in[17][l * 512 + h * 128 + tid]));
        }
        __syncthreads();
    }
    if (tid < 256) {
        const int ch = 256 * g + tid;
        const float* cw = p.in[10] + (size_t)l * 4 * 512; const float* st = p.in[2] + (size_t)(l * NS + s) * 3 * 512;
        const float cur = bf2f(prow[PC_LX + ch]);
        const float s0 = st[ch], s1 = st[512 + ch], s2 = st[1024 + ch];
        sxc[tid] = p.in[11][l * 512 + ch] + cw[ch] * s0 + cw[512 + ch] * s1 + cw[1024 + ch] * s2 + cw[1536 + ch] * cur;
        float* so = p.out + O_LCS + (size_t)(l * NS + s) * 3 * 512;
        so[ch] = s1; so[512 + ch] = s2; so[1024 + ch] = cur;
    }
    __syncthreads();
    if (tid < 256) {
        const int j = tid & 63, hl = tid >> 6, h = 4 * g + hl, ch = h * 64 + j;
        const float* wr = p.in[12] + (size_t)(l * 8 + h) * 4096; const float* wi = p.in[14] + (size_t)(l * 8 + h) * 4096;
        float r = 0.f, ig = 0.f;
        for (int i = 0; i < 64; ++i) { const float xv = sxc[hl * 64 + i]; r += xv * wr[i * 64 + j]; ig += xv * wi[i * 64 + j]; }
        r = sigmoidf_(r + p.in[13][l * 512 + ch]); ig = sigmoidf_(ig + p.in[15][l * 512 + ch]);
        const float sp = log1pf(fexp_(-p.in[16][l * 512 + ch]));
        const float la = -8.f * r * sp, a = fexp_(la);
        const float hn = a * p.in[3][(size_t)(l * NS + s) * 512 + ch] + __builtin_amdgcn_sqrtf(fmaxf(-expm1f(2.f * la), 0.f)) * ig * sxc[tid];
        p.out[O_LHS + (size_t)(l * NS + s) * 512 + ch] = hn;
        mix[t * DMIX + ch] = f2bf(hn * geluf_(bf2f(prow[PC_LG + ch])));
    }
    __syncthreads();
}

#ifndef ITMASK
#define ITMASK 0xFF
#endif
#define IT_EN(x) (((ITMASK) >> (x)) & 1)
#ifndef REP_ITEM
#define REP_ITEM 0
#endif
__device__ void phase_m1(const Params& p, LAS unsigned char* lds, int l) {
    for (int rr = 0; rr < 1 + ((REP_ITEM >> 0) & 1); ++rr) { if (IT_EN(0)) for (int it = blockIdx.x; it < 256; it += gridDim.x) ret_m1(p, lds, it >> 5, it & 31); }
    for (int rr = 0; rr < 1 + ((REP_ITEM >> 1) & 1); ++rr) { if (IT_EN(1)) for (int it = blockIdx.x; it < 256; it += gridDim.x) ssd_m1(p, lds, l, it >> 5, it & 31); }
    for (int rr = 0; rr < 1 + ((REP_ITEM >> 2) & 1); ++rr) { if (IT_EN(2)) for (int it = blockIdx.x; it < 256; it += gridDim.x) lru_item<1>(p, lds, l, it >> 5, it & 31); }
    for (int rr = 0; rr < 1 + ((REP_ITEM >> 3) & 1); ++rr) { if (IT_EN(3)) for (int it = blockIdx.x; it < 256; it += gridDim.x) sample_item(p, lds, l, it >> 1, it & 1); }
    const bf16_t* proj = (const bf16_t*)(p.ws + W_PROJ);
    const int gt = blockIdx.x * 512 + TIDX, gn = gridDim.x * 512;
    for (int u = gt; u < NB * 3 * 1536; u += gn) {
        const int b = u / (3 * 1536), r = u % (3 * 1536), k = r / 1536, cc = r % 1536;
        const size_t row = (size_t)b * SEQ + SEQ - 3 + k;
        if (cc < 512) p.out[O_LCP + ((size_t)(l * NB + b) * 3 + k) * 512 + cc] = bf2f(proj[row * NPROJ + PC_LX + cc]);
        else p.out[O_SCP + ((size_t)(l * NB + b) * 3 + k) * 1024 + cc - 512] = bf2f(proj[row * NPROJ + PC_XBC + cc - 512]);
    }
}
__device__ void phase_m2(const Params& p, LAS unsigned char* lds, int l) {
    for (int rr = 0; rr < 1 + ((REP_ITEM >> 4) & 1); ++rr) { if (IT_EN(4)) for (int it = blockIdx.x; it < 512; it += gridDim.x) ret_m2(p, lds, l, it >> 6, (it >> 1) & 31, it & 1); }
    for (int rr = 0; rr < 1 + ((REP_ITEM >> 5) & 1); ++rr) { if (IT_EN(5)) for (int it = blockIdx.x; it < 512; it += gridDim.x) ssd_m2(p, lds, l, it >> 6, (it >> 1) & 31, it & 1); }
    for (int rr = 0; rr < 1 + ((REP_ITEM >> 6) & 1); ++rr) { if (IT_EN(6)) for (int it = blockIdx.x; it < 256; it += gridDim.x) lru_item<2>(p, lds, l, it >> 5, it & 31); }
}


#define XB_TMO      128
#define XB_XCNT(j)  (256  + 64 * (j))
#define XB_XSUB(j)  (1280 + 64 * (j))
#define XB_XGEN(j)  (2304 + 64 * (j))
#define XB_TOP      3328
#define XB_TOPGEN   3392
#define XCD_BAR_WORDS 3456
#define XB_SPIN_CAP (1u << 22)
__device__ __forceinline__ unsigned xb_ld(unsigned* p)              { return __hip_atomic_load(p, __ATOMIC_RELAXED, __HIP_MEMORY_SCOPE_AGENT); }
__device__ __forceinline__ unsigned xb_add(unsigned* p, unsigned v) { return __hip_atomic_fetch_add(p, v, __ATOMIC_RELAXED, __HIP_MEMORY_SCOPE_AGENT); }
__device__ __forceinline__ unsigned xb_xcc_id() { return (unsigned)__builtin_amdgcn_s_getreg((3 << 11) | 20) & 0xFu; }
#define XB_SPIN(cond, bar) do { unsigned _sp = 0; while (cond) { __builtin_amdgcn_s_sleep(1); \
    if ((++_sp & 255u) == 0u) { if (xb_ld(&(bar)[XB_TMO])) break; if (_sp > XB_SPIN_CAP) { atomicAdd(&(bar)[XB_TMO], 1u); break; } } } } while (0)
struct XcdBarrier { unsigned* bar; unsigned x; volatile LAS unsigned* st; };
__device__ __forceinline__ XcdBarrier xcd_barrier_post(unsigned* bar, volatile LAS unsigned* st) {
    XcdBarrier b; b.bar = bar; b.x = xb_xcc_id(); b.st = st;
    if (threadIdx.x == 0) (void)xb_add(&bar[XB_XCNT(b.x)], 1u);
    return b;
}
__device__ __forceinline__ void xcd_barrier_complete(unsigned* bar, unsigned x, unsigned& nloc, unsigned& nx) {
    const unsigned G = gridDim.x * gridDim.y * gridDim.z;
    unsigned sum, cnt, mine, sp = 0u;
    for (;;) {
        sum = 0u; cnt = 0u; mine = 0u;
#pragma unroll
        for (unsigned j = 0; j < 16; ++j) { const unsigned c = xb_ld(&bar[XB_XCNT(j)]); sum += c; cnt += (c > 0u) ? 1u : 0u; mine = (j == x) ? c : mine; }
        if (sum == G) break;
        __builtin_amdgcn_s_sleep(1);
        if ((++sp & 255u) == 0u) { if (xb_ld(&bar[XB_TMO])) break; if (sp > XB_SPIN_CAP) { atomicAdd(&bar[XB_TMO], 1u); break; } }
    }
    nloc = mine > 0u ? mine : 1u; nx = cnt > 0u ? cnt : 1u;
}
__device__ __forceinline__ void xcd_barrier(const XcdBarrier& b) {
    asm volatile("s_waitcnt vmcnt(0)" ::: "memory");
    __syncthreads();
    if (threadIdx.x == 0) {
        unsigned* bar = b.bar;
        __builtin_amdgcn_s_waitcnt(0);
        unsigned nloc = b.st[0], nx = b.st[1];
        if (nloc == 0u) { xcd_barrier_complete(bar, b.x, nloc, nx); b.st[0] = nloc; b.st[1] = nx; }
        const unsigned old = xb_add(&bar[XB_XSUB(b.x)], 1u);
        const unsigned gen = old / nloc;
        if (old + 1u == (gen + 1u) * nloc) {
            __builtin_amdgcn_fence(__ATOMIC_RELEASE, "agent");
            asm volatile("s_waitcnt vmcnt(0)" ::: "memory");
            const unsigned og = xb_add(&bar[XB_TOP], 1u);
            const unsigned tg = og / nx;
            if (og + 1u == (tg + 1u) * nx) xb_add(&bar[XB_TOPGEN], 1u);
            else XB_SPIN(xb_ld(&bar[XB_TOPGEN]) == tg, bar);
            __builtin_amdgcn_fence(__ATOMIC_ACQUIRE, "agent");
            xb_add(&bar[XB_XGEN(b.x)], 1u);
            asm volatile("s_waitcnt vmcnt(0)" ::: "memory");
        } else {
            XB_SPIN(xb_ld(&bar[XB_XGEN(b.x)]) == gen, bar);
            __builtin_amdgcn_fence(__ATOMIC_ACQUIRE, "agent");
            asm volatile("s_waitcnt vmcnt(0)" ::: "memory");
        }
    }
    __syncthreads();
}

constexpr int NPHASE = 2 + 7 * DEPTH;
#ifndef PHMASK
#define PHMASK 0xFFF
#endif
#define PH_EN(x) (((PHMASK) >> (x)) & 1)
__device__ __forceinline__ void run_phase(const Params& p, LAS unsigned char* lds, int ph) {
    if (ph == 0) { if (PH_EN(10)) phase_prep(p, lds); return; }
    if (ph == NPHASE - 1) { if (PH_EN(11)) phase_final(p); return; }
    const int l = (ph - 1) / 7, s = (ph - 1) % 7;
    bf16_t* mix = (bf16_t*)(p.ws + W_HB); bf16_t* xb = (bf16_t*)(p.ws + W_XB); bf16_t* big = (bf16_t*)(p.ws + W_PROJ); bf16_t* act = (bf16_t*)(p.ws + W_DS);
    u64* rss = (u64*)(p.ws + W_RSS);
    pg8::StaticOrder S;
    switch (s) {
    case 0: if (PH_EN(1)) {
        const bf16_t* W = (const bf16_t*)(p.ws + W_WIN) + (size_t)l * NPROJ * DM;
        const u64* r = rss + (size_t)(2 * l) * TT;
        S.init(TP, NPROJ, gridDim.x, blockIdx.x);
        pg8::gemm_phase(lds, pg8::Gemm{xb, W, TP, NPROJ, DM}, S, pg8::EpiBf16{big, NPROJ, r});
        phase_dt(p, l);
        thin_gemm<DM, 0>(lds, xb + (size_t)TP * DM, W, NPROJ, big + (size_t)TP * NPROJ, NPROJ, nullptr, (u64*)r + TP);
    } break;
    case 1: if (PH_EN(2)) phase_m1(p, lds, l); break;
    case 2: if (PH_EN(3)) phase_m15(p, l); break;
    case 3: if (PH_EN(4)) phase_m2(p, lds, l); break;
    case 4: if (PH_EN(5)) {
        const bf16_t* W = (const bf16_t*)(p.ws + W_WOUT) + (size_t)l * DM * DMIX;
        u64* r = rss + (size_t)(2 * l + 1) * TT;
        S.init(TP, DM, gridDim.x, blockIdx.x);
        pg8::gemm_phase(lds, pg8::Gemm{mix, W, TP, DM, DMIX}, S, pg8::EpiResid{DM, xb, r});
        thin_gemm<DMIX, 1>(lds, mix + (size_t)TP * DMIX, W, DM, nullptr, DM, xb + (size_t)TP * DM, r + TP);
    } break;
    case 5: if (PH_EN(7)) {
        const bf16_t* W = (const bf16_t*)(p.ws + W_WUP) + (size_t)l * DGU * DM;
        const u64* r = rss + (size_t)(2 * l + 1) * TT;
        const float* cw = p.in[27] + (size_t)l * 3 * DFF; const float* cb = p.in[28] + (size_t)l * DFF;
        S.init(TP, DGU, gridDim.x, blockIdx.x);
        pg8::gemm_phase(lds, pg8::Gemm{xb, W, TP, DGU, DM}, S, pg8::EpiAct{act, r, cw, cb, (bf16_t*)(p.ws + W_GS01), (bf16_t*)(p.ws + W_US01), (bf16_t*)(p.ws + W_GS23), p.out + O_FCP + (size_t)l * NB * 2 * DFF});
        thin_gemm_act(lds, xb + (size_t)TP * DM, W, r + TP, cw, cb, p.in[7] + (size_t)l * NS * 2 * DFF, p.out + O_FCS + (size_t)l * NS * 2 * DFF, act + (size_t)TP * DFF);
    } break;
    case 6: if (PH_EN(9)) {
        const bf16_t* W = (const bf16_t*)(p.ws + W_WDOWN) + (size_t)l * DM * DFF;
        u64* r = rss + (size_t)(2 * l + 2) * TT;
        S.init(TP, DM, gridDim.x, blockIdx.x);
        { pg8::Unit uu; for (int i = 0; S.next(i, uu); ++i) act_fixup(p, l, uu.pm); __threadfence(); __syncthreads(); }
        pg8::gemm_phase(lds, pg8::Gemm{act, W, TP, DM, DFF}, S, pg8::EpiResid{DM, xb, r});
        thin_gemm<DFF, 1>(lds, act + (size_t)TP * DFF, W, DM, nullptr, DM, xb + (size_t)TP * DM, r + TP);
    } break;
    }
}

__global__ void __launch_bounds__(512, 2) mega(Params p, int ph0, int ph1, int coop) {
    extern __shared__ __attribute__((aligned(16))) unsigned char shm[];
    LAS unsigned char* lds = (LAS unsigned char*)shm;
    cg::grid_group grid = cg::this_grid();
    volatile LAS unsigned* st = (volatile LAS unsigned*)(lds + LDS_BYTES);
    if (threadIdx.x < 4) st[threadIdx.x] = 0u;
    __syncthreads();
    XcdBarrier xb = xcd_barrier_post((unsigned*)(p.ws + W_BAR), st);
    for (int ph = ph0; ph < ph1; ++ph) {
        int reps = 1;
#ifdef REP_MASK
        { const int s = (ph == 0) ? 10 : (ph == NPHASE - 1 ? 11 : (ph - 1) % 7); if ((REP_MASK >> s) & 1) reps = 2; }
#endif
        for (int r = 0; r < reps; ++r) { run_phase(p, lds, ph); if (reps > 1) __syncthreads(); }
        if (coop && ph + 1 < ph1) {
            if (coop == 2) grid.sync();
            xcd_barrier(xb);
#ifdef REP_SYNC
            xcd_barrier(xb);
#endif
        }
    }
}

extern "C" void kernel_launch(void* const* d_in, const int* in_sizes, int n_in, void* d_out, int out_size, void* d_ws, size_t ws_size, hipStream_t stream) {
    static int grid_blocks = 0;
    if (!grid_blocks) {
        int dev = 0, cus = 0, per_cu = 0;
        hipGetDevice(&dev);
        hipDeviceGetAttribute(&cus, hipDeviceAttributeMultiprocessorCount, dev);
        hipFuncSetAttribute((const void*)mega, hipFuncAttributeMaxDynamicSharedMemorySize, LDS_BYTES + 16);
        hipOccupancyMaxActiveBlocksPerMultiprocessor(&per_cu, (const void*)mega, 512, LDS_BYTES + 16);
        if (per_cu < 1) per_cu = 1;
        grid_blocks = cus * per_cu;
        if (grid_blocks > 256) grid_blocks = 256;
        if (ws_size < W_END) fprintf(stderr, "kernel_launch: workspace too small: %zu < %zu\n", ws_size, (size_t)W_END);
    }
    Params p{};
    for (int i = 0; i < 31; ++i) p.in[i] = (const float*)d_in[i];
    p.out = (float*)d_out; p.ws = (unsigned char*)d_ws;
    hipMemsetAsync((unsigned char*)d_ws + W_BAR, 0, XCD_BAR_WORDS * 4, stream);
    int ph0 = 0, ph1 = NPHASE, coop = 1;
    void* args[] = {&p, &ph0, &ph1, &coop};
    hipError_t e = hipLaunchCooperativeKernel((const void*)mega, dim3(grid_blocks), dim3(512), args, LDS_BYTES + 16, stream);
    if (e != hipSuccess) fprintf(stderr, "cooperative launch failed: %s (grid %d)\n", hipGetErrorString(e), grid_blocks);
}
```

```cpp
#include <hip/hip_runtime.h>
#include <hip/hip_cooperative_groups.h>
#include <cstdio>
namespace cg = cooperative_groups;

#define LAS __attribute__((address_space(3)))
typedef unsigned short bf16_t;
typedef short bf16x8 __attribute__((ext_vector_type(8)));
typedef short s16x4 __attribute__((ext_vector_type(4)));
typedef float f32x4 __attribute__((ext_vector_type(4)));
typedef float f32x2 __attribute__((ext_vector_type(2)));
typedef unsigned u32x4 __attribute__((ext_vector_type(4)));
typedef unsigned u32x2 __attribute__((ext_vector_type(2)));

constexpr int DM = 1024, NB = 8, SEQ = 2048, DEPTH = 4, NS = 128;
constexpr int TP = NB * SEQ;
constexpr int TT = TP + NS;
constexpr int DLRU = 512, DIN = 4104, NPROJ = 4096, DMIX = 1536, DFF = 2816, DGU = 5632;
constexpr int NCH = 32;
constexpr float EPS = 1e-6f;
constexpr int PC_LX = 0, PC_LG = 512, PC_Q = 1024, PC_K = 1280, PC_V = 1536, PC_RG = 2048, PC_Z = 2560, PC_XBC = 3072;

constexpr size_t O_Y = 0;
constexpr size_t O_LCP = (size_t)TT * DM;
constexpr size_t O_LCS = O_LCP + (size_t)DEPTH * NB * 3 * 512;
constexpr size_t O_LHP = O_LCS + (size_t)DEPTH * NS * 3 * 512;
constexpr size_t O_LHS = O_LHP + (size_t)DEPTH * NB * 512;
constexpr size_t O_RP = O_LHS + (size_t)DEPTH * NS * 512;
constexpr size_t O_RS = O_RP + (size_t)DEPTH * NB * 4 * 64 * 128;
constexpr size_t O_SCP = O_RS + (size_t)DEPTH * NS * 4 * 64 * 128;
constexpr size_t O_SCS = O_SCP + (size_t)DEPTH * NB * 3 * 1024;
constexpr size_t O_SP = O_SCS + (size_t)DEPTH * NS * 3 * 1024;
constexpr size_t O_SS = O_SP + (size_t)DEPTH * NB * 8 * 64 * 128;
constexpr size_t O_FCP = O_SS + (size_t)DEPTH * NS * 8 * 64 * 128;
constexpr size_t O_FCS = O_FCP + (size_t)DEPTH * NB * 2 * DFF;

constexpr size_t W_WIN = 0;
constexpr size_t W_WOUT = W_WIN + (size_t)DEPTH * NPROJ * DM * 2;
constexpr size_t W_WUP = W_WOUT + (size_t)DEPTH * DM * DMIX * 2;
constexpr size_t W_WDOWN = W_WUP + (size_t)DEPTH * DGU * DM * 2;
constexpr size_t W_LRUW = W_WDOWN + (size_t)DEPTH * DM * DFF * 2;
constexpr size_t W_ROPE = W_LRUW + (size_t)2 * DEPTH * 8 * 64 * 64 * 2;
constexpr size_t W_DT = W_ROPE + 524800;
constexpr size_t W_LRUAB = W_DT + (size_t)TT * 8 * 4;
constexpr size_t W_LRUHIN = W_LRUAB + (size_t)NB * NCH * 512 * 2 * 4;
constexpr size_t W_DEC = W_LRUHIN + (size_t)NB * NCH * 512 * 4;
constexpr size_t W_RSS = W_DEC + 8192;
constexpr size_t W_WDT = W_RSS + (size_t)9 * TT * 8;
constexpr size_t W_HB = W_WDT + (size_t)DEPTH * 16 * DM * 2;
constexpr size_t W_XB = W_HB + (size_t)TT * DMIX * 2;
constexpr size_t W_PROJ = W_XB + (size_t)TT * DM * 2;
constexpr size_t W_SPR = W_PROJ + (size_t)TT * NPROJ * 2;
constexpr size_t W_SPS = W_SPR + (size_t)NB * 4 * NCH * 8192 * 2;
static_assert(W_SPS + (size_t)NB * 8 * NCH * 8192 * 2 <= W_PROJ + (size_t)TT * DGU * 2, "Sp does not fit behind proj");
constexpr size_t W_DS = W_PROJ + (size_t)TT * DGU * 2;
constexpr size_t W_DSSSD = W_DS + (size_t)NB * 4 * NCH * 8192 * 4;
constexpr size_t W_BAR = W_DSSSD + (size_t)NB * 8 * NCH * 8192 * 4;
constexpr size_t W_GS01 = W_BAR + 16384;
constexpr size_t W_US01 = W_GS01 + (size_t)256 * 2 * DFF * 2;
constexpr size_t W_GS23 = W_US01 + (size_t)256 * 2 * DFF * 2;
constexpr size_t W_END = W_GS23 + (size_t)256 * 2 * DFF * 2;
static_assert(W_END <= (size_t)512 * 1024 * 1024, "workspace budget");
constexpr int LDS_BYTES = 131072;

struct Params { const float* in[31]; float* out; unsigned char* ws; };

typedef unsigned long long u64;
__device__ __forceinline__ u64 ss_fix(float ss) { return (u64)(ss * 1048576.f + 0.5f); }
__device__ __forceinline__ float rstd_fix(u64 v) { return rsqrtf((float)v * (1.f / (1048576.f * 1024.f)) + 1e-6f); }
__device__ __forceinline__ int opaque_tid() { int t = threadIdx.x; asm volatile("" : "+v"(t)); return t; }
#define TIDX opaque_tid()
__device__ __forceinline__ float bf2f(bf16_t v) { return __uint_as_float(((unsigned)v) << 16); }
__device__ __forceinline__ unsigned pk2(float lo, float hi) { unsigned r; asm volatile("v_cvt_pk_bf16_f32 %0, %1, %2" : "=v"(r) : "v"(lo), "v"(hi)); return r; }
__device__ __forceinline__ bf16_t f2bf(float f) { return (bf16_t)(pk2(f, 0.f) & 0xffffu); }
__device__ __forceinline__ void unpack8(u32x4 w, float* f) {
    f[0] = __uint_as_float(w.x << 16); f[1] = __uint_as_float(w.x & 0xffff0000u);
    f[2] = __uint_as_float(w.y << 16); f[3] = __uint_as_float(w.y & 0xffff0000u);
    f[4] = __uint_as_float(w.z << 16); f[5] = __uint_as_float(w.z & 0xffff0000u);
    f[6] = __uint_as_float(w.w << 16); f[7] = __uint_as_float(w.w & 0xffff0000u);
}
__device__ __forceinline__ void unpack4(u32x2 w, float* f) {
    f[0] = __uint_as_float(w.x << 16); f[1] = __uint_as_float(w.x & 0xffff0000u);
    f[2] = __uint_as_float(w.y << 16); f[3] = __uint_as_float(w.y & 0xffff0000u);
}
__device__ __forceinline__ u32x4 pack8(const float* f) { u32x4 w; w.x = pk2(f[0], f[1]); w.y = pk2(f[2], f[3]); w.z = pk2(f[4], f[5]); w.w = pk2(f[6], f[7]); return w; }
__device__ __forceinline__ float fexp_(float x) { return __builtin_amdgcn_exp2f(x * 1.44269504089f); }
__device__ __forceinline__ float sigmoidf_(float x) { return __builtin_amdgcn_rcpf(1.f + fexp_(-x)); }
__device__ __forceinline__ float siluf_(float x) { return x * __builtin_amdgcn_rcpf(1.f + fexp_(-x)); }
__device__ __forceinline__ float geluf_(float x) { const float z = x * __builtin_fmaf(x * x, 0.1029432397f, 2.302208198f); const float r = __builtin_amdgcn_rcpf(1.f + __builtin_amdgcn_exp2f(z)); return __builtin_fmaf(-x, r, x); }
__device__ __forceinline__ float softplusf_(float x) { return x > 20.f ? x : log1pf(fexp_(x)); }
__device__ __forceinline__ float shfl_idx(float v, int src) { return __int_as_float(__builtin_amdgcn_ds_bpermute(src << 2, __float_as_int(v))); }
__device__ __forceinline__ float shfl_xor_(float v, int o, int lane) { return shfl_idx(v, lane ^ o); }
__device__ __forceinline__ float shfl_up_(float v, int o, int lane) { return shfl_idx(v, (lane - o) & 63); }
__device__ __forceinline__ float wave_sum(float v, int lane) {
#pragma unroll
    for (int o = 32; o >= 1; o >>= 1) v += shfl_xor_(v, o, lane);
    return v;
}
template <int N> __device__ __forceinline__ float dpp_shr(float old, float src) { return __int_as_float(__builtin_amdgcn_update_dpp(__float_as_int(old), __float_as_int(src), 0x110 + N, 0xf, 0xf, false)); }
template <int N> __device__ __forceinline__ float dpp_ror(float src) { return __int_as_float(__builtin_amdgcn_update_dpp(0, __float_as_int(src), 0x120 + N, 0xf, 0xf, false)); }
__device__ __forceinline__ bf16x8 frag_row(const LAS bf16_t* t, int ld, int r0, int k0, int fr, int fq) {
    return *(const LAS bf16x8*)(t + (r0 + fr) * ld + k0 + 8 * fq);
}
__device__ __forceinline__ bf16x8 frag_tr(const LAS bf16_t* t, int ld, int k0, int c0, int fr, int fq) {
    const LAS bf16_t* p = t + (k0 + 8 * fq + (fr >> 2)) * ld + c0 + 4 * (fr & 3);
    s16x4 lo = __builtin_bit_cast(s16x4, __builtin_amdgcn_ds_read_tr16_b64_v4i16((LAS s16x4*)p));
    s16x4 hi = __builtin_bit_cast(s16x4, __builtin_amdgcn_ds_read_tr16_b64_v4i16((LAS s16x4*)(p + 4 * ld)));
    bf16x8 r; r[0] = lo[0]; r[1] = lo[1]; r[2] = lo[2]; r[3] = lo[3]; r[4] = hi[0]; r[5] = hi[1]; r[6] = hi[2]; r[7] = hi[3]; return r;
}
#define MFMA(X, Y, C) __builtin_amdgcn_mfma_f32_16x16x32_bf16((X), (Y), (C), 0, 0, 0)

namespace pg8 {
constexpr int BM = 256, BK = 64, HALF = 128, HTB = HALF * BK * 2, NXCD = 8, WGM = 8;
__device__ __forceinline__ int lds_byte(int r, int c) { const int st = (r >> 4) * 2 + (c >> 5), rr = r & 15, cc = c & 31, ob = rr * 64 + cc * 2; return st * 1024 + (ob ^ (((ob >> 9) & 1) << 5)); }
__device__ __forceinline__ void stage_rc(int b, int& R, int& C) { const int st = b / 1024, sb = b % 1024, swz = sb ^ (((sb >> 9) & 1) << 5); R = (st >> 1) * 16 + swz / 64; C = (st & 1) * 32 + (swz % 64) / 2; }
__device__ __forceinline__ int perm32(int rho) { const int n = rho >> 4, i = rho & 15; return 8 * (i >> 2) + 4 * n + (i & 3); }
struct Unit { int pm, pn; };
struct Gemm { const bf16_t* A; const bf16_t* Bt; int M, N, K; };
struct StaticOrder {
    int nM, nN, nwg, G, c;
    __device__ void init(int M, int N, int G_, int c_) { nM = M / BM; nN = N / BM; nwg = nM * nN; G = G_; c = c_; }
    __device__ bool next(int i, Unit& u) const {
        const long L = (long)i * G + c; if (L >= nwg) return false;
        int wgid = (int)L; { const int q = nwg / NXCD, r = nwg % NXCD, xcd = wgid % NXCD, off = wgid / NXCD; wgid = (xcd < r ? xcd * (q + 1) : r * (q + 1) + (xcd - r) * q) + off; }
        const int nig = WGM * nN, gid = wgid / nig, fm = gid * WGM, gsz = (nM - fm) < WGM ? (nM - fm) : WGM;
        u.pm = fm + ((wgid % nig) % gsz); u.pn = (wgid % nig) / gsz; return true;
    }
};
template <class Epi>
__device__ __forceinline__ void gemm_phase(LAS unsigned char* lds, const Gemm g, const StaticOrder& S, const Epi& E) {
    const int tid = TIDX, wid = __builtin_amdgcn_readfirstlane(tid >> 6), lane = tid & 63, wr = wid >> 2, wc = wid & 3, fr = lane & 15, fq = lane >> 4;
    const int K = g.K, nt = K / BK;
    unsigned voffA[2], voffB[2];
#pragma unroll
    for (int i = 0; i < 2; ++i) { int R, C; stage_rc(tid * 16 + i * 8192, R, C); const int Rb = Epi::PERM ? ((R & ~31) + perm32(R & 31)) : R;
        voffA[i] = (unsigned)(R * K + C) * 2u; voffB[i] = (unsigned)(Rb * K + C) * 2u; }
    const size_t kstep = (size_t)(BK * 2);
    const size_t hstep = (size_t)HALF * K * 2;
    const size_t tstep = 2 * hstep;
    const unsigned ldsw = (unsigned)wid * 1024u;
    const int aoff = lds_byte(wr * 64 + fr, fq * 8), boff = lds_byte(wc * 32 + fr, fq * 8);
#define PG8_SA(b, h) (((b) * 2 + (h)) * HTB)
#define PG8_SB(b, h) ((4 + (b) * 2 + (h)) * HTB)
#define PG8_STAGE(bufoff, gbase, voff) do { _Pragma("unroll") for (int _i = 0; _i < 2; ++_i) \
        __builtin_amdgcn_global_load_lds((const unsigned*)((const char*)(gbase) + (voff)[_i]), (LAS unsigned*)(lds + (bufoff) + ldsw + _i * 8192), 16, 0, 0); } while (0)
#define PG8_LDA(dst, b, h) do { _Pragma("unroll") for (int m = 0; m < 4; ++m) _Pragma("unroll") for (int k = 0; k < 2; ++k) dst[m][k] = *(const LAS bf16x8*)(lds + PG8_SA(b, h) + aoff + m * 2048 + k * 1024); } while (0)
#define PG8_LDB(dst, b, h) do { _Pragma("unroll") for (int n = 0; n < 2; ++n) _Pragma("unroll") for (int k = 0; k < 2; ++k) dst[n][k] = *(const LAS bf16x8*)(lds + PG8_SB(b, h) + boff + n * 2048 + k * 1024); } while (0)
#define PG8_MMA(ai, bj, At, Bt) do { __builtin_amdgcn_s_setprio(1); _Pragma("unroll") for (int m = 0; m < 4; ++m) _Pragma("unroll") for (int n = 0; n < 2; ++n) _Pragma("unroll") for (int k = 0; k < 2; ++k) \
        acc[ai][bj][m][n] = __builtin_amdgcn_mfma_f32_16x16x32_bf16(Bt[n][k], At[m][k], acc[ai][bj][m][n], 0, 0, 0); __builtin_amdgcn_s_setprio(0); } while (0)
#define PG8_WAIT_V(n) asm volatile("s_waitcnt vmcnt(" #n ")" ::: "memory")
#define PG8_WAIT_L(n) asm volatile("s_waitcnt lgkmcnt(" #n ")" ::: "memory")
#define PG8_BAR __builtin_amdgcn_s_barrier()
#define PG8_SCHED __builtin_amdgcn_sched_barrier(0)
    Unit cur, nxt; int ui = 0;
    if (!S.next(0, cur)) return;
    f32x4 acc[2][2][4][2];
#pragma unroll
    for (int a = 0; a < 2; ++a)
#pragma unroll
        for (int b = 0; b < 2; ++b)
#pragma unroll
            for (int m = 0; m < 4; ++m)
#pragma unroll
                for (int n = 0; n < 2; ++n) acc[a][b][m][n] = (f32x4){0.f, 0.f, 0.f, 0.f};
    bf16x8 At[4][2], B0[2][2], B1[2][2];
    const char* cA = (const char*)g.A + (size_t)cur.pm * tstep; const char* cB = (const char*)g.Bt + (size_t)cur.pn * tstep;
    PG8_STAGE(PG8_SB(0, 0), cB, voffB); PG8_STAGE(PG8_SA(0, 0), cA, voffA); PG8_STAGE(PG8_SB(0, 1), cB + hstep, voffB); PG8_STAGE(PG8_SA(0, 1), cA + hstep, voffA);
    if (wr == 1) PG8_BAR;
    PG8_WAIT_V(4); PG8_BAR;
    PG8_STAGE(PG8_SB(1, 0), cB + kstep, voffB); PG8_STAGE(PG8_SA(1, 0), cA + kstep, voffA); PG8_STAGE(PG8_SB(1, 1), cB + hstep + kstep, voffB);
    PG8_WAIT_V(6); PG8_BAR;
    for (;;) {
        const bool has_next = S.next(ui + 1, nxt);
        const char* nA = has_next ? (const char*)g.A + (size_t)nxt.pm * tstep : cA; const char* nB = has_next ? (const char*)g.Bt + (size_t)nxt.pn * tstep : cB;
        for (int t = 0; t < nt; t += 2) {
            const bool last = (t == nt - 2);
            const char* a1 = cA + (size_t)(t + 1) * kstep;
            const char* a2 = last ? nA : cA + (size_t)(t + 2) * kstep; const char* b2 = last ? nB : cB + (size_t)(t + 2) * kstep;
            const char* a3 = a2 + kstep; const char* b3 = b2 + kstep;
            PG8_LDB(B0, 0, 0); PG8_SCHED; PG8_LDA(At, 0, 0); PG8_STAGE(PG8_SA(1, 1), a1 + hstep, voffA);
            PG8_WAIT_L(8); PG8_BAR; PG8_WAIT_L(0); PG8_MMA(0, 0, At, B0); PG8_BAR; PG8_SCHED;
            PG8_LDB(B1, 0, 1); PG8_STAGE(PG8_SB(0, 0), b2, voffB);
            PG8_BAR; PG8_WAIT_L(0); PG8_MMA(0, 1, At, B1); PG8_BAR;
            PG8_LDA(At, 0, 1); PG8_STAGE(PG8_SA(0, 0), a2, voffA);
            PG8_BAR; PG8_WAIT_L(0); PG8_MMA(1, 0, At, B0); PG8_BAR; PG8_SCHED;
            PG8_STAGE(PG8_SB(0, 1), b2 + hstep, voffB);
            PG8_WAIT_V(6); PG8_BAR; PG8_MMA(1, 1, At, B1); PG8_BAR;
            PG8_LDB(B0, 1, 0); PG8_SCHED; PG8_LDA(At, 1, 0); PG8_STAGE(PG8_SA(0, 1), a2 + hstep, voffA);
            PG8_WAIT_L(8); PG8_BAR; PG8_WAIT_L(0); PG8_MMA(0, 0, At, B0); PG8_BAR; PG8_SCHED;
            PG8_LDB(B1, 1, 1); PG8_STAGE(PG8_SB(1, 0), b3, voffB);
            PG8_BAR; PG8_WAIT_L(0); PG8_MMA(0, 1, At, B1); PG8_BAR;
            PG8_LDA(At, 1, 1); PG8_STAGE(PG8_SA(1, 0), a3, voffA);
            PG8_BAR; PG8_WAIT_L(0); PG8_MMA(1, 0, At, B0); PG8_BAR; PG8_SCHED;
            PG8_STAGE(PG8_SB(1, 1), b3 + hstep, voffB);
            PG8_WAIT_V(6); PG8_BAR; PG8_MMA(1, 1, At, B1); PG8_BAR;
        }
        if constexpr (Epi::AFTER_DRAIN) { if (has_next) E(acc, cur, wr, wc, fr, fq); } else E(acc, cur, wr, wc, fr, fq);
        if (!has_next) break;
#pragma unroll
        for (int a = 0; a < 2; ++a)
#pragma unroll
            for (int b = 0; b < 2; ++b)
#pragma unroll
                for (int m = 0; m < 4; ++m)
#pragma unroll
                    for (int n = 0; n < 2; ++n) acc[a][b][m][n] = (f32x4){0.f, 0.f, 0.f, 0.f};
        cur = nxt; cA = nA; cB = nB; ++ui;
    }
    PG8_WAIT_V(0);
    if (wr == 0) PG8_BAR;
    PG8_BAR;
    if constexpr (Epi::AFTER_DRAIN) E.fused(acc, cur, wr, wc, fr, fq, lds, wid, lane);
#undef PG8_SA
#undef PG8_SB
#undef PG8_STAGE
#undef PG8_LDA
#undef PG8_LDB
#undef PG8_MMA
#undef PG8_WAIT_V
#undef PG8_WAIT_L
#undef PG8_BAR
#undef PG8_SCHED
}
struct EpiBf16 {
    static constexpr bool PERM = true, AFTER_DRAIN = false;
    bf16_t* O; int ldc; const u64* rss;
    __device__ __forceinline__ void operator()(const f32x4 (&acc)[2][2][4][2], const Unit& u, int wr, int wc, int fr, int fq) const {
        const int row0 = u.pm * BM + wr * 64 + fr, col0 = u.pn * BM + wc * 32 + 8 * fq;
        u64 rv[2][4];
#pragma unroll
        for (int ai = 0; ai < 2; ++ai)
#pragma unroll
            for (int m = 0; m < 4; ++m) rv[ai][m] = rss[row0 + ai * HALF + m * 16];
#pragma unroll
        for (int ai = 0; ai < 2; ++ai)
#pragma unroll
            for (int m = 0; m < 4; ++m) { const int row = row0 + ai * HALF + m * 16; bf16_t* rowp = O + (size_t)row * ldc + col0;
                const float rs = rstd_fix(rv[ai][m]);
#pragma unroll
                for (int bj = 0; bj < 2; ++bj) { const f32x4 v0 = acc[ai][bj][m][0] * rs, v1 = acc[ai][bj][m][1] * rs;
                    u32x4 w; w.x = pk2(v0[0], v0[1]); w.y = pk2(v0[2], v0[3]); w.z = pk2(v1[0], v1[1]); w.w = pk2(v1[2], v1[3]);
                    *(u32x4*)(rowp + bj * HALF) = w; } }
    }
};
struct EpiResid {
    static constexpr bool PERM = false, AFTER_DRAIN = true;
    int ldc; bf16_t* xb; u64* rss;
    __device__ __forceinline__ void operator()(const f32x4 (&acc)[2][2][4][2], const Unit& u, int wr, int wc, int fr, int fq) const {
        const int row0 = u.pm * BM + wr * 64 + fr, col0 = u.pn * BM + wc * 32 + 4 * fq, lane = fr | (fq << 4);
#pragma unroll
        for (int ai = 0; ai < 2; ++ai)
#pragma unroll
            for (int m = 0; m < 4; ++m) { const int row = row0 + ai * HALF + m * 16; bf16_t* xbp = xb + (size_t)row * ldc + col0;
                float ss = 0.f;
#pragma unroll
                for (int bj = 0; bj < 2; ++bj)
#pragma unroll
                    for (int n = 0; n < 2; ++n) { u32x2* pp = (u32x2*)(xbp + bj * HALF + n * 16); float o[4]; unpack4(*pp, o);
                        u32x2 w; w.x = pk2(o[0] + acc[ai][bj][m][n][0], o[1] + acc[ai][bj][m][n][1]); w.y = pk2(o[2] + acc[ai][bj][m][n][2], o[3] + acc[ai][bj][m][n][3]); *pp = w;
                        unpack4(w, o); ss += o[0] * o[0] + o[1] * o[1] + o[2] * o[2] + o[3] * o[3]; }
                ss += shfl_xor_(ss, 16, lane); ss += shfl_xor_(ss, 32, lane);
                if (fq == 0) atomicAdd(rss + row, ss_fix(ss)); }
    }
    __device__ __forceinline__ void fused(const f32x4 (&acc)[2][2][4][2], const Unit& u, int wr, int wc, int fr, int fq, LAS unsigned char* lds, int wid, int lane) const {
        LAS f32x4* t = (LAS f32x4*)lds;
#pragma unroll
        for (int ai = 0; ai < 2; ++ai) {
            const int rbase = u.pm * BM + ai * HALF + wid * 16, col = u.pn * BM + lane * 4;
            u32x2 xv[16];
#pragma unroll
            for (int i = 0; i < 16; ++i) xv[i] = *(const u32x2*)(xb + (size_t)(rbase + i) * ldc + col);
#pragma unroll
            for (int m = 0; m < 4; ++m)
#pragma unroll
                for (int bj = 0; bj < 2; ++bj)
#pragma unroll
                    for (int n = 0; n < 2; ++n) { const int r = 64 * wr + 16 * m + fr, chunk = 32 * bj + 8 * wc + 4 * n + fq; t[r * 64 + (chunk ^ (r & 15))] = acc[ai][bj][m][n]; }
            __syncthreads();
            float myss = 0.f;
#pragma unroll
            for (int i = 0; i < 16; ++i) { const int r = wid * 16 + i;
                const f32x4 a = t[r * 64 + (lane ^ (r & 15))]; float o[4]; unpack4(xv[i], o);
                u32x2 w; w.x = pk2(o[0] + a[0], o[1] + a[1]); w.y = pk2(o[2] + a[2], o[3] + a[3]); *(u32x2*)(xb + (size_t)(rbase + i) * ldc + col) = w;
                unpack4(w, o);
                const float ss = wave_sum(o[0] * o[0] + o[1] * o[1] + o[2] * o[2] + o[3] * o[3], lane);
                if (lane == i) myss = ss; }
            if (lane < 16) atomicAdd(rss + rbase + lane, ss_fix(myss));
            __syncthreads();
        }
    }
};
struct EpiAct {
    static constexpr bool PERM = true, AFTER_DRAIN = false;
    bf16_t* act; const u64* rss; const float* cw; const float* cb; bf16_t* gs01; bf16_t* us01; bf16_t* gs23; float* fcp;
    __device__ __forceinline__ void operator()(const f32x4 (&acc)[2][2][4][2], const Unit& u, int wr, int wc, int fr, int fq) const {
        const int row0 = u.pm * BM + wr * 64 + fr, f0 = u.pn * HALF + wc * 32 + 8 * fq;
        float w0[8], w1[8], w2[8], bb[8];
        *(f32x4*)w0 = *(const f32x4*)(cw + f0); *(f32x4*)(w0 + 4) = *(const f32x4*)(cw + f0 + 4);
        *(f32x4*)w1 = *(const f32x4*)(cw + DFF + f0); *(f32x4*)(w1 + 4) = *(const f32x4*)(cw + DFF + f0 + 4);
        *(f32x4*)w2 = *(const f32x4*)(cw + 2 * DFF + f0); *(f32x4*)(w2 + 4) = *(const f32x4*)(cw + 2 * DFF + f0 + 4);
        *(f32x4*)bb = *(const f32x4*)(cb + f0); *(f32x4*)(bb + 4) = *(const f32x4*)(cb + f0 + 4);
        u64 rv[2][4];
#pragma unroll
        for (int ai = 0; ai < 2; ++ai)
#pragma unroll
            for (int m = 0; m < 4; ++m) rv[ai][m] = rss[row0 + ai * HALF + m * 16];
#pragma unroll
        for (int ai = 0; ai < 2; ++ai) {
            float gp[8];
#pragma unroll
            for (int e = 0; e < 8; ++e) gp[e] = 0.f;
#pragma unroll
            for (int m = 0; m < 4; ++m) {
                const int row = row0 + ai * HALF + m * 16;
                const float rs = rstd_fix(rv[ai][m]);
                float g[8], up[8], o[8];
                { const f32x4 g0 = acc[ai][0][m][0] * rs, g1 = acc[ai][0][m][1] * rs, u0 = acc[ai][1][m][0] * rs, u1 = acc[ai][1][m][1] * rs;
#pragma unroll
                  for (int i = 0; i < 4; ++i) { g[i] = g0[i]; g[4 + i] = g1[i]; up[i] = u0[i]; up[4 + i] = u1[i]; } }
#pragma unroll
                for (int e2 = 0; e2 < 4; ++e2) {
                    const int e = 2 * e2;
                    const f32x2 gv = {g[e], g[e + 1]};
                    const f32x2 g1v = {dpp_shr<1>(dpp_ror<1>(gp[e]), g[e]), dpp_shr<1>(dpp_ror<1>(gp[e + 1]), g[e + 1])};
                    const f32x2 g2v = {dpp_shr<2>(dpp_ror<2>(gp[e]), g[e]), dpp_shr<2>(dpp_ror<2>(gp[e + 1]), g[e + 1])};
                    const f32x2 w0v = {w0[e], w0[e + 1]}, w1v = {w1[e], w1[e + 1]}, w2v = {w2[e], w2[e + 1]}, bbv = {bb[e], bb[e + 1]}, upv = {up[e], up[e + 1]};
                    const f32x2 y = __builtin_elementwise_fma(w0v, g2v, __builtin_elementwise_fma(w1v, g1v, __builtin_elementwise_fma(w2v, gv, bbv)));
                    const f32x2 z = y * __builtin_elementwise_fma(y * y, (f32x2){0.1029432397f, 0.1029432397f}, (f32x2){2.302208198f, 2.302208198f});
                    f32x2 d; d.x = __builtin_amdgcn_exp2f(z.x); d.y = __builtin_amdgcn_exp2f(z.y);
                    d = d + 1.0f;
                    f32x2 r; r.x = __builtin_amdgcn_rcpf(d.x); r.y = __builtin_amdgcn_rcpf(d.y);
                    const f32x2 ov = __builtin_elementwise_fma(-y, r, y) * upv;
                    o[e] = ov.x; o[e + 1] = ov.y;
                }
                if (m == 0 && fr < 2) {
                    const size_t so = ((size_t)(row >> 6) * 2 + fr) * DFF + f0;
                    *(u32x4*)(gs01 + so) = pack8(g); *(u32x4*)(us01 + so) = pack8(up);
                } else *(u32x4*)(act + (size_t)row * DFF + f0) = pack8(o);
                if (m == 3 && fr >= 14) *(u32x4*)(gs23 + ((size_t)(row >> 6) * 2 + (fr - 14)) * DFF + f0) = pack8(g);
                const int ts = row & (SEQ - 1);
                if (ts >= SEQ - 2) { float* fo = fcp + ((size_t)(row >> 11) * 2 + (ts - (SEQ - 2))) * DFF + f0;
                    *(f32x4*)fo = (f32x4){g[0], g[1], g[2], g[3]}; *(f32x4*)(fo + 4) = (f32x4){g[4], g[5], g[6], g[7]}; }
#pragma unroll
                for (int e = 0; e < 8; ++e) gp[e] = g[e];
            }
        }
    }
};
struct EpiDry {
    static constexpr bool PERM = false, AFTER_DRAIN = false;
    float* C;
    __device__ __forceinline__ void operator()(const f32x4 (&acc)[2][2][4][2], const Unit& u, int wr, int wc, int fr, int fq) const {
        float s = 0.f;
#pragma unroll
        for (int ai = 0; ai < 2; ++ai)
#pragma unroll
            for (int bj = 0; bj < 2; ++bj)
#pragma unroll
                for (int m = 0; m < 4; ++m)
#pragma unroll
                    for (int n = 0; n < 2; ++n) s += acc[ai][bj][m][n][0] + acc[ai][bj][m][n][1] + acc[ai][bj][m][n][2] + acc[ai][bj][m][n][3];
        if (s != s) C[0] = s;
    }
};
}

template <int K, int MODE  >
__device__ __forceinline__ void thin_gemm(LAS unsigned char* lds, const bf16_t* A, const bf16_t* Bt, int N, void* out, int ldc, bf16_t* xb, u64* rss) {
    const int tid = TIDX, wid = tid >> 6, lane = tid & 63, fr = lane & 15, fq = lane >> 4;
    constexpr int KW = K / 8, STEPS = KW / 32;
    const int ntask = (N / 16) * 8;
    LAS f32x4* red = (LAS f32x4*)lds;
    const int per = (ntask + (int)gridDim.x - 1) / (int)gridDim.x, t0 = blockIdx.x * per, t1 = min(ntask, t0 + per);
    for (int base = t0; base < t1; base += 8) {
        const int nr = min(8, t1 - base);
#pragma unroll (STEPS <= 4 ? 4 : 2)
        for (int i = 0; i < nr; ++i) {
            const int t = base + i, ct = t >> 3, rt = t & 7;
            const bf16_t* ap = A + (size_t)(rt * 16 + fr) * K + wid * KW + 8 * fq;
            const bf16_t* bp = Bt + (size_t)(ct * 16 + fr) * K + wid * KW + 8 * fq;
            bf16x8 a[STEPS], b[STEPS];
#pragma unroll
            for (int s = 0; s < STEPS; ++s) { a[s] = *(const bf16x8*)(ap + 32 * s); b[s] = *(const bf16x8*)(bp + 32 * s); }
            f32x4 acc = {0.f, 0.f, 0.f, 0.f};
#pragma unroll
            for (int s = 0; s < STEPS; ++s) acc = MFMA(b[s], a[s], acc);
            red[(i * 8 + wid) * 64 + lane] = acc;
        }
        __syncthreads();
        if (wid < nr) {
            const int t = base + wid, ct = t >> 3, rt = t & 7;
            f32x4 s = red[(wid * 8) * 64 + lane];
#pragma unroll
            for (int w = 1; w < 8; ++w) s = s + red[(wid * 8 + w) * 64 + lane];
            const int row = rt * 16 + fr, col = ct * 16 + 4 * fq;
            if (MODE == 0) { const float rs = rstd_fix(rss[row]);
                u32x2 w2; w2.x = pk2(s[0] * rs, s[1] * rs); w2.y = pk2(s[2] * rs, s[3] * rs); *(u32x2*)((bf16_t*)out + (size_t)row * ldc + col) = w2; }
            else { u32x2* pp = (u32x2*)(xb + (size_t)row * ldc + col); float o[4]; unpack4(*pp, o);
                u32x2 w2; w2.x = pk2(o[0] + s[0], o[1] + s[1]); w2.y = pk2(o[2] + s[2], o[3] + s[3]); *pp = w2;
                unpack4(w2, o);
                float ss = o[0] * o[0] + o[1] * o[1] + o[2] * o[2] + o[3] * o[3];
                ss += shfl_xor_(ss, 16, lane); ss += shfl_xor_(ss, 32, lane);
                if (fq == 0) atomicAdd(rss + row, ss_fix(ss)); }
        }
        __syncthreads();
    }
}

__device__ __forceinline__ void thin_gemm_act(LAS unsigned char* lds, const bf16_t* A, const bf16_t* Bt, const u64* rss, const float* cw, const float* cb, const float* st, float* fo, bf16_t* act, int c0, int cnt) {
    const int tid = TIDX, wid = tid >> 6, lane = tid & 63, fr = lane & 15, fq = lane >> 4;
    constexpr int K = DM, KW = K / 8, STEPS = KW / 32;
    const int ntask = (DFF / 16) * 8;
    LAS f32x4* red = (LAS f32x4*)lds;
    if ((int)blockIdx.x < c0) return;
    const int per = (ntask + cnt - 1) / cnt, t0 = ((int)blockIdx.x - c0) * per, t1 = min(ntask, t0 + per);
    for (int base = t0; base < t1; base += 8) {
        const int nr = min(8, t1 - base);
#pragma unroll 2
        for (int i = 0; i < nr; ++i) {
            const int t = base + i, ft = t >> 3, rt = t & 7;
            const int f = ft * 16 + fr, wrow = 256 * (f >> 7) + (f & 127);
            const bf16_t* ap = A + (size_t)(rt * 16 + fr) * K + wid * KW + 8 * fq;
            const bf16_t* bg = Bt + (size_t)wrow * K + wid * KW + 8 * fq;
            const bf16_t* bu = bg + (size_t)128 * K;
            bf16x8 a[STEPS], b1[STEPS], b2[STEPS];
#pragma unroll
            for (int s = 0; s < STEPS; ++s) { a[s] = *(const bf16x8*)(ap + 32 * s); b1[s] = *(const bf16x8*)(bg + 32 * s); b2[s] = *(const bf16x8*)(bu + 32 * s); }
            f32x4 ag = {0.f, 0.f, 0.f, 0.f}, au = {0.f, 0.f, 0.f, 0.f};
#pragma unroll
            for (int s = 0; s < STEPS; ++s) { ag = MFMA(b1[s], a[s], ag); au = MFMA(b2[s], a[s], au); }
            red[(i * 8 + wid) * 64 + lane] = ag; red[4096 + (i * 8 + wid) * 64 + lane] = au;
        }
        __syncthreads();
        if (wid < nr) {
            const int t = base + wid, ft = t >> 3, rt = t & 7;
            f32x4 g = red[(wid * 8) * 64 + lane], up = red[4096 + (wid * 8) * 64 + lane];
#pragma unroll
            for (int w = 1; w < 8; ++w) { g = g + red[(wid * 8 + w) * 64 + lane]; up = up + red[4096 + (wid * 8 + w) * 64 + lane]; }
            const int s = rt * 16 + fr, f = ft * 16 + 4 * fq;
            const float rs = rstd_fix(rss[s]);
            g = g * rs; up = up * rs;
            const f32x4 p0 = *(const f32x4*)(st + ((size_t)s * 2 + 0) * DFF + f), p1 = *(const f32x4*)(st + ((size_t)s * 2 + 1) * DFF + f);
            const f32x4 c0 = *(const f32x4*)(cw + f), c1 = *(const f32x4*)(cw + DFF + f), c2 = *(const f32x4*)(cw + 2 * DFF + f), cbv = *(const f32x4*)(cb + f);
            float o[4];
#pragma unroll
            for (int e = 0; e < 4; ++e) o[e] = geluf_(cbv[e] + c0[e] * p0[e] + c1[e] * p1[e] + c2[e] * g[e]) * up[e];
            u32x2 w2; w2.x = pk2(o[0], o[1]); w2.y = pk2(o[2], o[3]); *(u32x2*)(act + (size_t)s * DFF + f) = w2;
            *(f32x4*)(fo + ((size_t)s * 2 + 0) * DFF + f) = p1; *(f32x4*)(fo + ((size_t)s * 2 + 1) * DFF + f) = g;
        }
        __syncthreads();
    }
}
__device__ __forceinline__ void act_fixup(const Params& p, int l, int pm) {
    const bf16_t* gs01 = (const bf16_t*)(p.ws + W_GS01); const bf16_t* us01 = (const bf16_t*)(p.ws + W_US01); const bf16_t* gs23 = (const bf16_t*)(p.ws + W_GS23);
    bf16_t* act = (bf16_t*)(p.ws + W_DS);
    const float* cw = p.in[27] + (size_t)l * 3 * DFF; const float* cb = p.in[28] + (size_t)l * DFF;
    const int tid = TIDX;
    constexpr int NU = 8 * (DFF / 8), NK = (NU + 511) / 512;
    u32x4 rg[NK], ru[NK], r1[NK], r2[NK];
#pragma unroll
    for (int k = 0; k < NK; ++k) {
        const int idx = tid + 512 * k;
        rg[k] = ru[k] = r1[k] = r2[k] = (u32x4){0u, 0u, 0u, 0u};
        if (idx < NU) {
            const int rsel = idx / (DFF / 8), c0 = (idx % (DFF / 8)) * 8, blk = pm * 4 + (rsel >> 1), rr = rsel & 1;
            const bool seq0 = (blk & 31) == 0;
            rg[k] = *(const u32x4*)(gs01 + ((size_t)blk * 2 + rr) * DFF + c0);
            ru[k] = *(const u32x4*)(us01 + ((size_t)blk * 2 + rr) * DFF + c0);
            if (rr == 0) { if (!seq0) { r1[k] = *(const u32x4*)(gs23 + ((size_t)(blk - 1) * 2 + 1) * DFF + c0); r2[k] = *(const u32x4*)(gs23 + ((size_t)(blk - 1) * 2 + 0) * DFF + c0); } }
            else { r1[k] = *(const u32x4*)(gs01 + ((size_t)blk * 2 + 0) * DFF + c0); if (!seq0) r2[k] = *(const u32x4*)(gs23 + ((size_t)(blk - 1) * 2 + 1) * DFF + c0); }
        }
    }
#pragma unroll
    for (int k = 0; k < NK; ++k) {
        const int idx = tid + 512 * k;
        if (idx < NU) {
            const int rsel = idx / (DFF / 8), c0 = (idx % (DFF / 8)) * 8, blk = pm * 4 + (rsel >> 1), rr = rsel & 1;
            float g[8], up[8], g1[8], g2[8], o[8];
            unpack8(rg[k], g); unpack8(ru[k], up); unpack8(r1[k], g1); unpack8(r2[k], g2);
#pragma unroll
            for (int e = 0; e < 8; ++e) o[e] = geluf_(cb[c0 + e] + cw[c0 + e] * g2[e] + cw[DFF + c0 + e] * g1[e] + cw[2 * DFF + c0 + e] * g[e]) * up[e];
            *(u32x4*)(act + ((size_t)blk * 64 + rr) * DFF + c0) = pack8(o);
        }
    }
}

__device__ void phase_prep(const Params& p, LAS unsigned char* lds) {
    const int tid = TIDX;
    LAS float* tl = (LAS float*)lds;
    for (int grp = blockIdx.x; grp < DEPTH * 3520 / 4; grp += gridDim.x) {
        const float* src[4]; bf16_t* dst[4]; int Ks[4], ldns[4]; const float* gs[4];
        f32x4 v[4][2];
#pragma unroll
        for (int q = 0; q < 4; ++q) {
            const int idx = grp * 4 + q;
            const int l = idx / 3520; int r = idx % 3520;
            int kt, nt;
            if (r < 1024) { gs[q] = p.in[8] + l * DM; src[q] = p.in[9] + (size_t)l * DM * DIN; ldns[q] = DIN; Ks[q] = DM; dst[q] = (bf16_t*)(p.ws + W_WIN) + (size_t)l * NPROJ * DM; nt = r % 64; kt = r / 64; }
            else if (r < 1408) { r -= 1024; gs[q] = nullptr; src[q] = p.in[24] + (size_t)l * DMIX * DM; ldns[q] = DM; Ks[q] = DMIX; dst[q] = (bf16_t*)(p.ws + W_WOUT) + (size_t)l * DM * DMIX; nt = r % 16; kt = r / 16; }
            else if (r < 2816) { r -= 1408; gs[q] = p.in[25] + l * DM; src[q] = p.in[26] + (size_t)l * DM * DGU; ldns[q] = DGU; Ks[q] = DM; dst[q] = (bf16_t*)(p.ws + W_WUP) + (size_t)l * DGU * DM; nt = r % 88; kt = r / 88; }
            else { r -= 2816; gs[q] = nullptr; src[q] = p.in[29] + (size_t)l * DFF * DM; ldns[q] = DM; Ks[q] = DFF; dst[q] = (bf16_t*)(p.ws + W_WDOWN) + (size_t)l * DM * DFF; nt = r % 16; kt = r / 16; }
            int drow = nt * 64;
            if (ldns[q] == DGU) { const int f = drow < DFF ? drow : drow - DFF; drow = 256 * (f >> 7) + (f & 127) + (drow < DFF ? 0 : 128); }
            src[q] += (size_t)(kt * 64) * ldns[q] + nt * 64; dst[q] += (size_t)drow * Ks[q] + kt * 64;
#pragma unroll
            for (int ps = 0; ps < 2; ++ps) { v[q][ps] = __builtin_nontemporal_load((const f32x4*)(src[q] + (size_t)((tid >> 4) + ps * 32) * ldns[q] + (tid & 15) * 4)); if (gs[q]) v[q][ps] = v[q][ps] * gs[q][kt * 64 + (tid >> 4) + ps * 32]; }
        }
#pragma unroll
        for (int q = 0; q < 4; ++q)
#pragma unroll
            for (int ps = 0; ps < 2; ++ps) { LAS float* t = tl + q * 4160 + ((tid >> 4) + ps * 32) * 65 + (tid & 15) * 4; t[0] = v[q][ps][0]; t[1] = v[q][ps][1]; t[2] = v[q][ps][2]; t[3] = v[q][ps][3]; }
        __syncthreads();
#pragma unroll
        for (int q = 0; q < 4; ++q) {
            const int n = tid >> 3, kq = tid & 7;
            float f[8];
#pragma unroll
            for (int e = 0; e < 8; ++e) f[e] = tl[q * 4160 + (8 * kq + e) * 65 + n];
            *(u32x4*)(dst[q] + (size_t)n * Ks[q] + 8 * kq) = pack8(f);
        }
        __syncthreads();
    }
    const int gt = blockIdx.x * 512 + tid, gn = gridDim.x * 512;
    {
        bf16_t* wrT = (bf16_t*)(p.ws + W_LRUW); bf16_t* wiT = wrT + DEPTH * 8 * 64 * 64;
        for (int i = gt; i < DEPTH * 8 * 64 * 64; i += gn) {
            const int lh = i >> 12, j = (i >> 6) & 63, ii = i & 63;
            wrT[i] = f2bf(p.in[12][(size_t)lh * 4096 + ii * 64 + j]);
            wiT[i] = f2bf(p.in[14][(size_t)lh * 4096 + ii * 64 + j]);
        }
    }
    {
        float* rc = (float*)(p.ws + W_ROPE); float* rs = rc + 2049 * 32;
        for (int i = gt; i < 2049 * 32; i += gn) {
            const int pos = (i >> 5) < 2048 ? (i >> 5) : 16384; const int d = i & 31;
            const float freq = powf(10000.f, -(float)d / 32.f);
            const float ang = (float)pos * freq;
            rc[i] = cosf(ang); rs[i] = sinf(ang);
        }
    }
    {
        bf16_t* wdt = (bf16_t*)(p.ws + W_WDT);
        for (int i = gt; i < DEPTH * 16 * DM; i += gn) {
            const int l = i >> 14, j = (i >> 10) & 15, k = i & 1023;
            wdt[i] = j < 8 ? f2bf(p.in[8][l * DM + k] * p.in[9][((size_t)l * DM + k) * DIN + NPROJ + j]) : (bf16_t)0;
        }
    }
    {
        u64* rss = (u64*)(p.ws + W_RSS);
        for (int i = gt; i < 8 * TT; i += gn) rss[TT + i] = 0ull;
    }
    {
        const int wid = tid >> 6, lane = tid & 63;
        bf16_t* xb = (bf16_t*)(p.ws + W_XB); u64* rss = (u64*)(p.ws + W_RSS);
        const int nw = gridDim.x * 8;
        for (int row0 = blockIdx.x * 8 + wid; row0 < TT; row0 += 4 * nw) {
            f32x4 v[4][4];
#pragma unroll
            for (int r = 0; r < 4; ++r) { const int row = row0 + r * nw; const float* src = row < TP ? p.in[0] + (size_t)row * DM : p.in[1] + (size_t)(row - TP) * DM;
#pragma unroll
                for (int i = 0; i < 4; ++i) v[r][i] = row < TT ? __builtin_nontemporal_load((const f32x4*)(src + i * 256 + lane * 4)) : (f32x4){0.f, 0.f, 0.f, 0.f}; }
#pragma unroll
            for (int r = 0; r < 4; ++r) { const int row = row0 + r * nw; float ss = 0.f;
                if (row < TT) {
#pragma unroll
                    for (int i = 0; i < 4; ++i) { u32x2 w; w.x = pk2(v[r][i][0], v[r][i][1]); w.y = pk2(v[r][i][2], v[r][i][3]); *(u32x2*)(xb + (size_t)row * DM + i * 256 + lane * 4) = w;
                        float o[4]; unpack4(w, o); ss += o[0] * o[0] + o[1] * o[1] + o[2] * o[2] + o[3] * o[3]; }
                }
                ss = wave_sum(ss, lane);
                if (lane == 0 && row < TT) rss[row] = ss_fix(ss);
            }
        }
    }
}

__device__ void phase_dt(const Params& p, int l) {
    const int tid = TIDX, wid = tid >> 6, lane = tid & 63, fr = lane & 15, fq = lane >> 4;
    const bf16_t* xb = (const bf16_t*)(p.ws + W_XB); const bf16_t* wdt = (const bf16_t*)(p.ws + W_WDT) + (size_t)l * 16 * DM;
    const u64* rss = (const u64*)(p.ws + W_RSS) + (size_t)(2 * l) * TT; float* dtraw = (float*)(p.ws + W_DT);
    for (int tile = blockIdx.x * 8 + wid; tile < TT / 16; tile += gridDim.x * 8) {
        const bf16_t* ap = xb + (size_t)(tile * 16 + fr) * DM + 8 * fq; const bf16_t* bp = wdt + (size_t)fr * DM + 8 * fq;
        f32x4 acc = {0.f, 0.f, 0.f, 0.f};
#pragma unroll 16
        for (int s = 0; s < 32; ++s) acc = MFMA(*(const bf16x8*)(bp + 32 * s), *(const bf16x8*)(ap + 32 * s), acc);
        const int row = tile * 16 + fr;
        if (fq < 2) { const float rs = rstd_fix(rss[row]); *(f32x4*)(dtraw + (size_t)row * 8 + 4 * fq) = acc * rs; }
    }
}

__device__ void phase_final(const Params& p) {
    const int tid = TIDX, wid = tid >> 6, lane = tid & 63;
    const bf16_t* xb = (const bf16_t*)(p.ws + W_XB);
    const float* g = p.in[30];
    f32x4 g4[4];
#pragma unroll
    for (int i = 0; i < 4; ++i) g4[i] = *(const f32x4*)(g + i * 256 + lane * 4);
    const int nw = gridDim.x * 8;
    for (int row0 = blockIdx.x * 8 + wid; row0 < TT; row0 += 4 * nw) {
        u32x2 raw[4][4];
#pragma unroll
        for (int r = 0; r < 4; ++r) { const int row = row0 + r * nw;
#pragma unroll
            for (int i = 0; i < 4; ++i) raw[r][i] = row < TT ? *(const u32x2*)(xb + (size_t)row * DM + i * 256 + lane * 4) : (u32x2){0u, 0u}; }
#pragma unroll
        for (int r = 0; r < 4; ++r) { const int row = row0 + r * nw;
            f32x4 v[4]; float ss = 0.f;
#pragma unroll
            for (int i = 0; i < 4; ++i) { float o[4]; unpack4(raw[r][i], o); v[i] = (f32x4){o[0], o[1], o[2], o[3]}; ss += o[0] * o[0] + o[1] * o[1] + o[2] * o[2] + o[3] * o[3]; }
            ss = wave_sum(ss, lane);
            const float rstd = rsqrtf(ss * (1.f / DM) + EPS);
            if (row < TT) {
#pragma unroll
                for (int i = 0; i < 4; ++i) __builtin_nontemporal_store(v[i] * rstd * g4[i], (f32x4*)(p.out + (size_t)row * DM + i * 256 + lane * 4));
            }
        }
    }
}


__device__ __forceinline__ float ret_logg(int h) { return log1pf(-exp2f(-5.f - (float)h)); }

template <class CM, class F>
__device__ __forceinline__ void conv64(const bf16_t* proj, int row0, int tseq0, int pc0, const float* cw, const float* cb, int C, int nchunks, CM&& chmap, F&& emit) {
    for (int u = TIDX; u < nchunks * 8; u += 512) {
        const int q = u % nchunks, seg = u / nchunks, c = chmap(q), j0 = seg * 8;
        const bf16_t* src = proj + (size_t)(row0 + j0) * NPROJ + pc0 + c;
        u32x4 raw[11];
        if (tseq0 + j0 == 0) { raw[0] = (u32x4){0u, 0u, 0u, 0u}; raw[1] = raw[0]; raw[2] = raw[0]; }
        else { raw[0] = *(const u32x4*)(src - 3 * NPROJ); raw[1] = *(const u32x4*)(src - 2 * NPROJ); raw[2] = *(const u32x4*)(src - NPROJ); }
#pragma unroll
        for (int j = 0; j < 8; ++j) raw[3 + j] = *(const u32x4*)(src + (size_t)j * NPROJ);
        float w0[8], w1[8], w2[8], w3[8], bb[8];
#pragma unroll
        for (int e = 0; e < 8; ++e) { w0[e] = cw[c + e]; w1[e] = cw[C + c + e]; w2[e] = cw[2 * C + c + e]; w3[e] = cw[3 * C + c + e]; bb[e] = cb[c + e]; }
        float h3[8], h2[8], h1[8];
        unpack8(raw[0], h3); unpack8(raw[1], h2); unpack8(raw[2], h1);
#pragma unroll
        for (int j = 0; j < 8; ++j) {
            float cur[8], y[8];
            unpack8(raw[3 + j], cur);
#pragma unroll
            for (int e = 0; e < 8; ++e) y[e] = bb[e] + w0[e] * h3[e] + w1[e] * h2[e] + w2[e] * h1[e] + w3[e] * cur[e];
            emit(j0 + j, q, c, y);
#pragma unroll
            for (int e = 0; e < 8; ++e) { h3[e] = h2[e]; h2[e] = h1[e]; h1[e] = cur[e]; }
        }
    }
}

__device__ __forceinline__ void rot16(const bf16_t* src, const float* rc, const float* rs, float scale, LAS bf16_t* dst) {
    float x1[16], x2[16], o1[16], o2[16];
    unpack8(*(const u32x4*)src, x1); unpack8(*(const u32x4*)(src + 8), x1 + 8);
    unpack8(*(const u32x4*)(src + 32), x2); unpack8(*(const u32x4*)(src + 40), x2 + 8);
#pragma unroll
    for (int e = 0; e < 16; ++e) { const float c = rc[e], s = rs[e]; o1[e] = (x1[e] * c - x2[e] * s) * scale; o2[e] = (x1[e] * s + x2[e] * c) * scale; }
    *(LAS u32x4*)dst = pack8(o1); *(LAS u32x4*)(dst + 8) = pack8(o1 + 8);
    *(LAS u32x4*)(dst + 32) = pack8(o2); *(LAS u32x4*)(dst + 40) = pack8(o2 + 8);
}

__device__ void ret_m1(const Params& p, LAS unsigned char* lds, int b, int c) {
    const int tid = TIDX, wid = tid >> 6, lane = tid & 63, fr = lane & 15, fq = lane >> 4;
    const bf16_t* proj = (const bf16_t*)(p.ws + W_PROJ);
    const float* rc = (const float*)(p.ws + W_ROPE); const float* rs = rc + 2049 * 32;
    float* dS = (float*)(p.ws + W_DS);
    LAS bf16_t* Kt = (LAS bf16_t*)lds;
    LAS bf16_t* Vt = (LAS bf16_t*)(lds + 33792);
    const int row0 = b * SEQ + c * 64, pos0 = c * 64;
    {
        const int j = tid >> 3, sub = tid & 7, h = sub >> 1, d0 = (sub & 1) * 16;
        const float scale = 0.125f * fexp_((float)(63 - j) * ret_logg(h));
        rot16(proj + (size_t)(row0 + j) * NPROJ + PC_K + h * 64 + d0, rc + (pos0 + j) * 32 + d0, rs + (pos0 + j) * 32 + d0, scale, Kt + j * 264 + h * 64 + d0);
#pragma unroll
        for (int i = 0; i < 8; ++i) { const int id = tid + 512 * i, jj = id >> 6, cc = id & 63;
            *(LAS u32x4*)(Vt + jj * 520 + cc * 8) = *(const u32x4*)(proj + (size_t)(row0 + jj) * NPROJ + PC_V + cc * 8); }
    }
    __syncthreads();
    {
        const int h = wid >> 1, vh = wid & 1;
        bf16x8 X[4][2];
#pragma unroll
        for (int kt = 0; kt < 4; ++kt)
#pragma unroll
            for (int kk = 0; kk < 2; ++kk) X[kt][kk] = frag_tr(Kt, 264, kk * 32, h * 64 + kt * 16, fr, fq);
        float* out = dS + ((size_t)((b * 4 + h) * NCH + c)) * 8192;
#pragma unroll
        for (int vt = 0; vt < 4; ++vt) {
            bf16x8 Y[2];
#pragma unroll
            for (int kk = 0; kk < 2; ++kk) Y[kk] = frag_tr(Vt, 520, kk * 32, h * 128 + vh * 64 + vt * 16, fr, fq);
#pragma unroll
            for (int kt = 0; kt < 4; ++kt) {
                f32x4 a = {0.f, 0.f, 0.f, 0.f};
                a = MFMA(X[kt][0], Y[0], a); a = MFMA(X[kt][1], Y[1], a);
                *(f32x4*)(out + (vh * 64 + vt * 16 + fr) * 64 + kt * 16 + 4 * fq) = a;
            }
        }
    }
    __syncthreads();
}

template <int NH>
__device__ __forceinline__ void ssd_dt_cum(const Params& p, int l, int row0, int h0, LAS float* dtv, LAS float* cum) {
    const int tid = TIDX, hl = tid >> 6, j = tid & 63;
    const float* dtraw = (const float*)(p.ws + W_DT);
    if (hl < NH) {
        const int h = h0 + hl;
        const float dt = softplusf_(dtraw[(size_t)(row0 + j) * 8 + h] + p.in[20][l * 8 + h]);
        float v = -dt * fexp_(p.in[21][l * 8 + h]);
#pragma unroll
        for (int o = 1; o < 64; o <<= 1) { const float t = shfl_up_(v, o, j); if (j >= o) v += t; }
        dtv[hl * 64 + j] = dt; cum[hl * 64 + j] = v;
    }
    __syncthreads();
}

__device__ void ssd_m1(const Params& p, LAS unsigned char* lds, int l, int b, int c) {
    const int tid = TIDX, wid = tid >> 6, lane = tid & 63, fr = lane & 15, fq = lane >> 4;
    const bf16_t* proj = (const bf16_t*)(p.ws + W_PROJ);
    float* dS = (float*)(p.ws + W_DSSSD); float* dec = (float*)(p.ws + W_DEC);
    LAS bf16_t* Xs = (LAS bf16_t*)lds;
    LAS bf16_t* Bm = (LAS bf16_t*)(lds + 66560);
    LAS float* dtv = (LAS float*)(lds + 100352);
    LAS float* cum = dtv + 512;
    LAS float* wl = cum + 512;
    const int row0 = b * SEQ + c * 64;
    ssd_dt_cum<8>(p, l, row0, 0, dtv, cum);
    { const int h = tid >> 6, j = tid & 63; wl[tid] = fexp_(cum[h * 64 + 63] - cum[tid]) * dtv[tid]; if (j == 63) dec[(b * 8 + h) * NCH + c] = fexp_(cum[h * 64 + 63]); }
    __syncthreads();
    conv64(proj, row0, c * 64, PC_XBC, p.in[18] + (size_t)l * 4 * 1024, p.in[19] + l * 1024, 1024, 96, [](int q) { return q * 8; },
           [&](int j, int q, int ch, float* y) {
               float s[8];
               if (ch < 512) { const float w = wl[(ch >> 6) * 64 + j];
#pragma unroll
                   for (int e = 0; e < 8; ++e) s[e] = siluf_(y[e]) * w;
                   *(LAS u32x4*)(Xs + j * 520 + ch) = pack8(s);
               } else {
#pragma unroll
                   for (int e = 0; e < 8; ++e) s[e] = siluf_(y[e]);
                   *(LAS u32x4*)(Bm + j * 264 + ch - 512) = pack8(s);
               }
           });
    __syncthreads();
    {
        const int h = wid, g = h >> 2;
        bf16x8 Y[4][2];
#pragma unroll
        for (int pt = 0; pt < 4; ++pt)
#pragma unroll
            for (int kk = 0; kk < 2; ++kk) Y[pt][kk] = frag_tr(Xs, 520, kk * 32, h * 64 + pt * 16, fr, fq);
        float* out = dS + ((size_t)((b * 8 + h) * NCH + c)) * 8192;
#pragma unroll
        for (int nt = 0; nt < 8; ++nt) {
            bf16x8 X[2];
#pragma unroll
            for (int kk = 0; kk < 2; ++kk) X[kk] = frag_tr(Bm, 264, kk * 32, g * 128 + nt * 16, fr, fq);
#pragma unroll
            for (int pt = 0; pt < 4; ++pt) {
                f32x4 a = {0.f, 0.f, 0.f, 0.f};
                a = MFMA(X[0], Y[pt][0], a); a = MFMA(X[1], Y[pt][1], a);
                *(f32x4*)(out + (pt * 16 + fr) * 128 + nt * 16 + 4 * fq) = a;
            }
        }
    }
    __syncthreads();
}

template <int PASS>
__device__ void lru_item(const Params& p, LAS unsigned char* lds, int l, int b, int c) {
    const int tid = TIDX, wid = tid >> 6, lane = tid & 63, fr = lane & 15, fq = lane >> 4;
    const bf16_t* proj = (const bf16_t*)(p.ws + W_PROJ);
    LAS bf16_t* xc = (LAS bf16_t*)lds;
    const int row0 = b * SEQ + c * 64;
    const int h = wid;
    const bf16_t* wrT = (const bf16_t*)(p.ws + W_LRUW) + (size_t)(l * 8 + h) * 4096;
    const bf16_t* wiT = wrT + DEPTH * 8 * 4096;
    bf16x8 BrA[4][2], BiA[4][2]; float brA[4], biA[4], lamA[4], hinA[4];
#pragma unroll
    for (int n = 0; n < 4; ++n) {
#pragma unroll
        for (int kk = 0; kk < 2; ++kk) { BrA[n][kk] = *(const bf16x8*)(wrT + (n * 16 + fr) * 64 + kk * 32 + 8 * fq); BiA[n][kk] = *(const bf16x8*)(wiT + (n * 16 + fr) * 64 + kk * 32 + 8 * fq); }
        const int ch = h * 64 + n * 16 + fr;
        brA[n] = p.in[13][l * 512 + ch]; biA[n] = p.in[15][l * 512 + ch]; lamA[n] = p.in[16][l * 512 + ch];
        hinA[n] = PASS == 2 ? ((const float*)(p.ws + W_LRUHIN))[(size_t)(b * NCH + c) * 512 + ch] : 0.f;
    }
    conv64(proj, row0, c * 64, PC_LX, p.in[10] + (size_t)l * 4 * 512, p.in[11] + l * 512, 512, 64, [](int q) { return q * 8; },
           [&](int j, int q, int ch, float* y) { *(LAS u32x4*)(xc + j * 520 + ch) = pack8(y); });
    __syncthreads();
    float* lruAB = (float*)(p.ws + W_LRUAB); const float* hin = (const float*)(p.ws + W_LRUHIN);
    bf16_t* mix = (bf16_t*)(p.ws + W_HB);
#pragma unroll
    for (int n = 0; n < 4; ++n) {
        f32x4 ar[4], ai[4];
        {
            bf16x8 Af[4][2];
#pragma unroll
            for (int m = 0; m < 4; ++m)
#pragma unroll
                for (int kk = 0; kk < 2; ++kk) Af[m][kk] = frag_row(xc, 520, m * 16, h * 64 + kk * 32, fr, fq);
            bf16x8 Br[2], Bi[2];
#pragma unroll
            for (int kk = 0; kk < 2; ++kk) { Br[kk] = BrA[n][kk]; Bi[kk] = BiA[n][kk]; }
#pragma unroll
            for (int m = 0; m < 4; ++m) {
                f32x4 a = {0.f, 0.f, 0.f, 0.f}, bq = {0.f, 0.f, 0.f, 0.f};
                a = MFMA(Af[m][0], Br[0], a); a = MFMA(Af[m][1], Br[1], a);
                bq = MFMA(Af[m][0], Bi[0], bq); bq = MFMA(Af[m][1], Bi[1], bq);
                ar[m] = a; ai[m] = bq;
            }
        }
        const int ch = h * 64 + n * 16 + fr;
        const float br = brA[n], bi = biA[n];
        const float sp = log1pf(fexp_(-lamA[n]));
        const float nsp = -8.f * sp * 1.44269504089f;
#pragma unroll
        for (int m = 0; m < 4; ++m)
#pragma unroll
            for (int i = 0; i < 4; i += 2) {
                const int t = m * 16 + 4 * fq + i;
                const f32x2 xv = {bf2f(xc[t * 520 + ch]), bf2f(xc[(t + 1) * 520 + ch])};
                const f32x2 zr = ((f32x2){ar[m][i], ar[m][i + 1]} + br) * (-1.44269504089f), zi = ((f32x2){ai[m][i], ai[m][i + 1]} + bi) * (-1.44269504089f);
                f32x2 er, ei; er.x = __builtin_amdgcn_exp2f(zr.x); er.y = __builtin_amdgcn_exp2f(zr.y); ei.x = __builtin_amdgcn_exp2f(zi.x); ei.y = __builtin_amdgcn_exp2f(zi.y);
                er = er + 1.0f; ei = ei + 1.0f;
                f32x2 r, ig; r.x = __builtin_amdgcn_rcpf(er.x); r.y = __builtin_amdgcn_rcpf(er.y); ig.x = __builtin_amdgcn_rcpf(ei.x); ig.y = __builtin_amdgcn_rcpf(ei.y);
                const f32x2 l2 = r * nsp;
                f32x2 av; av.x = __builtin_amdgcn_exp2f(l2.x); av.y = __builtin_amdgcn_exp2f(l2.y);
                const f32x2 om = __builtin_elementwise_fma(-av, av, (f32x2){1.f, 1.f});
                f32x2 sq; sq.x = __builtin_amdgcn_sqrtf(fmaxf(om.x, 0.f)); sq.y = __builtin_amdgcn_sqrtf(fmaxf(om.y, 0.f));
                const f32x2 bv = sq * (ig * xv);
                ar[m][i] = av.x; ar[m][i + 1] = av.y; ai[m][i] = bv.x; ai[m][i + 1] = bv.y;
            }
        float carry = 0.f, Atot = 1.f;
        if (PASS == 2) carry = hinA[n];
#pragma unroll
        for (int m = 0; m < 4; ++m) {
            const float a0 = ar[m][0], a1 = ar[m][1], a2 = ar[m][2], a3 = ar[m][3];
            const float b0 = ai[m][0], b1 = ai[m][1], b2 = ai[m][2], b3 = ai[m][3];
            float Al = a0 * a1 * a2 * a3, Bl = ((b0 * a1 + b1) * a2 + b2) * a3 + b3;
            float Ap = shfl_up_(Al, 16, lane), Bp = shfl_up_(Bl, 16, lane);
            if (fq >= 1) { Bl = Bp * Al + Bl; Al = Ap * Al; }
            Ap = shfl_up_(Al, 32, lane); Bp = shfl_up_(Bl, 32, lane);
            if (fq >= 2) { Bl = Bp * Al + Bl; Al = Ap * Al; }
            float Aex = shfl_up_(Al, 16, lane), Bex = shfl_up_(Bl, 16, lane);
            if (fq == 0) { Aex = 1.f; Bex = 0.f; }
            const float At = shfl_idx(Al, fr + 48), Bt = shfl_idx(Bl, fr + 48);
            if (PASS == 2) {
                float hh = Aex * carry + Bex;
                hh = a0 * hh + b0; ai[m][0] = hh;
                hh = a1 * hh + b1; ai[m][1] = hh;
                hh = a2 * hh + b2; ai[m][2] = hh;
                hh = a3 * hh + b3; ai[m][3] = hh;
            }
            carry = At * carry + Bt; Atot *= At;
        }
        if (PASS == 1) {
            if (fq == 0) { f32x2 v = {Atot, carry}; *(f32x2*)(lruAB + ((size_t)(b * NCH + c) * 512 + ch) * 2) = v; }
        } else {
            bf16_t gv[4][4];
#pragma unroll
            for (int m = 0; m < 4; ++m)
#pragma unroll
                for (int i = 0; i < 4; ++i) gv[m][i] = proj[(size_t)(row0 + m * 16 + 4 * fq + i) * NPROJ + PC_LG + ch];
#pragma unroll
            for (int m = 0; m < 4; ++m)
#pragma unroll
                for (int i = 0; i < 4; ++i) {
                    const size_t t = row0 + m * 16 + 4 * fq + i;
                    mix[t * DMIX + ch] = f2bf(ai[m][i] * geluf_(bf2f(gv[m][i])));
                }
        }
    }
    __syncthreads();
}

__device__ void phase_m15(const Params& p, int l) {
    const int gt = blockIdx.x * 512 + TIDX, gn = gridDim.x * 512;
    const float* dSr = (const float*)(p.ws + W_DS); const float* dSs = (const float*)(p.ws + W_DSSSD); const float* dec = (const float*)(p.ws + W_DEC);
    bf16_t* spr = (bf16_t*)(p.ws + W_SPR); bf16_t* sps = (bf16_t*)(p.ws + W_SPS);
    for (int u = gt; u < (32 + 64) * 4096; u += gn) {
        float zz = 0.f; asm volatile("" : "+v"(zz));
        f32x2 S = {zz, zz};
        f32x2 tv[NCH];
        if (u < 32 * 4096) {
            const int bh = u >> 12, e2 = u & 4095, h = bh & 3;
            const float* ptr = dSr + (size_t)bh * NCH * 8192 + e2 * 2; bf16_t* sp = spr + (size_t)bh * NCH * 8192 + e2 * 2;
            const float d = fexp_(64.f * ret_logg(h));
#pragma unroll
            for (int c = 0; c < NCH; ++c) tv[c] = *(const f32x2*)(ptr + (size_t)c * 8192);
#pragma unroll
            for (int c = 0; c < NCH; ++c) { *(unsigned*)(sp + (size_t)c * 8192) = pk2(S[0], S[1]); S = S * d + tv[c]; }
            float* o = p.out + O_RP + ((size_t)(l * NB * 4 + bh)) * 8192;
#pragma unroll
            for (int i = 0; i < 2; ++i) { const int e = e2 * 2 + i, v = e >> 6, k = e & 63; o[k * 128 + v] = S[i]; }
        } else {
            const int uu = u - 32 * 4096, bh = uu >> 12, e2 = uu & 4095;
            const float* ptr = dSs + (size_t)bh * NCH * 8192 + e2 * 2; bf16_t* sp = sps + (size_t)bh * NCH * 8192 + e2 * 2;
            float dc[NCH];
#pragma unroll
            for (int c = 0; c < NCH; ++c) { tv[c] = *(const f32x2*)(ptr + (size_t)c * 8192); dc[c] = dec[bh * NCH + c]; }
#pragma unroll
            for (int c = 0; c < NCH; ++c) { *(unsigned*)(sp + (size_t)c * 8192) = pk2(S[0], S[1]); S = S * dc[c] + tv[c]; }
            *(f32x2*)(p.out + O_SP + ((size_t)(l * NB * 8 + bh)) * 8192 + e2 * 2) = S;
        }
    }
    const float* lruAB = (const float*)(p.ws + W_LRUAB); float* hin = (float*)(p.ws + W_LRUHIN);
    for (int u = gt; u < NB * 512; u += gn) {
        const int b = u >> 9, ch = u & 511; float h = 0.f;
        f32x2 ab[NCH];
#pragma unroll
        for (int c = 0; c < NCH; ++c) ab[c] = *(const f32x2*)(lruAB + ((size_t)(b * NCH + c) * 512 + ch) * 2);
#pragma unroll
        for (int c = 0; c < NCH; ++c) { hin[(size_t)(b * NCH + c) * 512 + ch] = h; h = ab[c][0] * h + ab[c][1]; }
        p.out[O_LHP + (size_t)(l * NB + b) * 512 + ch] = h;
    }
}

__device__ void ret_m2(const Params& p, LAS unsigned char* lds, int l, int b, int c, int hp) {
    const int tid = TIDX, wid = tid >> 6, lane = tid & 63, fr = lane & 15, fq = lane >> 4;
    const bf16_t* proj = (const bf16_t*)(p.ws + W_PROJ);
    const float* rc = (const float*)(p.ws + W_ROPE); const float* rs = rc + 2049 * 32;
    const bf16_t* sp = (const bf16_t*)(p.ws + W_SPR);
    bf16_t* mix = (bf16_t*)(p.ws + W_HB);
    const int row0 = b * SEQ + c * 64, pos0 = c * 64;
    constexpr int HB = 63488;
    {
        const int j = tid >> 3, sub = tid & 7, hh = sub >> 2, which = (sub >> 1) & 1, d0 = (sub & 1) * 16, h = 2 * hp + hh;
        LAS bf16_t* dst = (LAS bf16_t*)(lds + hh * HB + which * 9216) + j * 72 + d0;
        rot16(proj + (size_t)(row0 + j) * NPROJ + (which ? PC_K : PC_Q) + h * 64 + d0, rc + (pos0 + j) * 32 + d0, rs + (pos0 + j) * 32 + d0, which ? 0.125f : 1.f, dst);
#pragma unroll
        for (int i = 0; i < 4; ++i) { const int id = tid + 512 * i, h2 = id >> 10, jj = (id >> 4) & 63, cc = id & 15;
            *(LAS u32x4*)((LAS bf16_t*)(lds + h2 * HB + 18432) + jj * 136 + cc * 8) = *(const u32x4*)(proj + (size_t)(row0 + jj) * NPROJ + PC_V + (2 * hp + h2) * 128 + cc * 8); }
#pragma unroll
        for (int i = 0; i < 4; ++i) { const int id = tid + 512 * i, h2 = id >> 10, v = (id >> 3) & 127, kc = id & 7;
            *(LAS u32x4*)((LAS bf16_t*)(lds + h2 * HB + 35840) + v * 72 + kc * 8) = *(const u32x4*)(sp + ((size_t)((b * 4 + 2 * hp + h2) * NCH + c)) * 8192 + v * 64 + kc * 8); }
    }
    __syncthreads();
    const int hh = wid >> 2, it = wid & 3, i0 = it * 16, h = 2 * hp + hh;
    const float lg = ret_logg(h);
    LAS bf16_t* Q = (LAS bf16_t*)(lds + hh * HB); LAS bf16_t* Kk = Q + 64 * 72; LAS bf16_t* V = (LAS bf16_t*)(lds + hh * HB + 18432);
    LAS bf16_t* S = (LAS bf16_t*)(lds + hh * HB + 35840); LAS bf16_t* P = (LAS bf16_t*)(lds + hh * HB + 54272);
    bf16x8 Yq[2];
#pragma unroll
    for (int kk = 0; kk < 2; ++kk) Yq[kk] = frag_row(Q, 72, i0, kk * 32, fr, fq);
    const int irow = i0 + fr;
#pragma unroll
    for (int jt = 0; jt < 4; ++jt) {
        f32x4 sc = {0.f, 0.f, 0.f, 0.f};
#pragma unroll
        for (int kk = 0; kk < 2; ++kk) sc = MFMA(frag_row(Kk, 72, jt * 16, kk * 32, fr, fq), Yq[kk], sc);
        float v[4];
#pragma unroll
        for (int i = 0; i < 4; ++i) { const int j = jt * 16 + 4 * fq + i; v[i] = j <= irow ? sc[i] * fexp_((float)(irow - j) * lg) : 0.f; }
        u32x2 w; w.x = pk2(v[0], v[1]); w.y = pk2(v[2], v[3]);
        *(LAS u32x2*)(P + irow * 72 + jt * 16 + 4 * fq) = w;
    }
    __syncthreads();
    const size_t t = row0 + irow;
    u32x2 rgv[8]; f32x4 ngv[8];
#pragma unroll
    for (int vt = 0; vt < 8; ++vt) { rgv[vt] = *(const u32x2*)(proj + t * NPROJ + PC_RG + h * 128 + vt * 16 + 4 * fq); ngv[vt] = *(const f32x4*)(p.in[17] + l * 512 + h * 128 + vt * 16 + 4 * fq); }
    bf16x8 Yp[2];
#pragma unroll
    for (int kk = 0; kk < 2; ++kk) Yp[kk] = frag_row(P, 72, i0, kk * 32, fr, fq);
    const float qdec = fexp_((float)(irow + 1) * lg);
    f32x4 o[8]; float ssq = 0.f;
#pragma unroll
    for (int vt = 0; vt < 8; ++vt) {
        f32x4 a1 = {0.f, 0.f, 0.f, 0.f}, a2 = {0.f, 0.f, 0.f, 0.f};
#pragma unroll
        for (int kk = 0; kk < 2; ++kk) { a1 = MFMA(frag_tr(V, 136, kk * 32, vt * 16, fr, fq), Yp[kk], a1); a2 = MFMA(frag_row(S, 72, vt * 16, kk * 32, fr, fq), Yq[kk], a2); }
        o[vt] = a1 + a2 * qdec;
        ssq += o[vt][0] * o[vt][0] + o[vt][1] * o[vt][1] + o[vt][2] * o[vt][2] + o[vt][3] * o[vt][3];
    }
    ssq += shfl_xor_(ssq, 16, lane); ssq += shfl_xor_(ssq, 32, lane);
    const float rstd = rsqrtf(ssq * (1.f / 128.f) + EPS);
#pragma unroll
    for (int vt = 0; vt < 8; ++vt) {
        const int v = vt * 16 + 4 * fq;
        float gt[4]; unpack4(rgv[vt], gt);
        const f32x4 ng = ngv[vt];
        float y[4];
#pragma unroll
        for (int i = 0; i < 4; ++i) y[i] = siluf_(gt[i]) * (o[vt][i] * rstd * ng[i]);
        u32x2 w; w.x = pk2(y[0], y[1]); w.y = pk2(y[2], y[3]);
        *(u32x2*)(mix + t * DMIX + 512 + h * 128 + v) = w;
    }
    __syncthreads();
}

__device__ void ssd_m2(const Params& p, LAS unsigned char* lds, int l, int b, int c, int g) {
    const int tid = TIDX, wid = tid >> 6, lane = tid & 63, fr = lane & 15, fq = lane >> 4;
    const bf16_t* proj = (const bf16_t*)(p.ws + W_PROJ);
    const bf16_t* sp = (const bf16_t*)(p.ws + W_SPS);
    bf16_t* mix = (bf16_t*)(p.ws + W_HB);
    const int row0 = b * SEQ + c * 64;
    LAS bf16_t* Cm = (LAS bf16_t*)lds;
    LAS bf16_t* Bm = (LAS bf16_t*)(lds + 17408);
    constexpr int PB = 34816, HB = 35840;
    LAS float* dtv = (LAS float*)(lds + 106496);
    LAS float* cum = dtv + 256;
    LAS float* ssqb = cum + 256;
    ssd_dt_cum<4>(p, l, row0, 4 * g, dtv, cum);
    const float* cw = p.in[18] + (size_t)l * 4 * 1024; const float* cb = p.in[19] + l * 1024;
    conv64(proj, row0, c * 64, PC_XBC, cw, cb, 1024, 32, [g](int q) { return (q < 16 ? 512 : 768 - 128) + g * 128 + q * 8; },
           [&](int j, int q, int ch, float* y) {
               float s[8];
#pragma unroll
               for (int e = 0; e < 8; ++e) s[e] = siluf_(y[e]);
               if (q < 16) *(LAS u32x4*)(Bm + j * 136 + q * 8) = pack8(s); else *(LAS u32x4*)(Cm + j * 136 + (q - 16) * 8) = pack8(s);
           });
    const int hh = wid >> 2, it = wid & 3, i0 = it * 16, irow = i0 + fr;
    const size_t t = row0 + irow;
    f32x4 gy[2][4]; float ssq = 0.f;
#pragma unroll
    for (int pr = 0; pr < 2; ++pr) {
        const int hbase = 4 * g + 2 * pr;
        conv64(proj, row0, c * 64, PC_XBC, cw, cb, 1024, 16, [hbase](int q) { return hbase * 64 + q * 8; },
               [&](int j, int q, int ch, float* y) {
                   float s[8];
#pragma unroll
                   for (int e = 0; e < 8; ++e) s[e] = siluf_(y[e]);
                   *(LAS u32x4*)((LAS bf16_t*)(lds + PB + (q >> 3) * HB + 9216) + j * 72 + (q & 7) * 8) = pack8(s);
               });
#pragma unroll
        for (int i = 0; i < 4; ++i) { const int id = tid + 512 * i, h2 = id >> 10, pp = (id >> 4) & 63, nc = id & 15;
            *(LAS u32x4*)((LAS bf16_t*)(lds + PB + h2 * HB + 18432) + pp * 136 + nc * 8) = *(const u32x4*)(sp + ((size_t)((b * 8 + hbase + h2) * NCH + c)) * 8192 + pp * 128 + nc * 8); }
        __syncthreads();
        const int h = hbase + hh, hl = 2 * pr + hh;
        LAS bf16_t* P = (LAS bf16_t*)(lds + PB + hh * HB); LAS bf16_t* X = P + 64 * 72; LAS bf16_t* S = (LAS bf16_t*)(lds + PB + hh * HB + 18432);
        bf16x8 Yc[4];
#pragma unroll
        for (int kk = 0; kk < 4; ++kk) Yc[kk] = frag_row(Cm, 136, i0, kk * 32, fr, fq);
        const float cumi = cum[hl * 64 + irow];
#pragma unroll
        for (int jh = 0; jh < 2; ++jh) {
            bf16x8 Xb[2][4]; f32x4 cj[2], dj[2];
#pragma unroll
            for (int q = 0; q < 2; ++q) {
#pragma unroll
                for (int kk = 0; kk < 4; ++kk) Xb[q][kk] = frag_row(Bm, 136, (2 * jh + q) * 16, kk * 32, fr, fq);
                cj[q] = *(const LAS f32x4*)(cum + hl * 64 + (2 * jh + q) * 16 + 4 * fq); dj[q] = *(const LAS f32x4*)(dtv + hl * 64 + (2 * jh + q) * 16 + 4 * fq);
            }
#pragma unroll
            for (int q = 0; q < 2; ++q) {
                const int jt = 2 * jh + q;
                f32x4 sc = {0.f, 0.f, 0.f, 0.f};
#pragma unroll
                for (int kk = 0; kk < 4; ++kk) sc = MFMA(Xb[q][kk], Yc[kk], sc);
                float v[4];
#pragma unroll
                for (int i = 0; i < 4; ++i) { const int j = jt * 16 + 4 * fq + i; v[i] = j <= irow ? sc[i] * fexp_(cumi - cj[q][i]) * dj[q][i] : 0.f; }
                u32x2 w; w.x = pk2(v[0], v[1]); w.y = pk2(v[2], v[3]);
                *(LAS u32x2*)(P + irow * 72 + jt * 16 + 4 * fq) = w;
            }
        }
        __syncthreads();
        u32x2 zraw[4];
#pragma unroll
        for (int pt = 0; pt < 4; ++pt) zraw[pt] = *(const u32x2*)(proj + t * NPROJ + PC_Z + h * 64 + pt * 16 + 4 * fq);
        bf16x8 Yp[2];
#pragma unroll
        for (int kk = 0; kk < 2; ++kk) Yp[kk] = frag_row(P, 72, i0, kk * 32, fr, fq);
        const float ecum = fexp_(cumi), Dh = p.in[22][l * 8 + h];
#pragma unroll
        for (int pt = 0; pt < 4; ++pt) {
            f32x4 a1 = {0.f, 0.f, 0.f, 0.f}, a2 = {0.f, 0.f, 0.f, 0.f};
#pragma unroll
            for (int kk = 0; kk < 2; ++kk) a1 = MFMA(frag_tr(X, 72, kk * 32, pt * 16, fr, fq), Yp[kk], a1);
#pragma unroll
            for (int kk = 0; kk < 4; ++kk) a2 = MFMA(frag_row(S, 136, pt * 16, kk * 32, fr, fq), Yc[kk], a2);
            const int pp = pt * 16 + 4 * fq;
            float xv[4], zv[4]; unpack4(*(const LAS u32x2*)(X + irow * 72 + pp), xv);
            unpack4(zraw[pt], zv);
            f32x4 r;
#pragma unroll
            for (int i = 0; i < 4; ++i) { const float y = a1[i] + ecum * a2[i] + Dh * xv[i]; r[i] = y * siluf_(zv[i]); ssq += r[i] * r[i]; }
            gy[pr][pt] = r;
        }
        __syncthreads();
    }
    f32x4 ngv[2][4];
#pragma unroll
    for (int pr = 0; pr < 2; ++pr)
#pragma unroll
        for (int pt = 0; pt < 4; ++pt) ngv[pr][pt] = *(const f32x4*)(p.in[23] + l * 512 + g * 256 + (2 * pr + hh) * 64 + pt * 16 + 4 * fq);
    ssq += shfl_xor_(ssq, 16, lane); ssq += shfl_xor_(ssq, 32, lane);
    if (fq == 0) ssqb[irow * 2 + hh] = ssq;
    __syncthreads();
    const float rstd = rsqrtf((ssqb[irow * 2] + ssqb[irow * 2 + 1]) * (1.f / 256.f) + EPS);
#pragma unroll
    for (int pr = 0; pr < 2; ++pr)
#pragma unroll
        for (int pt = 0; pt < 4; ++pt) {
            const int chn = g * 256 + (2 * pr + hh) * 64 + pt * 16 + 4 * fq;
            const f32x4 ng = ngv[pr][pt];
            u32x2 w; w.x = pk2(gy[pr][pt][0] * rstd * ng[0], gy[pr][pt][1] * rstd * ng[1]); w.y = pk2(gy[pr][pt][2] * rstd * ng[2], gy[pr][pt][3] * rstd * ng[3]);
            *(u32x2*)(mix + t * DMIX + 1024 + chn) = w;
        }
    __syncthreads();
}

__device__ void sample_item(const Params& p, LAS unsigned char* lds, int l, int s, int g) {
    const int tid = TIDX, wid = tid >> 6, lane = tid & 63;
    const bf16_t* proj = (const bf16_t*)(p.ws + W_PROJ);
    bf16_t* mix = (bf16_t*)(p.ws + W_HB);
    const size_t t = TP + s;
    const bf16_t* prow = proj + t * NPROJ;
    LAS float* sv = (LAS float*)lds;
    LAS float* sdt = sv + 512;
    LAS float* gy = sv + 520;
    LAS float* sq = sv + 776;
    LAS float* ro = sv + 1032;
    LAS float* sxc = sv + 2304;
    f32x4 ssd0[4][4], ret0[2][4];
    {
        const int n4 = (tid & 31) * 4, pr = tid >> 5;
#pragma unroll
        for (int hl = 0; hl < 4; ++hl)
#pragma unroll
            for (int ps = 0; ps < 4; ++ps) ssd0[hl][ps] = __builtin_nontemporal_load((const f32x4*)(p.in[6] + ((size_t)(l * NS + s) * 8 + 4 * g + hl) * 8192 + (ps * 16 + pr) * 128 + n4));
#pragma unroll
        for (int hh = 0; hh < 2; ++hh)
#pragma unroll
            for (int ps = 0; ps < 4; ++ps) ret0[hh][ps] = __builtin_nontemporal_load((const f32x4*)(p.in[4] + ((size_t)(l * NS + s) * 4 + 2 * g + hh) * 8192 + (ps * 16 + pr) * 128 + n4));
    }
    {
        const int ch = tid < 256 ? g * 256 + tid : (tid < 384 ? 512 + g * 128 + (tid - 256) : 768 + g * 128 + (tid - 384));
        const float* cw = p.in[18] + (size_t)l * 4 * 1024; const float* st = p.in[5] + (size_t)(l * NS + s) * 3 * 1024;
        const float cur = bf2f(prow[PC_XBC + ch]);
        const float s0 = st[ch], s1 = st[1024 + ch], s2 = st[2048 + ch];
        const float y = p.in[19][l * 1024 + ch] + cw[ch] * s0 + cw[1024 + ch] * s1 + cw[2048 + ch] * s2 + cw[3072 + ch] * cur;
        sv[tid] = siluf_(y);
        float* so = p.out + O_SCS + (size_t)(l * NS + s) * 3 * 1024;
        so[ch] = s1; so[1024 + ch] = s2; so[2048 + ch] = cur;
        if (tid < 4) {
            const int h = 4 * g + tid;
            const float dt = softplusf_(((const float*)(p.ws + W_DT))[t * 8 + h] + p.in[20][l * 8 + h]);
            sdt[tid] = dt; sdt[4 + tid] = fexp_(-dt * fexp_(p.in[21][l * 8 + h]));
        }
    }
    __syncthreads();
    {
        const int n4 = (tid & 31) * 4, pr = tid >> 5;
        const f32x4 bv = *(const LAS f32x4*)(sv + 256 + n4), cv = *(const LAS f32x4*)(sv + 384 + n4);
        float part[4][4]; bf16_t zr[4][4];
#pragma unroll
        for (int hl = 0; hl < 4; ++hl)
#pragma unroll
            for (int ps = 0; ps < 4; ++ps) zr[hl][ps] = prow[PC_Z + (4 * g + hl) * 64 + ps * 16 + pr];
#pragma unroll
        for (int hl = 0; hl < 4; ++hl) {
            const int h = 4 * g + hl;
            const float dt = sdt[hl], eda = sdt[4 + hl];
            float* S1 = p.out + O_SS + ((size_t)(l * NS + s) * 8 + h) * 8192;
#pragma unroll
            for (int ps = 0; ps < 4; ++ps) {
                const int pp = ps * 16 + pr;
                const float xp = sv[hl * 64 + pp];
                const f32x4 sn = ssd0[hl][ps] * eda + bv * (dt * xp);
                __builtin_nontemporal_store(sn, (f32x4*)(S1 + pp * 128 + n4));
                part[hl][ps] = cv[0] * sn[0] + cv[1] * sn[1] + cv[2] * sn[2] + cv[3] * sn[3];
            }
        }
#pragma unroll
        for (int o = 16; o >= 1; o >>= 1)
#pragma unroll
            for (int hl = 0; hl < 4; ++hl)
#pragma unroll
                for (int ps = 0; ps < 4; ++ps) part[hl][ps] += shfl_xor_(part[hl][ps], o, lane);
        if ((tid & 31) == 0) {
#pragma unroll
            for (int hl = 0; hl < 4; ++hl)
#pragma unroll
                for (int ps = 0; ps < 4; ++ps) { const int pp = ps * 16 + pr; const float y = part[hl][ps] + p.in[22][l * 8 + 4 * g + hl] * sv[hl * 64 + pp]; gy[hl * 64 + pp] = y * siluf_(bf2f(zr[hl][ps])); }
        }
    }
    __syncthreads();
    {
        const f32x4 v = *(const LAS f32x4*)(gy + lane * 4);
        const float ssq = wave_sum(v[0] * v[0] + v[1] * v[1] + v[2] * v[2] + v[3] * v[3], lane);
        const float rstd = rsqrtf(ssq * (1.f / 256.f) + EPS);
        if (tid < 256) mix[t * DMIX + 1024 + g * 256 + tid] = f2bf(gy[tid] * rstd * p.in[23][l * 512 + g * 256 + tid]);
    }
    if (tid < 128) {
        const int hh = tid >> 6, w = (tid >> 5) & 1, d = tid & 31, h = 2 * g + hh;
        const int col = (w ? PC_K : PC_Q) + h * 64;
        const float x1 = bf2f(prow[col + d]), x2 = bf2f(prow[col + 32 + d]);
        const float* rc = (const float*)(p.ws + W_ROPE); const float* rs = rc + 2049 * 32;
        const float cs = rc[2048 * 32 + d], sn = rs[2048 * 32 + d], sc = w ? 0.125f : 1.f;
        sq[w * 128 + hh * 64 + d] = (x1 * cs - x2 * sn) * sc; sq[w * 128 + hh * 64 + 32 + d] = (x1 * sn + x2 * cs) * sc;
    }
    __syncthreads();
#pragma unroll
    for (int hh = 0; hh < 2; ++hh) {
        const int h = 2 * g + hh;
        const float gh = 1.f - exp2f(-5.f - (float)h);
        const int v4 = (tid & 31) * 4, kr = tid >> 5;
        float vv[4]; unpack4(*(const u32x2*)(prow + PC_V + h * 128 + v4), vv);
        const float* S0 = p.in[4] + ((size_t)(l * NS + s) * 4 + h) * 8192; float* S1 = p.out + O_RS + ((size_t)(l * NS + s) * 4 + h) * 8192;
        f32x4 part = {0.f, 0.f, 0.f, 0.f};
#pragma unroll
        for (int ps = 0; ps < 4; ++ps) {
            const int k = ps * 16 + kr;
            const float kk = sq[128 + hh * 64 + k], qq = sq[hh * 64 + k];
            const f32x4 s0 = ret0[hh][ps];
            f32x4 sn; sn[0] = gh * s0[0] + kk * vv[0]; sn[1] = gh * s0[1] + kk * vv[1]; sn[2] = gh * s0[2] + kk * vv[2]; sn[3] = gh * s0[3] + kk * vv[3];
            __builtin_nontemporal_store(sn, (f32x4*)(S1 + k * 128 + v4));
            part = part + sn * qq;
        }
#pragma unroll
        for (int i = 0; i < 4; ++i) part[i] += shfl_xor_(part[i], 32, lane);
        if (lane < 32) *(LAS f32x4*)(ro + wid * 128 + v4) = part;
        __syncthreads();
        if (tid < 128) {
            float o = 0.f;
#pragma unroll
            for (int w = 0; w < 8; ++w) o += ro[w * 128 + tid];
            float ssq = wave_sum(o * o, lane);
            ro[1024 + tid] = o; if (lane == 0) ro[1152 + wid] = ssq;
        }
        __syncthreads();
        if (tid < 128) {
            const float rstd = rsqrtf((ro[1152] + ro[1153]) * (1.f / 128.f) + EPS);
            const float o = ro[1024 + tid];
            mix[t * DMIX + 512 + h * 128 + tid] = f2bf(siluf_(bf2f(prow[PC_RG + h * 128 + tid])) * (o * rstd * p.in[17][l * 512 + h * 128 + tid]));
        }
        __syncthreads();
    }
    if (tid < 256) {
        const int ch = 256 * g + tid;
        const float* cw = p.in[10] + (size_t)l * 4 * 512; const float* st = p.in[2] + (size_t)(l * NS + s) * 3 * 512;
        const float cur = bf2f(prow[PC_LX + ch]);
        const float s0 = st[ch], s1 = st[512 + ch], s2 = st[1024 + ch];
        sxc[tid] = p.in[11][l * 512 + ch] + cw[ch] * s0 + cw[512 + ch] * s1 + cw[1024 + ch] * s2 + cw[1536 + ch] * cur;
        float* so = p.out + O_LCS + (size_t)(l * NS + s) * 3 * 512;
        so[ch] = s1; so[512 + ch] = s2; so[1024 + ch] = cur;
    }
    __syncthreads();
    if (tid < 256) {
        const int j = tid & 63, hl = tid >> 6, h = 4 * g + hl, ch = h * 64 + j;
        const float* wr = p.in[12] + (size_t)(l * 8 + h) * 4096; const float* wi = p.in[14] + (size_t)(l * 8 + h) * 4096;
        float r = 0.f, ig = 0.f;
        for (int i = 0; i < 64; ++i) { const float xv = sxc[hl * 64 + i]; r += xv * wr[i * 64 + j]; ig += xv * wi[i * 64 + j]; }
        r = sigmoidf_(r + p.in[13][l * 512 + ch]); ig = sigmoidf_(ig + p.in[15][l * 512 + ch]);
        const float sp = log1pf(fexp_(-p.in[16][l * 512 + ch]));
        const float la = -8.f * r * sp, a = fexp_(la);
        const float hn = a * p.in[3][(size_t)(l * NS + s) * 512 + ch] + __builtin_amdgcn_sqrtf(fmaxf(-expm1f(2.f * la), 0.f)) * ig * sxc[tid];
        p.out[O_LHS + (size_t)(l * NS + s) * 512 + ch] = hn;
        mix[t * DMIX + ch] = f2bf(hn * geluf_(bf2f(prow[PC_LG + ch])));
    }
    __syncthreads();
}

#ifndef ITMASK
#define ITMASK 0xFF
#endif
#define IT_EN(x) (((ITMASK) >> (x)) & 1)
#ifndef REP_ITEM
#define REP_ITEM 0
#endif
__device__ void phase_m1(const Params& p, LAS unsigned char* lds, int l) {
    for (int rr = 0; rr < 1 + ((REP_ITEM >> 0) & 1); ++rr) { if (IT_EN(0)) for (int it = blockIdx.x; it < 256; it += gridDim.x) ret_m1(p, lds, it >> 5, it & 31); }
    for (int rr = 0; rr < 1 + ((REP_ITEM >> 1) & 1); ++rr) { if (IT_EN(1)) for (int it = blockIdx.x; it < 256; it += gridDim.x) ssd_m1(p, lds, l, it >> 5, it & 31); }
    for (int rr = 0; rr < 1 + ((REP_ITEM >> 2) & 1); ++rr) { if (IT_EN(2)) for (int it = blockIdx.x; it < 256; it += gridDim.x) lru_item<1>(p, lds, l, it >> 5, it & 31); }
    for (int rr = 0; rr < 1 + ((REP_ITEM >> 3) & 1); ++rr) { if (IT_EN(3)) for (int it = blockIdx.x; it < 256; it += gridDim.x) sample_item(p, lds, l, it >> 1, it & 1); }
    const bf16_t* proj = (const bf16_t*)(p.ws + W_PROJ);
    const int gt = blockIdx.x * 512 + TIDX, gn = gridDim.x * 512;
    for (int u = gt; u < NB * 3 * 1536; u += gn) {
        const int b = u / (3 * 1536), r = u % (3 * 1536), k = r / 1536, cc = r % 1536;
        const size_t row = (size_t)b * SEQ + SEQ - 3 + k;
        if (cc < 512) p.out[O_LCP + ((size_t)(l * NB + b) * 3 + k) * 512 + cc] = bf2f(proj[row * NPROJ + PC_LX + cc]);
        else p.out[O_SCP + ((size_t)(l * NB + b) * 3 + k) * 1024 + cc - 512] = bf2f(proj[row * NPROJ + PC_XBC + cc - 512]);
    }
}
__device__ void phase_m2(const Params& p, LAS unsigned char* lds, int l) {
    for (int rr = 0; rr < 1 + ((REP_ITEM >> 4) & 1); ++rr) { if (IT_EN(4)) for (int it = blockIdx.x; it < 512; it += gridDim.x) ret_m2(p, lds, l, it >> 6, (it >> 1) & 31, it & 1); }
    for (int rr = 0; rr < 1 + ((REP_ITEM >> 5) & 1); ++rr) { if (IT_EN(5)) for (int it = blockIdx.x; it < 512; it += gridDim.x) ssd_m2(p, lds, l, it >> 6, (it >> 1) & 31, it & 1); }
    for (int rr = 0; rr < 1 + ((REP_ITEM >> 6) & 1); ++rr) { if (IT_EN(6)) for (int it = blockIdx.x; it < 256; it += gridDim.x) lru_item<2>(p, lds, l, it >> 5, it & 31); }
}


#define XB_TMO      128
#define XB_XCNT(j)  (256  + 64 * (j))
#define XB_XSUB(j)  (1280 + 64 * (j))
#define XB_XGEN(j)  (2304 + 64 * (j))
#define XB_TOP      3328
#define XB_TOPGEN   3392
#define XCD_BAR_WORDS 3456
#define XB_SPIN_CAP (1u << 22)
__device__ __forceinline__ unsigned xb_ld(unsigned* p)              { return __hip_atomic_load(p, __ATOMIC_RELAXED, __HIP_MEMORY_SCOPE_AGENT); }
__device__ __forceinline__ unsigned xb_add(unsigned* p, unsigned v) { return __hip_atomic_fetch_add(p, v, __ATOMIC_RELAXED, __HIP_MEMORY_SCOPE_AGENT); }
__device__ __forceinline__ unsigned xb_xcc_id() { return (unsigned)__builtin_amdgcn_s_getreg((3 << 11) | 20) & 0xFu; }
#define XB_SPIN(cond, bar) do { unsigned _sp = 0; while (cond) { __builtin_amdgcn_s_sleep(1); \
    if ((++_sp & 255u) == 0u) { if (xb_ld(&(bar)[XB_TMO])) break; if (_sp > XB_SPIN_CAP) { atomicAdd(&(bar)[XB_TMO], 1u); break; } } } } while (0)
struct XcdBarrier { unsigned* bar; unsigned x; volatile LAS unsigned* st; };
__device__ __forceinline__ XcdBarrier xcd_barrier_post(unsigned* bar, volatile LAS unsigned* st) {
    XcdBarrier b; b.bar = bar; b.x = xb_xcc_id(); b.st = st;
    if (threadIdx.x == 0) (void)xb_add(&bar[XB_XCNT(b.x)], 1u);
    return b;
}
__device__ __forceinline__ void xcd_barrier_complete(unsigned* bar, unsigned x, unsigned& nloc, unsigned& nx) {
    const unsigned G = gridDim.x * gridDim.y * gridDim.z;
    unsigned sum, cnt, mine, sp = 0u;
    for (;;) {
        sum = 0u; cnt = 0u; mine = 0u;
#pragma unroll
        for (unsigned j = 0; j < 16; ++j) { const unsigned c = xb_ld(&bar[XB_XCNT(j)]); sum += c; cnt += (c > 0u) ? 1u : 0u; mine = (j == x) ? c : mine; }
        if (sum == G) break;
        __builtin_amdgcn_s_sleep(1);
        if ((++sp & 255u) == 0u) { if (xb_ld(&bar[XB_TMO])) break; if (sp > XB_SPIN_CAP) { atomicAdd(&bar[XB_TMO], 1u); break; } }
    }
    nloc = mine > 0u ? mine : 1u; nx = cnt > 0u ? cnt : 1u;
}
__device__ __forceinline__ void xcd_barrier(const XcdBarrier& b) {
    asm volatile("s_waitcnt vmcnt(0)" ::: "memory");
    __syncthreads();
    if (threadIdx.x == 0) {
        unsigned* bar = b.bar;
        __builtin_amdgcn_s_waitcnt(0);
        unsigned nloc = b.st[0], nx = b.st[1];
        if (nloc == 0u) { xcd_barrier_complete(bar, b.x, nloc, nx); b.st[0] = nloc; b.st[1] = nx; }
        const unsigned old = xb_add(&bar[XB_XSUB(b.x)], 1u);
        const unsigned gen = old / nloc;
        if (old + 1u == (gen + 1u) * nloc) {
            __builtin_amdgcn_fence(__ATOMIC_RELEASE, "agent");
            asm volatile("s_waitcnt vmcnt(0)" ::: "memory");
            const unsigned og = xb_add(&bar[XB_TOP], 1u);
            const unsigned tg = og / nx;
            if (og + 1u == (tg + 1u) * nx) xb_add(&bar[XB_TOPGEN], 1u);
            else XB_SPIN(xb_ld(&bar[XB_TOPGEN]) == tg, bar);
            __builtin_amdgcn_fence(__ATOMIC_ACQUIRE, "agent");
            xb_add(&bar[XB_XGEN(b.x)], 1u);
            asm volatile("s_waitcnt vmcnt(0)" ::: "memory");
        } else {
            XB_SPIN(xb_ld(&bar[XB_XGEN(b.x)]) == gen, bar);
            __builtin_amdgcn_fence(__ATOMIC_ACQUIRE, "agent");
            asm volatile("s_waitcnt vmcnt(0)" ::: "memory");
        }
    }
    __syncthreads();
}

constexpr int NPHASE = 2 + 7 * DEPTH;
#ifndef PHMASK
#define PHMASK 0xFFF
#endif
#define PH_EN(x) (((PHMASK) >> (x)) & 1)
__device__ __forceinline__ void run_phase(const Params& p, LAS unsigned char* lds, int ph) {
    if (ph == 0) { if (PH_EN(10)) phase_prep(p, lds); return; }
    if (ph == NPHASE - 1) { if (PH_EN(11)) phase_final(p); return; }
    const int l = (ph - 1) / 7, s = (ph - 1) % 7;
    bf16_t* mix = (bf16_t*)(p.ws + W_HB); bf16_t* xb = (bf16_t*)(p.ws + W_XB); bf16_t* big = (bf16_t*)(p.ws + W_PROJ); bf16_t* act = (bf16_t*)(p.ws + W_DS);
    u64* rss = (u64*)(p.ws + W_RSS);
    pg8::StaticOrder S;
    switch (s) {
    case 0: if (PH_EN(1)) {
        const bf16_t* W = (const bf16_t*)(p.ws + W_WIN) + (size_t)l * NPROJ * DM;
        const u64* r = rss + (size_t)(2 * l) * TT;
        S.init(TP, NPROJ, gridDim.x, blockIdx.x);
        pg8::gemm_phase(lds, pg8::Gemm{xb, W, TP, NPROJ, DM}, S, pg8::EpiBf16{big, NPROJ, r});
        phase_dt(p, l);
        thin_gemm<DM, 0>(lds, xb + (size_t)TP * DM, W, NPROJ, big + (size_t)TP * NPROJ, NPROJ, nullptr, (u64*)r + TP);
    } break;
    case 1: if (PH_EN(2)) phase_m1(p, lds, l); break;
    case 2: if (PH_EN(3)) phase_m15(p, l); break;
    case 3: if (PH_EN(4)) phase_m2(p, lds, l); break;
    case 4: if (PH_EN(5)) {
        const bf16_t* W = (const bf16_t*)(p.ws + W_WOUT) + (size_t)l * DM * DMIX;
        u64* r = rss + (size_t)(2 * l + 1) * TT;
        S.init(TP, DM, gridDim.x, blockIdx.x);
        pg8::gemm_phase(lds, pg8::Gemm{mix, W, TP, DM, DMIX}, S, pg8::EpiResid{DM, xb, r});
        thin_gemm<DMIX, 1>(lds, mix + (size_t)TP * DMIX, W, DM, nullptr, DM, xb + (size_t)TP * DM, r + TP);
    } break;
    case 5: if (PH_EN(7)) {
        const bf16_t* W = (const bf16_t*)(p.ws + W_WUP) + (size_t)l * DGU * DM;
        const u64* r = rss + (size_t)(2 * l + 1) * TT;
        const float* cw = p.in[27] + (size_t)l * 3 * DFF; const float* cb = p.in[28] + (size_t)l * DFF;
        S.init(TP, DGU, gridDim.x, blockIdx.x);
        pg8::gemm_phase(lds, pg8::Gemm{xb, W, TP, DGU, DM}, S, pg8::EpiAct{act, r, cw, cb, (bf16_t*)(p.ws + W_GS01), (bf16_t*)(p.ws + W_US01), (bf16_t*)(p.ws + W_GS23), p.out + O_FCP + (size_t)l * NB * 2 * DFF});
        thin_gemm_act(lds, xb + (size_t)TP * DM, W, r + TP, cw, cb, p.in[7] + (size_t)l * NS * 2 * DFF, p.out + O_FCS + (size_t)l * NS * 2 * DFF, act + (size_t)TP * DFF, gridDim.x == 256 ? 128 : 0, gridDim.x == 256 ? 128 : (int)gridDim.x);
    } break;
    case 6: if (PH_EN(9)) {
        const bf16_t* W = (const bf16_t*)(p.ws + W_WDOWN) + (size_t)l * DM * DFF;
        u64* r = rss + (size_t)(2 * l + 2) * TT;
        S.init(TP, DM, gridDim.x, blockIdx.x);
        { pg8::Unit uu; for (int i = 0; S.next(i, uu); ++i) act_fixup(p, l, uu.pm); __threadfence(); __syncthreads(); }
        pg8::gemm_phase(lds, pg8::Gemm{act, W, TP, DM, DFF}, S, pg8::EpiResid{DM, xb, r});
        thin_gemm<DFF, 1>(lds, act + (size_t)TP * DFF, W, DM, nullptr, DM, xb + (size_t)TP * DM, r + TP);
    } break;
    }
}

__global__ void __launch_bounds__(512, 2) mega(Params p, int ph0, int ph1, int coop) {
    extern __shared__ __attribute__((aligned(16))) unsigned char shm[];
    LAS unsigned char* lds = (LAS unsigned char*)shm;
    cg::grid_group grid = cg::this_grid();
    volatile LAS unsigned* st = (volatile LAS unsigned*)(lds + LDS_BYTES);
    if (threadIdx.x < 4) st[threadIdx.x] = 0u;
    __syncthreads();
    XcdBarrier xb = xcd_barrier_post((unsigned*)(p.ws + W_BAR), st);
    for (int ph = ph0; ph < ph1; ++ph) {
        int reps = 1;
#ifdef REP_MASK
        { const int s = (ph == 0) ? 10 : (ph == NPHASE - 1 ? 11 : (ph - 1) % 7); if ((REP_MASK >> s) & 1) reps = 2; }
#endif
        for (int r = 0; r < reps; ++r) { run_phase(p, lds, ph); if (reps > 1) __syncthreads(); }
        if (coop && ph + 1 < ph1) {
            if (coop == 2) grid.sync();
            xcd_barrier(xb);
#ifdef REP_SYNC
            xcd_barrier(xb);
#endif
        }
    }
}

extern "C" void kernel_launch(void* const* d_in, const int* in_sizes, int n_in, void* d_out, int out_size, void* d_ws, size_t ws_size, hipStream_t stream) {
    static int grid_blocks = 0;
    if (!grid_blocks) {
        int dev = 0, cus = 0, per_cu = 0;
        hipGetDevice(&dev);
        hipDeviceGetAttribute(&cus, hipDeviceAttributeMultiprocessorCount, dev);
        hipFuncSetAttribute((const void*)mega, hipFuncAttributeMaxDynamicSharedMemorySize, LDS_BYTES + 16);
        hipOccupancyMaxActiveBlocksPerMultiprocessor(&per_cu, (const void*)mega, 512, LDS_BYTES + 16);
        if (per_cu < 1) per_cu = 1;
        grid_blocks = cus * per_cu;
        if (grid_blocks > 256) grid_blocks = 256;
        if (ws_size < W_END) fprintf(stderr, "kernel_launch: workspace too small: %zu < %zu\n", ws_size, (size_t)W_END);
    }
    Params p{};
    for (int i = 0; i < 31; ++i) p.in[i] = (const float*)d_in[i];
    p.out = (float*)d_out; p.ws = (unsigned char*)d_ws;
    hipMemsetAsync((unsigned char*)d_ws + W_BAR, 0, XCD_BAR_WORDS * 4, stream);
    int ph0 = 0, ph1 = NPHASE, coop = 1;
    void* args[] = {&p, &ph0, &ph1, &coop};
    hipError_t e = hipLaunchCooperativeKernel((const void*)mega, dim3(grid_blocks), dim3(512), args, LDS_BYTES + 16, stream);
    if (e != hipSuccess) fprintf(stderr, "cooperative launch failed: %s (grid %d)\n", hipGetErrorString(e), grid_blocks);
}
```
